# Optimizing an MI355X kernel written in HIP

```python
import math
import jax, jax.numpy as jnp
from jax import lax
import numpy as np

D_MODEL = 1024
BATCH = 4
SEQ = 8192
DEPTH = 2

GRID_W = 64
CTX_LEN = 256
HEAD_DIM = 64
A_HEADS = 4
A_KV_HEADS = 2
B_HEADS = 4
B_DK = 32
B_DV = 64
C_HEADS = 4
C_KV_HEADS = 2
WINDOW = 128
D_HEADS = 4
NA_ROWS_MAX = 8
NA_COLS = 16
Q_BLOCK = 128
N_BAND = 1 + 2 * (WINDOW // Q_BLOCK)
ROPE_THETA = 10000.0
N_BRANCH = 4
BRANCH_W = 256
N_EXPERTS = 32
TOP_K = 4
D_FF = D_MODEL
SWIGLU_LIMIT = 7.0
SWIGLU_ALPHA = 1.702
EXPERT_BLOCK = 256
N_MOD = 6
EPS = 1e-6
NEG_INF = -1e30
Q_SIZES = (A_HEADS * HEAD_DIM, B_HEADS * 2 * B_DK, C_HEADS * HEAD_DIM, D_HEADS * HEAD_DIM)
K_SIZES = (A_KV_HEADS * HEAD_DIM, B_HEADS * 2 * B_DK, C_KV_HEADS * HEAD_DIM, D_HEADS * HEAD_DIM)
V_SIZES = (A_KV_HEADS * HEAD_DIM, B_HEADS * B_DV, C_KV_HEADS * HEAD_DIM, D_HEADS * HEAD_DIM)
Q_TOT = sum(Q_SIZES)
KV_TOT = sum(K_SIZES) + sum(V_SIZES)
GATE_TOT = N_BRANCH * D_MODEL
W_IN_COLS = Q_TOT + KV_TOT + GATE_TOT

kernel_name = 'hybrid_diffusion_backbone'


def rms_norm(x, g):
    xf = x.astype(jnp.float32)
    y = xf * lax.rsqrt(jnp.mean(xf * xf, axis=-1, keepdims=True) + EPS)
    return (y * g.astype(jnp.float32)).astype(x.dtype)


def modulate(h, shift, scale):
    return h * (1 + scale) + shift


def heads(x, n):
    return x.reshape(x.shape[:-1] + (n, -1))


def split_cols(x, sizes):
    return jnp.split(x, np.cumsum(sizes)[:-1].tolist(), axis=-1)


def rope_2d(n_tok, dim):
    t = jnp.arange(n_tok, dtype=jnp.int32)
    row = (t // GRID_W).astype(jnp.float32)
    col = (t % GRID_W).astype(jnp.float32)
    n_freq = dim // 4
    inv = ROPE_THETA ** (-jnp.arange(n_freq, dtype=jnp.float32) / n_freq)
    ang = jnp.concatenate([row[:, None] * inv, col[:, None] * inv], axis=-1)
    return (jnp.cos(ang), jnp.sin(ang))


def apply_rope(x, cos, sin):
    half = x.shape[-1] // 2
    shape = (cos.shape[0],) + (1,) * (x.ndim - 3) + (half,)
    cos = cos.reshape(shape).astype(x.dtype)
    sin = sin.reshape(shape).astype(x.dtype)
    x1, x2 = x[..., :half], x[..., half:]
    return jnp.concatenate([x1 * cos - x2 * sin, x1 * sin + x2 * cos], axis=-1)


def softmax_sink(s, sink):
    m = jnp.maximum(jnp.max(s, axis=-1, keepdims=True), sink)
    e = jnp.exp(s - m)
    return e / (jnp.sum(e, axis=-1, keepdims=True) + jnp.exp(sink - m))


def sweep_query_blocks(attend, q):
    B, S = q.shape[:2]
    nb = S // Q_BLOCK
    qb = jnp.moveaxis(q.reshape((B, nb, Q_BLOCK) + q.shape[2:]), 1, 0)
    o = lax.map(attend, qb)
    return jnp.moveaxis(o, 0, 1).reshape((B, S) + o.shape[3:])


def gqa_attend(q, k, v, sink=None):
    B, Q, H, d = q.shape
    Hkv = k.shape[2]
    G = H // Hkv
    s = jnp.einsum('bqkgd,btkd->bkgqt', q.reshape(B, Q, Hkv, G, d), k).astype(jnp.float32) * (d ** -0.5)
    if sink is None:
        p = jax.nn.softmax(s, axis=-1)
    else:
        p = softmax_sink(s, sink.astype(jnp.float32).reshape(Hkv, G, 1, 1))
    o = jnp.einsum('bkgqt,btkd->bqkgd', p.astype(v.dtype), v)
    return o.reshape(B, Q, H, v.shape[-1])


def diff_lambda(lq1, lk1, lq2, lk2, lam_init):
    f = lambda a: a.astype(jnp.float32)
    return jnp.exp(jnp.sum(f(lq1) * f(lk1))) - jnp.exp(jnp.sum(f(lq2) * f(lk2))) + lam_init


def diff_attend(q, k, v, lam):
    s = jnp.einsum('bqhcd,bthcd->bchqt', q, k).astype(jnp.float32) * (q.shape[-1] ** -0.5)
    p = jax.nn.softmax(s, axis=-1)
    a = (p[:, 0] - lam * p[:, 1]).astype(v.dtype)
    return jnp.einsum('bhqt,bthd->bqhd', a, v)


def diff_out(o, subln_g, lam_init):
    return rms_norm(o, subln_g) * (1 - lam_init)


def window_attend(q, k, v, kc, vc, sink):
    B, S, H, d = q.shape
    Hkv = k.shape[2]
    G = H // Hkv
    nb = S // Q_BLOCK
    pad = ((0, 0), (WINDOW, WINDOW), (0, 0), (0, 0))
    idx = jnp.arange(nb)[:, None] + jnp.arange(N_BAND)[None, :]
    J = N_BAND * Q_BLOCK
    kb = jnp.pad(k, pad).reshape(B, nb + N_BAND - 1, Q_BLOCK, Hkv, d)[:, idx].reshape(B, nb, J, Hkv, d)
    vb = jnp.pad(v, pad).reshape(B, nb + N_BAND - 1, Q_BLOCK, Hkv, v.shape[-1])[:, idx].reshape(B, nb, J, Hkv, v.shape[-1])
    qb = q.reshape(B, nb, Q_BLOCK, Hkv, G, d)
    scale = d ** -0.5
    s_loc = jnp.einsum('bnqkgd,bnjkd->bnkgqj', qb, kb).astype(jnp.float32) * scale
    qpos = jnp.arange(nb)[:, None] * Q_BLOCK + jnp.arange(Q_BLOCK)[None, :]
    kpos = jnp.arange(nb)[:, None] * Q_BLOCK - WINDOW + jnp.arange(J)[None, :]
    valid = (jnp.abs(kpos[:, None, :] - qpos[:, :, None]) <= WINDOW) & (kpos[:, None, :] >= 0) & (kpos[:, None, :] < S)
    s_loc = jnp.where(valid[None, :, None, None], s_loc, NEG_INF)
    s_ctx = jnp.einsum('bnqkgd,bckd->bnkgqc', qb, kc).astype(jnp.float32) * scale
    p = softmax_sink(jnp.concatenate([s_loc, s_ctx], axis=-1), sink.astype(jnp.float32).reshape(1, 1, Hkv, G, 1, 1))
    p = p.astype(v.dtype)
    o = jnp.einsum('bnkgqj,bnjkd->bnqkgd', p[..., :J], vb) + jnp.einsum('bnkgqc,bckd->bnqkgd', p[..., J:], vc)
    return o.reshape(B, S, H, v.shape[-1])


def neighbourhood_attend(q, k, v, kc, vc, rpb):
    B, S, H, d = q.shape
    rows = S // GRID_W
    kh = min(NA_ROWS_MAX, rows)
    J = kh * GRID_W
    qg = q.reshape(B, rows, GRID_W, H, d)
    r = jnp.arange(rows)
    r0 = jnp.clip(r - kh // 2, 0, rows - kh)
    ridx = r0[:, None] + jnp.arange(kh)[None, :]
    kn = k.reshape(B, rows, GRID_W, H, d)[:, ridx].reshape(B, rows, J, H, d)
    vn = v.reshape(B, rows, GRID_W, H, v.shape[-1])[:, ridx].reshape(B, rows, J, H, v.shape[-1])
    scale = d ** -0.5
    s_loc = jnp.einsum('brqhd,brjhd->brhqj', qg, kn).astype(jnp.float32) * scale
    col = jnp.arange(GRID_W)
    c0 = jnp.clip(col - NA_COLS // 2, 0, GRID_W - NA_COLS)
    col_ok = (col[None, :] >= c0[:, None]) & (col[None, :] < c0[:, None] + NA_COLS)
    mask = jnp.broadcast_to(col_ok[:, None, :], (GRID_W, kh, GRID_W)).reshape(GRID_W, J)
    dr = ridx - r[:, None] + (NA_ROWS_MAX - 1)
    dc = jnp.clip(col[None, :] - col[:, None], -(NA_COLS - 1), NA_COLS - 1) + (NA_COLS - 1)
    bias = rpb[:, dr[:, None, :, None], dc[None, :, None, :]]
    bias = bias.transpose(1, 0, 2, 3, 4).reshape(rows, H, GRID_W, J).astype(jnp.float32)
    s_loc = jnp.where(mask, s_loc + bias, NEG_INF)
    s_ctx = jnp.einsum('brqhd,bchd->brhqc', qg, kc).astype(jnp.float32) * scale
    p = jax.nn.softmax(jnp.concatenate([s_loc, s_ctx], axis=-1), axis=-1).astype(v.dtype)
    o = jnp.einsum('brhqj,brjhd->brqhd', p[..., :J], vn) + jnp.einsum('brhqc,bchd->brqhd', p[..., J:], vc)
    return o.reshape(B, S, H, v.shape[-1])


def merge_branches(outs, g, b_gate, w_branch, w_out):
    lead = outs[0].shape[:2]
    br = jnp.stack([o.reshape(lead + (BRANCH_W,)) for o in outs], axis=2)
    proj = jnp.einsum('btnc,ncd->btnd', br, w_branch)
    gate = jax.nn.sigmoid(g + b_gate).reshape(lead + (N_BRANCH, D_MODEL))
    return jnp.sum(gate * proj, axis=2) @ w_out


def token_mixer(h, hc, need_ctx, lam_init, rope, w_in, b_gate, a_qn, a_kn, b_qn, b_kn,
                lam_q1, lam_k1, lam_q2, lam_k2, subln_g, c_qn, c_kn, sink, d_qn, d_kn,
                rpb, w_branch, w_out):
    cos64, sin64, cos32, sin32 = rope
    B, S, _ = h.shape
    C = hc.shape[1]
    q, kv, g = split_cols(h @ w_in, (Q_TOT, KV_TOT, GATE_TOT))
    q_g, q_d, q_w, q_n = split_cols(q, Q_SIZES)
    k_g, k_d, k_w, k_n, v_g, v_d, v_w, v_n = split_cols(kv, K_SIZES + V_SIZES)
    ck_g, ck_d, ck_w, ck_n, cv_g, cv_d, cv_w, cv_n = split_cols(hc @ w_in[:, Q_TOT:Q_TOT + KV_TOT], K_SIZES + V_SIZES)

    q_g = apply_rope(rms_norm(heads(q_g, A_HEADS), a_qn), cos64, sin64)
    k_g = apply_rope(rms_norm(heads(k_g, A_KV_HEADS), a_kn), cos64, sin64)
    ck_g = rms_norm(heads(ck_g, A_KV_HEADS), a_kn)
    cv_g = heads(cv_g, A_KV_HEADS)
    kk_g = jnp.concatenate([k_g, ck_g], axis=1)
    vv_g = jnp.concatenate([heads(v_g, A_KV_HEADS), cv_g], axis=1)
    o_g = sweep_query_blocks(lambda qb: gqa_attend(qb, kk_g, vv_g), q_g)

    lam = diff_lambda(lam_q1, lam_k1, lam_q2, lam_k2, lam_init)
    q_d = apply_rope(rms_norm(q_d.reshape(B, S, B_HEADS, 2, B_DK), b_qn), cos32, sin32)
    k_d = apply_rope(rms_norm(k_d.reshape(B, S, B_HEADS, 2, B_DK), b_kn), cos32, sin32)
    ck_d = rms_norm(ck_d.reshape(B, C, B_HEADS, 2, B_DK), b_kn)
    cv_d = heads(cv_d, B_HEADS)
    kk_d = jnp.concatenate([k_d, ck_d], axis=1)
    vv_d = jnp.concatenate([heads(v_d, B_HEADS), cv_d], axis=1)
    o_d = diff_out(sweep_query_blocks(lambda qb: diff_attend(qb, kk_d, vv_d, lam), q_d), subln_g, lam_init)

    q_w = apply_rope(rms_norm(heads(q_w, C_HEADS), c_qn), cos64, sin64)
    k_w = apply_rope(rms_norm(heads(k_w, C_KV_HEADS), c_kn), cos64, sin64)
    ck_w = rms_norm(heads(ck_w, C_KV_HEADS), c_kn)
    cv_w = heads(cv_w, C_KV_HEADS)
    o_w = window_attend(q_w, k_w, heads(v_w, C_KV_HEADS), ck_w, cv_w, sink)

    q_n = rms_norm(heads(q_n, D_HEADS), d_qn)
    k_n = rms_norm(heads(k_n, D_HEADS), d_kn)
    ck_n = rms_norm(heads(ck_n, D_HEADS), d_kn)
    cv_n = heads(cv_n, D_HEADS)
    o_n = neighbourhood_attend(q_n, k_n, heads(v_n, D_HEADS), ck_n, cv_n, rpb)

    out = merge_branches((o_g, o_d, o_w, o_n), g, b_gate, w_branch, w_out)
    if not need_ctx:
        return out, None
    cq_g, cq_d, cq_w, cq_n = split_cols(hc @ w_in[:, :Q_TOT], Q_SIZES)
    co_g = gqa_attend(rms_norm(heads(cq_g, A_HEADS), a_qn), ck_g, cv_g)
    co_d = diff_out(diff_attend(rms_norm(cq_d.reshape(B, C, B_HEADS, 2, B_DK), b_qn), ck_d, cv_d, lam), subln_g, lam_init)
    co_w = gqa_attend(rms_norm(heads(cq_w, C_HEADS), c_qn), ck_w, cv_w, sink)
    co_n = gqa_attend(rms_norm(heads(cq_n, D_HEADS), d_qn), ck_n, cv_n)
    out_c = merge_branches((co_g, co_d, co_w, co_n), hc @ w_in[:, Q_TOT + KV_TOT:], b_gate, w_branch, w_out)
    return out, out_c


def moe_ffn(h, router_w, router_b, w_gate_up, b_gate_up, w_down, b_down):
    T, D = h.shape
    logits = (h @ router_w).astype(jnp.float32) + router_b.astype(jnp.float32)
    top_v, top_e = lax.top_k(logits, TOP_K)
    top_w = jax.nn.softmax(top_v, axis=-1).astype(h.dtype)
    n = T * TOP_K
    flat_e = top_e.reshape(-1)
    order = jnp.argsort(flat_e, stable=True)
    e_sorted = flat_e[order]
    tok = (order // TOP_K).astype(jnp.int32)
    counts = jnp.bincount(flat_e, length=N_EXPERTS)
    padded = (counts + EXPERT_BLOCK - 1) // EXPERT_BLOCK * EXPERT_BLOCK
    pad_end = jnp.cumsum(padded)
    pad_start = pad_end - padded
    start = jnp.cumsum(counts) - counts
    dest = pad_start[e_sorted] + jnp.arange(n) - start[e_sorted]
    P = n + N_EXPERTS * EXPERT_BLOCK
    n_blk = P // EXPERT_BLOCK
    slot_tok = jnp.full((P,), T, jnp.int32).at[dest].set(tok)
    hp = jnp.concatenate([h, jnp.zeros((1, D), h.dtype)], axis=0)
    xbuf = hp[slot_tok].reshape(n_blk, EXPERT_BLOCK, D)
    blk_e = jnp.minimum(jnp.searchsorted(pad_end, jnp.arange(n_blk) * EXPERT_BLOCK, side='right'), N_EXPERTS - 1)

    def expert_block(args):
        xb, e = args
        gu = xb @ w_gate_up[e] + b_gate_up[e]
        gate = jnp.minimum(gu[:, :D_FF], SWIGLU_LIMIT)
        up = jnp.clip(gu[:, D_FF:], -SWIGLU_LIMIT, SWIGLU_LIMIT)
        return (gate * jax.nn.sigmoid(SWIGLU_ALPHA * gate) * (up + 1)) @ w_down[e] + b_down[e]

    y = lax.map(expert_block, (xbuf, blk_e)).reshape(P, D)
    contrib = y[dest] * top_w.reshape(-1)[order][:, None]
    return jax.ops.segment_sum(contrib, tok, num_segments=T)


def _normal(k, shape, scale):
    return jax.random.normal(k, shape, jnp.float32) * scale


def _gain(k, shape):
    return 1.0 + 0.05 * jax.random.normal(k, shape, jnp.float32)


def setup_inputs(seed: int = 0) -> dict:
    key = jax.random.key(seed)
    ks = jax.random.split(key, 33)
    L, D, E = DEPTH, D_MODEL, N_EXPERTS
    return {
        'x': _normal(ks[0], (BATCH, SEQ, D), 1.0),
        'c': _normal(ks[1], (BATCH, D), 1.0),
        'ctx': _normal(ks[2], (BATCH, CTX_LEN, D), 1.0),
        'c_ctx': _normal(ks[3], (D,), 1.0),
        'norm1_g': _gain(ks[4], (L, D)),
        'norm2_g': _gain(ks[5], (L, D)),
        'w_ada': _normal(ks[6], (L, D, N_MOD * D), 0.5 * D ** -0.5),
        'b_ada': _normal(ks[7], (L, N_MOD * D), 0.1),
        'w_in': _normal(ks[8], (L, D, W_IN_COLS), D ** -0.5),
        'b_gate': _normal(ks[9], (L, GATE_TOT), 0.1),
        'a_qn': _gain(ks[10], (L, HEAD_DIM)),
        'a_kn': _gain(ks[11], (L, HEAD_DIM)),
        'b_qn': _gain(ks[12], (L, B_DK)),
        'b_kn': _gain(ks[13], (L, B_DK)),
        'lam_q1': _normal(ks[14], (L, B_DK), 0.1),
        'lam_k1': _normal(ks[15], (L, B_DK), 0.1),
        'lam_q2': _normal(ks[16], (L, B_DK), 0.1),
        'lam_k2': _normal(ks[17], (L, B_DK), 0.1),
        'subln_g': _gain(ks[18], (L, B_DV)),
        'c_qn': _gain(ks[19], (L, HEAD_DIM)),
        'c_kn': _gain(ks[20], (L, HEAD_DIM)),
        'sink': _normal(ks[21], (L, C_HEADS), 0.5),
        'd_qn': _gain(ks[22], (L, HEAD_DIM)),
        'd_kn': _gain(ks[23], (L, HEAD_DIM)),
        'rpb': _normal(ks[24], (L, D_HEADS, 2 * NA_ROWS_MAX - 1, 2 * NA_COLS - 1), 0.1),
        'w_branch': _normal(ks[25], (L, N_BRANCH, BRANCH_W, D), BRANCH_W ** -0.5),
        'w_out': _normal(ks[26], (L, D, D), D ** -0.5),
        'router_w': _normal(ks[27], (L, D, E), D ** -0.5),
        'router_b': _normal(ks[28], (L, E), 0.01),
        'w_gate_up': _normal(ks[29], (L, E, D, 2 * D_FF), D ** -0.5),
        'b_gate_up': _normal(ks[30], (L, E, 2 * D_FF), 0.02),
        'w_down': _normal(ks[31], (L, E, D_FF, D), D_FF ** -0.5),
        'b_down': _normal(ks[32], (L, E, D), 0.02),
    }


def reference(x, c, ctx, c_ctx, norm1_g, norm2_g, w_ada, b_ada, w_in, b_gate,
              a_qn, a_kn, b_qn, b_kn, lam_q1, lam_k1, lam_q2, lam_k2, subln_g,
              c_qn, c_kn, sink, d_qn, d_kn, rpb, w_branch, w_out,
              router_w, router_b, w_gate_up, b_gate_up, w_down, b_down):
    B, S, D = x.shape
    rope = rope_2d(S, HEAD_DIM) + rope_2d(S, B_DK)
    for l in range(DEPTH):
        last = l == DEPTH - 1
        lam_init = 0.8 - 0.6 * math.exp(-0.3 * l)
        mod = (jax.nn.silu(c) @ w_ada[l] + b_ada[l])[:, None, :]
        sh1, sc1, g1, sh2, sc2, g2 = jnp.split(mod, N_MOD, axis=-1)
        cmod = jax.nn.silu(c_ctx) @ w_ada[l] + b_ada[l]
        csh1, csc1, cg1, csh2, csc2, cg2 = jnp.split(cmod, N_MOD, axis=-1)
        h = modulate(rms_norm(x, norm1_g[l]), sh1, sc1)
        hc = modulate(rms_norm(ctx, norm1_g[l]), csh1, csc1)
        mix, mix_c = token_mixer(h, hc, not last, lam_init, rope, w_in[l], b_gate[l], a_qn[l], a_kn[l],
                                 b_qn[l], b_kn[l], lam_q1[l], lam_k1[l], lam_q2[l], lam_k2[l], subln_g[l],
                                 c_qn[l], c_kn[l], sink[l], d_qn[l], d_kn[l], rpb[l], w_branch[l], w_out[l])
        x = x + g1 * mix
        h = modulate(rms_norm(x, norm2_g[l]), sh2, sc2)
        expert_args = (router_w[l], router_b[l], w_gate_up[l], b_gate_up[l], w_down[l], b_down[l])
        if last:
            x = x + g2 * moe_ffn(h.reshape(-1, D), *expert_args).reshape(B, S, D)
        else:
            ctx = ctx + cg1 * mix_c
            hc = modulate(rms_norm(ctx, norm2_g[l]), csh2, csc2)
            y = moe_ffn(jnp.concatenate([h.reshape(-1, D), hc.reshape(-1, D)], axis=0), *expert_args)
            x = x + g2 * y[:B * S].reshape(B, S, D)
            ctx = ctx + cg2 * y[B * S:].reshape(ctx.shape)
    return x
```

```cpp
#include <hip/hip_runtime.h>
#include <cstdio>
#include <cstdint>

#ifndef MK_PER_PHASE
#define MK_PER_PHASE 0
#endif

#define LAS __attribute__((address_space(3)))
typedef unsigned short bf16_t;
typedef short bf16x8 __attribute__((ext_vector_type(8)));
typedef short s16x4 __attribute__((ext_vector_type(4)));
typedef float f32x4 __attribute__((ext_vector_type(4)));
typedef float f32x16 __attribute__((ext_vector_type(16)));
typedef float f32x2 __attribute__((ext_vector_type(2)));
typedef unsigned u32x4 __attribute__((ext_vector_type(4)));
typedef unsigned u32x2 __attribute__((ext_vector_type(2)));
typedef __bf16 bf16x2_t __attribute__((ext_vector_type(2)));

constexpr int DM = 1024, NB = 4, SEQ = 8192, CTXL = 256;
constexpr int TL = NB * SEQ;
constexpr int TC = NB * CTXL;
constexpr int TT = TL + TC;
constexpr int NQKV = 2560, NGATE = 4096, NIN = 6656;
constexpr int NEXP = 32, ECAP = TT;
constexpr int MAXTILES = 560;
constexpr float LOG2E = 1.4426950408889634f;
constexpr float EPSN = 1e-6f;
constexpr int QA = 0, QB_ = 256, QC = 512, QD = 768, KA = 1024, KB_ = 1152, KC = 1408, KD = 1536, VA = 1792, VB_ = 1920, VC = 2176, VD = 2304;

constexpr size_t MiB = 1u << 20;
constexpr size_t WS_CTL = 0, CTL_ZERO_BYTES = 1 * MiB;
constexpr size_t WS_MOD = 1 * MiB;
constexpr size_t WS_ROPE = 2 * MiB;
constexpr size_t WS_TOKEP = 6 * MiB;
constexpr size_t WS_TOKW = 7 * MiB;
constexpr size_t WS_TOKMAP = 8 * MiB;
constexpr size_t WS_WIN = 16 * MiB;
constexpr size_t WS_WB = 42 * MiB;
constexpr size_t WS_WO = 46 * MiB;
constexpr size_t WS_WGU = 50 * MiB;
constexpr size_t WS_WD = 306 * MiB;
constexpr size_t WS_H = 434 * MiB;
constexpr size_t WS_QKV = 501 * MiB;
constexpr size_t WS_G = 666 * MiB;
constexpr size_t WS_BR = 930 * MiB;
constexpr size_t WS_XR = 996 * MiB;
constexpr size_t WS_ACT = 1128 * MiB;
constexpr size_t WS_Y = 1408 * MiB;
constexpr size_t WS_END = 1688 * MiB;
constexpr int CW_GCOUNT = 64;
constexpr int CW_BAR = 4096;

constexpr int LDS_BYTES = 163840;
constexpr int MISC_OFF = LDS_BYTES - 1024;
constexpr int NWAVES = 8, NTHR = 512;

__device__ __forceinline__ unsigned cvtpk(float lo, float hi) { f32x2 v = {lo, hi}; bf16x2_t b = __builtin_convertvector(v, bf16x2_t); return __builtin_bit_cast(unsigned, b); }
__device__ __forceinline__ float bflo(unsigned u) { return __builtin_bit_cast(float, u << 16); }
__device__ __forceinline__ float bfhi(unsigned u) { return __builtin_bit_cast(float, u & 0xffff0000u); }
__device__ __forceinline__ float shx(float v, int m, int lane) { return __builtin_bit_cast(float, __builtin_amdgcn_ds_bpermute((lane ^ m) << 2, __builtin_bit_cast(int, v))); }
__device__ __forceinline__ float wave_sum(float v, int lane) {
#pragma unroll
    for (int o = 1; o < 64; o <<= 1) v += shx(v, o, lane);
    return v;
}
__device__ __forceinline__ float wave_max(float v, int lane) {
#pragma unroll
    for (int o = 1; o < 64; o <<= 1) v = fmaxf(v, shx(v, o, lane));
    return v;
}
#define LDS_WAIT() asm volatile("s_waitcnt lgkmcnt(0)" ::: "memory")
#define VM_WAIT() asm volatile("s_waitcnt vmcnt(0)" ::: "memory")

#define XB_TMO      128
#define XB_XCNT(j)  (256  + 64 * (j))
#define XB_XSUB(j)  (1280 + 64 * (j))
#define XB_XGEN(j)  (2304 + 64 * (j))
#define XB_TOP      3328
#define XB_TOPGEN   3392
#define XCD_BAR_WORDS 3456
#define XB_SPIN_CAP (1u << 24)

__device__ __forceinline__ unsigned xb_ld(unsigned* p)              { return __hip_atomic_load(p, __ATOMIC_RELAXED, __HIP_MEMORY_SCOPE_AGENT); }
__device__ __forceinline__ unsigned xb_add(unsigned* p, unsigned v) { return __hip_atomic_fetch_add(p, v, __ATOMIC_RELAXED, __HIP_MEMORY_SCOPE_AGENT); }
__device__ __forceinline__ unsigned xb_xcc_id() { return (unsigned)__builtin_amdgcn_s_getreg((3 << 11) | 20) & 0xFu; }
#define XB_SPIN(cond, bar) do { unsigned _sp = 0; while (cond) { __builtin_amdgcn_s_sleep(1); \
    if ((++_sp & 255u) == 0u) { if (xb_ld(&(bar)[XB_TMO])) break; if (_sp > XB_SPIN_CAP) { atomicAdd(&(bar)[XB_TMO], 1u); break; } } } } while (0)

struct XcdBarrier { unsigned* bar; unsigned x; volatile LAS unsigned* st; };

__device__ __forceinline__ XcdBarrier xcd_barrier_post(unsigned* bar, volatile LAS unsigned* st) {
    XcdBarrier b; b.bar = bar; b.x = xb_xcc_id(); b.st = st;
    if (threadIdx.x == 0) (void)xb_add(&bar[XB_XCNT(b.x)], 1u);
    return b;
}
__device__ __forceinline__ void xcd_barrier_complete(unsigned* bar, unsigned x, unsigned& nloc, unsigned& nx) {
    const unsigned G = gridDim.x * gridDim.y * gridDim.z;
    unsigned sum, cnt, mine, sp = 0u;
    for (;;) {
        sum = 0u; cnt = 0u; mine = 0u;
#pragma unroll
        for (unsigned j = 0; j < 16; ++j) { const unsigned c = xb_ld(&bar[XB_XCNT(j)]); sum += c; cnt += (c > 0u) ? 1u : 0u; mine = (j == x) ? c : mine; }
        if (sum == G) break;
        __builtin_amdgcn_s_sleep(1);
        if ((++sp & 255u) == 0u) { if (xb_ld(&bar[XB_TMO])) break; if (sp > XB_SPIN_CAP) { atomicAdd(&bar[XB_TMO], 1u); break; } }
    }
    nloc = mine > 0u ? mine : 1u; nx = cnt > 0u ? cnt : 1u;
}
__device__ __forceinline__ void xcd_barrier(const XcdBarrier& b) {
    asm volatile("s_waitcnt vmcnt(0)" ::: "memory");
    __syncthreads();
    if (threadIdx.x == 0) {
        unsigned* bar = b.bar;
        __builtin_amdgcn_s_waitcnt(0);
        unsigned nloc = b.st[0], nx = b.st[1];
        if (nloc == 0u) { xcd_barrier_complete(bar, b.x, nloc, nx); b.st[0] = nloc; b.st[1] = nx; }
        const unsigned old = xb_add(&bar[XB_XSUB(b.x)], 1u);
        const unsigned gen = old / nloc;
        if (old + 1u == (gen + 1u) * nloc) {
            __builtin_amdgcn_fence(__ATOMIC_RELEASE, "agent");
            asm volatile("s_waitcnt vmcnt(0)" ::: "memory");
            const unsigned og = xb_add(&bar[XB_TOP], 1u);
            const unsigned tg = og / nx;
            if (og + 1u == (tg + 1u) * nx) xb_add(&bar[XB_TOPGEN], 1u);
            else XB_SPIN(xb_ld(&bar[XB_TOPGEN]) == tg, bar);
            __builtin_amdgcn_fence(__ATOMIC_ACQUIRE, "agent");
            xb_add(&bar[XB_XGEN(b.x)], 1u);
            asm volatile("s_waitcnt vmcnt(0)" ::: "memory");
        } else {
            XB_SPIN(xb_ld(&bar[XB_XGEN(b.x)]) == gen, bar);
            __builtin_amdgcn_fence(__ATOMIC_ACQUIRE, "agent");
            asm volatile("s_waitcnt vmcnt(0)" ::: "memory");
        }
    }
    __syncthreads();
}

namespace pg8 {
constexpr int BM = 256, BK = 64, HALF = 128, HTB = HALF * BK * 2, STAGE_BYTES = 8 * HTB;
__host__ __device__ __forceinline__ int lds_byte(int r, int c) { const int st = (r >> 4) * 2 + (c >> 5), rr = r & 15, cc = c & 31, ob = rr * 64 + cc * 2; return st * 1024 + (ob ^ (((ob >> 9) & 1) << 5)); }
__host__ __device__ __forceinline__ void stage_rc(int b, int& R, int& C) { const int st = b / 1024, sb = b % 1024, swz = sb ^ (((sb >> 9) & 1) << 5); R = (st >> 1) * 16 + swz / 64; C = (st & 1) * 32 + (swz % 64) / 2; }
__host__ __device__ __forceinline__ int perm32(int rho) { const int n = rho >> 4, i = rho & 15; return 8 * (i >> 2) + 4 * n + (i & 3); }
struct Unit { int pm, pn, ex; };

template <class Epi, class Sched>
__device__ __forceinline__ void gemm_phase(LAS unsigned char* lds, const char* Abase, const unsigned lda2, const unsigned ldb2, const int K, const Sched& S, const Epi& E) {
    int tid_ = threadIdx.x; asm volatile("" : "+v"(tid_));
    const int tid = tid_, wid = __builtin_amdgcn_readfirstlane(tid >> 6), lane = tid & 63, wr = wid >> 2, wc = wid & 3, fr = lane & 15, fq = lane >> 4;
    const int nt = K / BK;
    int Rr[2]; unsigned Cc[2], voffB[2];
#pragma unroll
    for (int i = 0; i < 2; ++i) { int R, C; stage_rc(tid * 16 + i * 8192, R, C); const int Rb = Epi::PERM ? ((R & ~31) + perm32(R & 31)) : R;
        Rr[i] = R; Cc[i] = (unsigned)C * 2u; voffB[i] = (unsigned)Rb * ldb2 + (unsigned)C * 2u; }
    const size_t kstep = (size_t)(BK * 2);
    const size_t hstepB = (size_t)HALF * ldb2;
    const unsigned ldsw = (unsigned)wid * 1024u;
    const int aoff = lds_byte(wr * 64 + fr, fq * 8), boff = lds_byte(wc * 32 + fr, fq * 8);
#define PG8_SA(b, h) (((b) * 2 + (h)) * HTB)
#define PG8_SB(b, h) ((4 + (b) * 2 + (h)) * HTB)
#define PG8_STAGE_A(bufoff, kptr, V) do { _Pragma("unroll") for (int _i = 0; _i < 2; ++_i) \
        __builtin_amdgcn_global_load_lds((const unsigned*)((const char*)(kptr) + (V)[_i]), (LAS unsigned*)(lds + (bufoff) + ldsw + _i * 8192), 16, 0, 0); } while (0)
#define PG8_STAGE_B(bufoff, gbase) do { _Pragma("unroll") for (int _i = 0; _i < 2; ++_i) \
        __builtin_amdgcn_global_load_lds((const unsigned*)((const char*)(gbase) + voffB[_i]), (LAS unsigned*)(lds + (bufoff) + ldsw + _i * 8192), 16, 0, 0); } while (0)
#define PG8_LDA(dst, b, h) do { _Pragma("unroll") for (int m = 0; m < 4; ++m) _Pragma("unroll") for (int k = 0; k < 2; ++k) dst[m][k] = *(const LAS bf16x8*)(lds + PG8_SA(b, h) + aoff + m * 2048 + k * 1024); } while (0)
#define PG8_LDB(dst, b, h) do { _Pragma("unroll") for (int n = 0; n < 2; ++n) _Pragma("unroll") for (int k = 0; k < 2; ++k) dst[n][k] = *(const LAS bf16x8*)(lds + PG8_SB(b, h) + boff + n * 2048 + k * 1024); } while (0)
#define PG8_MMA(ai, bj, At, Bt) do { __builtin_amdgcn_s_setprio(1); _Pragma("unroll") for (int m = 0; m < 4; ++m) _Pragma("unroll") for (int n = 0; n < 2; ++n) _Pragma("unroll") for (int k = 0; k < 2; ++k) \
        acc[ai][bj][m][n] = __builtin_amdgcn_mfma_f32_16x16x32_bf16(Bt[n][k], At[m][k], acc[ai][bj][m][n], 0, 0, 0); __builtin_amdgcn_s_setprio(0); } while (0)
#define PG8_WAIT_V(n) asm volatile("s_waitcnt vmcnt(" #n ")" ::: "memory")
#define PG8_WAIT_L(n) asm volatile("s_waitcnt lgkmcnt(" #n ")" ::: "memory")
#define PG8_BAR __builtin_amdgcn_s_barrier()
#define PG8_SCHED __builtin_amdgcn_sched_barrier(0)
#define PG8_FILLA(dst, u) do { const unsigned ko_ = S.akoff(u); _Pragma("unroll") for (int h_ = 0; h_ < 2; ++h_) _Pragma("unroll") for (int i_ = 0; i_ < 2; ++i_) \
        dst[h_][i_] = (unsigned)S.arow(u, h_ * 128 + Rr[i_]) * lda2 + Cc[i_] + ko_; } while (0)
    Unit cur, nxt; int ui = 0;
    if (!S.next(0, cur)) return;
    f32x4 acc[2][2][4][2];
#pragma unroll
    for (int a = 0; a < 2; ++a)
#pragma unroll
        for (int b = 0; b < 2; ++b)
#pragma unroll
            for (int m = 0; m < 4; ++m)
#pragma unroll
                for (int n = 0; n < 2; ++n) acc[a][b][m][n] = (f32x4){0.f, 0.f, 0.f, 0.f};
    bf16x8 At[4][2], B0[2][2], B1[2][2];
    unsigned vA[2][2], nvA[2][2];
    PG8_FILLA(vA, cur);
    const char* cB = S.bptr(cur);
    constexpr bool HN = Epi::HALFN;
    if constexpr (HN) {
        PG8_STAGE_B(PG8_SB(0, 0), cB); PG8_STAGE_A(PG8_SA(0, 0), Abase, vA[0]); PG8_STAGE_A(PG8_SA(0, 1), Abase, vA[1]);
        if (wr == 1) PG8_BAR;
        PG8_WAIT_V(2); PG8_BAR;
        PG8_STAGE_B(PG8_SB(1, 0), cB + kstep); PG8_STAGE_A(PG8_SA(1, 0), Abase + kstep, vA[0]);
        PG8_WAIT_V(4); PG8_BAR;
    } else {
    PG8_STAGE_B(PG8_SB(0, 0), cB); PG8_STAGE_B(PG8_SB(0, 1), cB + hstepB); PG8_STAGE_A(PG8_SA(0, 0), Abase, vA[0]); PG8_STAGE_A(PG8_SA(0, 1), Abase, vA[1]);
    if (wr == 1) PG8_BAR;
    PG8_WAIT_V(2); PG8_BAR;
    PG8_STAGE_B(PG8_SB(1, 0), cB + kstep); PG8_STAGE_A(PG8_SA(1, 0), Abase + kstep, vA[0]); PG8_STAGE_B(PG8_SB(1, 1), cB + hstepB + kstep);
    PG8_WAIT_V(6); PG8_BAR;
    }
    for (;;) {
        const bool has_next = S.next(ui + 1, nxt);
        const char* nB = cB;
        if (has_next) { PG8_FILLA(nvA, nxt); nB = S.bptr(nxt); }
        else {
#pragma unroll
            for (int h = 0; h < 2; ++h)
#pragma unroll
                for (int i = 0; i < 2; ++i) nvA[h][i] = vA[h][i];
        }
        for (int t = 0; t < nt; t += 2) {
            const bool last = (t == nt - 2);
            const char* a1k = Abase + (size_t)(t + 1) * kstep;
            const char* a2k = last ? Abase : Abase + (size_t)(t + 2) * kstep; const char* b2 = last ? nB : cB + (size_t)(t + 2) * kstep;
            const char* a3k = a2k + kstep; const char* b3 = b2 + kstep;
            unsigned s0[2], s1[2];
#pragma unroll
            for (int i = 0; i < 2; ++i) { s0[i] = last ? nvA[0][i] : vA[0][i]; s1[i] = last ? nvA[1][i] : vA[1][i]; }
            if constexpr (HN) {
            PG8_LDB(B0, 0, 0); PG8_SCHED; PG8_LDA(At, 0, 0); PG8_STAGE_A(PG8_SA(1, 1), a1k, vA[1]);
            PG8_WAIT_V(6); PG8_WAIT_L(0); PG8_BAR; PG8_MMA(0, 0, At, B0); PG8_BAR; PG8_SCHED;
            PG8_LDA(At, 0, 1); PG8_STAGE_B(PG8_SB(0, 0), b2); PG8_STAGE_A(PG8_SA(0, 0), a2k, s0);
            PG8_WAIT_V(6); PG8_WAIT_L(0); PG8_BAR; PG8_MMA(1, 0, At, B0); PG8_BAR; PG8_SCHED;
            PG8_LDB(B0, 1, 0); PG8_SCHED; PG8_LDA(At, 1, 0); PG8_STAGE_A(PG8_SA(0, 1), a2k, s1);
            PG8_WAIT_V(6); PG8_WAIT_L(0); PG8_BAR; PG8_MMA(0, 0, At, B0); PG8_BAR; PG8_SCHED;
            PG8_LDA(At, 1, 1); PG8_STAGE_B(PG8_SB(1, 0), b3); PG8_STAGE_A(PG8_SA(1, 0), a3k, s0);
            PG8_WAIT_V(6); PG8_WAIT_L(0); PG8_BAR; PG8_MMA(1, 0, At, B0); PG8_BAR; PG8_SCHED;
            } else {
            PG8_LDB(B0, 0, 0); PG8_LDB(B1, 0, 1); PG8_SCHED; PG8_LDA(At, 0, 0); PG8_STAGE_A(PG8_SA(1, 1), a1k, vA[1]);
            PG8_WAIT_V(8); PG8_WAIT_L(0); PG8_BAR; PG8_MMA(0, 0, At, B0); PG8_MMA(0, 1, At, B1); PG8_BAR; PG8_SCHED;
            PG8_LDA(At, 0, 1); PG8_STAGE_B(PG8_SB(0, 0), b2); PG8_STAGE_B(PG8_SB(0, 1), b2 + hstepB); PG8_STAGE_A(PG8_SA(0, 0), a2k, s0);
            PG8_WAIT_V(8); PG8_WAIT_L(0); PG8_BAR; PG8_MMA(1, 0, At, B0); PG8_MMA(1, 1, At, B1); PG8_BAR; PG8_SCHED;
            PG8_LDB(B0, 1, 0); PG8_LDB(B1, 1, 1); PG8_SCHED; PG8_LDA(At, 1, 0); PG8_STAGE_A(PG8_SA(0, 1), a2k, s1);
            PG8_WAIT_V(8); PG8_WAIT_L(0); PG8_BAR; PG8_MMA(0, 0, At, B0); PG8_MMA(0, 1, At, B1); PG8_BAR; PG8_SCHED;
            PG8_LDA(At, 1, 1); PG8_STAGE_B(PG8_SB(1, 0), b3); PG8_STAGE_B(PG8_SB(1, 1), b3 + hstepB); PG8_STAGE_A(PG8_SA(1, 0), a3k, s0);
            PG8_WAIT_V(8); PG8_WAIT_L(0); PG8_BAR; PG8_MMA(1, 0, At, B0); PG8_MMA(1, 1, At, B1); PG8_BAR; PG8_SCHED;
            }
        }
        if (wr == 0) PG8_BAR;
        E(acc, cur, wr, wc, fr, fq);
        if (!has_next) break;
#pragma unroll
        for (int a = 0; a < 2; ++a)
#pragma unroll
            for (int b = 0; b < 2; ++b)
#pragma unroll
                for (int m = 0; m < 4; ++m)
#pragma unroll
                    for (int n = 0; n < 2; ++n) acc[a][b][m][n] = (f32x4){0.f, 0.f, 0.f, 0.f};
        cur = nxt; cB = nB; ++ui;
#pragma unroll
        for (int h = 0; h < 2; ++h)
#pragma unroll
            for (int i = 0; i < 2; ++i) vA[h][i] = nvA[h][i];
        if (wr == 1) PG8_BAR;
    }
    PG8_WAIT_V(0);
    PG8_BAR;
#undef PG8_SA
#undef PG8_SB
#undef PG8_STAGE_A
#undef PG8_STAGE_B
#undef PG8_LDA
#undef PG8_LDB
#undef PG8_MMA
#undef PG8_WAIT_V
#undef PG8_WAIT_L
#undef PG8_BAR
#undef PG8_SCHED
#undef PG8_FILLA
}

struct DenseSched {
    int nM, nN, nwg, G, c; const char* Bt; unsigned ldb2; int kmul;
    __device__ __forceinline__ bool next(int i, Unit& u) const {
        const long L = (long)i * G + c; if (L >= nwg) return false;
        int wgid = (int)L; { const int q = nwg / 8, r = nwg % 8, xcd = wgid % 8, off = wgid / 8; wgid = (xcd < r ? xcd * (q + 1) : r * (q + 1) + (xcd - r) * q) + off; }
        const int nig = 8 * nN, gid = wgid / nig, fm = gid * 8, gsz = (nM - fm) < 8 ? (nM - fm) : 8;
        u.pm = fm + ((wgid % nig) % gsz); u.pn = (wgid % nig) / gsz; u.ex = 0; return true;
    }
    __device__ __forceinline__ int arow(const Unit& u, int r) const { return u.pm * 256 + r; }
    __device__ __forceinline__ unsigned akoff(const Unit& u) const { return (unsigned)((u.pn >> 2) * kmul); }
    __device__ __forceinline__ const char* bptr(const Unit& u) const { return Bt + (size_t)u.pn * 256 * ldb2; }
};
struct BranchSched {
    int nM, nwg, G, c; const char* Bt;
    __device__ __forceinline__ bool next(int i, Unit& u) const {
        const long L = (long)(i >> 2) * G + c; if (L >= nwg) return false;
        int wgid = (int)L; { const int q = nwg / 8, r = nwg % 8, xcd = wgid % 8, off = wgid / 8; wgid = (xcd < r ? xcd * (q + 1) : r * (q + 1) + (xcd - r) * q) + off; }
        const int nig = 8 * 4, gid = wgid / nig, fm = gid * 8, gsz = (nM - fm) < 8 ? (nM - fm) : 8;
        u.pm = fm + ((wgid % nig) % gsz); u.pn = (i & 3) * 4 + (wgid % nig) / gsz; u.ex = 0; return true;
    }
    __device__ __forceinline__ int arow(const Unit& u, int r) const { return u.pm * 256 + r; }
    __device__ __forceinline__ unsigned akoff(const Unit& u) const { return (unsigned)((u.pn >> 2) * 512); }
    __device__ __forceinline__ const char* bptr(const Unit& u) const { return Bt + (size_t)u.pn * 256 * 512; }
};
struct BranchSchedH {
    int nM, nwg, G, c; const char* Bt;
    __device__ __forceinline__ bool next(int i, Unit& u) const {
        const long L = (long)(i >> 2) * G + c; if (L >= nwg) return false;
        int wgid = (int)L; { const int q = nwg / 8, r = nwg % 8, xcd = wgid % 8, off = wgid / 8; wgid = (xcd < r ? xcd * (q + 1) : r * (q + 1) + (xcd - r) * q) + off; }
        const int nig = 8 * 8, gid = wgid / nig, fm = gid * 8, gsz = (nM - fm) < 8 ? (nM - fm) : 8;
        u.pm = fm + ((wgid % nig) % gsz); u.pn = (wgid % nig) / gsz; u.ex = i & 3; return true;
    }
    __device__ __forceinline__ int arow(const Unit& u, int r) const { return u.pm * 256 + r; }
    __device__ __forceinline__ unsigned akoff(const Unit& u) const { return (unsigned)(u.ex * 512); }
    __device__ __forceinline__ const char* bptr(const Unit& u) const { return Bt + (size_t)(u.ex * 1024 + u.pn * 128) * 512; }
};
struct EpiBranchH {
    static constexpr bool PERM = true, HALFN = true;
    const bf16_t* Gt; bf16_t* SUMB; mutable f32x4 S[2][4][2];
    __device__ __forceinline__ void operator()(const f32x4 (&acc)[2][2][4][2], const Unit& u, int wr, int wc, int fr, int fq) const {
        const int row0 = u.pm * BM + wr * 64 + fr, scol0 = u.pn * 128 + wc * 32 + 8 * fq, gcol0 = u.ex * 1024 + scol0;
        const bool first = u.ex == 0, lastb = u.ex == 3; const int tid_ = (wr * 4 + wc) * 64 + fq * 16 + fr; (void)gcol0;
#pragma unroll
        for (int ai = 0; ai < 2; ++ai)
#pragma unroll
            for (int m = 0; m < 4; ++m) { const size_t row = (size_t)(row0 + ai * HALF + m * 16);
                const u32x4 g = *(const u32x4*)(Gt + ((((size_t)u.pm * 32 + (u.ex * 8 + u.pn)) * 8 + (ai * 4 + m)) * 512 + tid_) * 8);
                const f32x4 v0 = acc[ai][0][m][0], v1 = acc[ai][0][m][1];
                f32x4 s0 = (f32x4){v0[0] * bflo(g.x), v0[1] * bfhi(g.x), v0[2] * bflo(g.y), v0[3] * bfhi(g.y)};
                f32x4 s1 = (f32x4){v1[0] * bflo(g.z), v1[1] * bfhi(g.z), v1[2] * bflo(g.w), v1[3] * bfhi(g.w)};
                if (!first) { s0 += S[ai][m][0]; s1 += S[ai][m][1]; }
                S[ai][m][0] = s0; S[ai][m][1] = s1;
                if (lastb) { u32x4 w; w.x = cvtpk(s0[0], s0[1]); w.y = cvtpk(s0[2], s0[3]); w.z = cvtpk(s1[0], s1[1]); w.w = cvtpk(s1[2], s1[3]);
                    *(u32x4*)(SUMB + row * DM + scol0) = w; } }
    }
};
struct MoeSched {
    int G, c, npn, gather; const LAS int* tb; const int* tokmap; const char* Bt; size_t bexp; unsigned ldb2; int zrow;
    __device__ __forceinline__ bool next(int i, Unit& u) const {
        const int ntl = tb[32];
        int tile, pn;
        if ((G & 7) == 0 && (G >> 3) % npn == 0) {
            const int x = c & 7, j = c >> 3, tpr = (G >> 3) / npn;
            tile = (i * tpr + j / npn) * 8 + x; pn = j % npn;
            if (tile >= ntl) return false;
        } else { const int idx = i * G + c; if (idx >= ntl * npn) return false; tile = idx / npn; pn = idx - tile * npn; }
        u.pm = tile; u.pn = pn;
        int e = 0;
#pragma unroll 1
        for (int k = 1; k < 32; ++k) e = (tb[k] <= tile) ? k : e;
        u.ex = e; return true;
    }
    __device__ __forceinline__ int arow(const Unit& u, int r) const {
        if (!gather) return u.pm * 256 + r;
        const int p = (u.pm - tb[u.ex]) * 256 + r;
        return (p < tb[64 + u.ex]) ? tokmap[(size_t)u.ex * ECAP + p] : zrow;
    }
    __device__ __forceinline__ unsigned akoff(const Unit&) const { return 0u; }
    __device__ __forceinline__ const char* bptr(const Unit& u) const { return Bt + (size_t)u.ex * bexp + (size_t)u.pn * 256 * ldb2; }
};

__device__ __forceinline__ float sigmoidf_(float v) { return __builtin_amdgcn_rcpf(1.0f + __builtin_amdgcn_exp2f(-v * LOG2E)); }

struct EpiIn {
    static constexpr bool PERM = true, HALFN = false;
    bf16_t* QKV; bf16_t* Gt; const float* bgate;
    __device__ __forceinline__ void operator()(const f32x4 (&acc)[2][2][4][2], const Unit& u, int wr, int wc, int fr, int fq) const {
        const int row0 = u.pm * BM + wr * 64 + fr;
        const bool isg = u.pn >= 10;
        const int colt = isg ? (u.pn - 10) * 256 : u.pn * 256, ldc = isg ? NGATE : NQKV;
        bf16_t* base = isg ? Gt : QKV;
        const int col0 = colt + wc * 32 + 8 * fq;
        f32x4 bv[2][2];
#pragma unroll
        for (int bj = 0; bj < 2; ++bj)
#pragma unroll
            for (int n = 0; n < 2; ++n) bv[bj][n] = isg ? *(const f32x4*)(bgate + col0 + bj * HALF + 4 * n) : (f32x4){0.f, 0.f, 0.f, 0.f};
#pragma unroll
        for (int ai = 0; ai < 2; ++ai)
#pragma unroll
            for (int m = 0; m < 4; ++m) { bf16_t* rowp = base + (size_t)(row0 + ai * HALF + m * 16) * ldc + col0;
#pragma unroll
                for (int bj = 0; bj < 2; ++bj) { f32x4 v0 = acc[ai][bj][m][0] + bv[bj][0], v1 = acc[ai][bj][m][1] + bv[bj][1];
                    if (isg) {
#pragma unroll
                        for (int q = 0; q < 4; ++q) { v0[q] = sigmoidf_(v0[q]); v1[q] = sigmoidf_(v1[q]); } }
                    u32x4 w; w.x = cvtpk(v0[0], v0[1]); w.y = cvtpk(v0[2], v0[3]); w.z = cvtpk(v1[0], v1[1]); w.w = cvtpk(v1[2], v1[3]);
                    if (isg) { const int tid_ = (wr * 4 + wc) * 64 + fq * 16 + fr, ch = (u.pn - 10) * 2 + bj;
                        *(u32x4*)(Gt + ((((size_t)u.pm * 32 + ch) * 8 + (ai * 4 + m)) * 512 + tid_) * 8) = w; }
                    else *(u32x4*)(rowp + bj * HALF) = w; } }
    }
};
struct EpiBranch {
    static constexpr bool PERM = true, HALFN = false;
    const bf16_t* Gt; bf16_t* SUMB;
    __device__ __forceinline__ void operator()(const f32x4 (&acc)[2][2][4][2], const Unit& u, int wr, int wc, int fr, int fq) const {
        const int row0 = u.pm * BM + wr * 64 + fr, col0 = u.pn * 256 + wc * 32 + 8 * fq, scol0 = (u.pn & 3) * 256 + wc * 32 + 8 * fq;
        const bool first = (u.pn >> 2) == 0;
#pragma unroll
        for (int ai = 0; ai < 2; ++ai)
#pragma unroll
            for (int m = 0; m < 4; ++m) { const bf16_t* rowp = Gt + (size_t)(row0 + ai * HALF + m * 16) * NGATE + col0; bf16_t* outp = SUMB + (size_t)(row0 + ai * HALF + m * 16) * DM + scol0;
#pragma unroll
                for (int bj = 0; bj < 2; ++bj) { const u32x4 g = *(const u32x4*)(rowp + bj * HALF);
                    u32x4 so = (u32x4){0u, 0u, 0u, 0u}; if (!first) so = *(const u32x4*)(outp + bj * HALF);
                    const f32x4 v0 = acc[ai][bj][m][0], v1 = acc[ai][bj][m][1];
                    u32x4 w; w.x = cvtpk(v0[0] * bflo(g.x) + bflo(so.x), v0[1] * bfhi(g.x) + bfhi(so.x)); w.y = cvtpk(v0[2] * bflo(g.y) + bflo(so.y), v0[3] * bfhi(g.y) + bfhi(so.y));
                    w.z = cvtpk(v1[0] * bflo(g.z) + bflo(so.z), v1[1] * bfhi(g.z) + bfhi(so.z)); w.w = cvtpk(v1[2] * bflo(g.w) + bflo(so.w), v1[3] * bfhi(g.w) + bfhi(so.w));
                    *(u32x4*)(outp + bj * HALF) = w; } }
    }
};
struct EpiOut {
    static constexpr bool PERM = true, HALFN = false;
    const float* x0; const float* c0; bf16_t* XRB; const float* mod; int layer;
    __device__ __forceinline__ void operator()(const f32x4 (&acc)[2][2][4][2], const Unit& u, int wr, int wc, int fr, int fq) const {
        const int rt = u.pm * BM;
        const int ridx = rt < TL ? (rt >> 13) : 4;
        const float* srcf = rt < TL ? x0 + (size_t)rt * DM : c0 + (size_t)(rt - TL) * DM;
        bf16_t* dst = XRB + (size_t)rt * DM;
        const float* g1 = mod + ridx * 6144 + 2 * 1024;
        const int col0 = u.pn * BM + wc * 32 + 8 * fq;
#pragma unroll
        for (int ai = 0; ai < 2; ++ai)
#pragma unroll
            for (int m = 0; m < 4; ++m) { const size_t off = (size_t)(ai * HALF + wr * 64 + m * 16 + fr) * DM + col0;
#pragma unroll
                for (int bj = 0; bj < 2; ++bj) { const int cc = bj * HALF;
                    const f32x4 ga = *(const f32x4*)(g1 + col0 + cc), gb = *(const f32x4*)(g1 + col0 + cc + 4);
                    f32x4 xa, xb;
                    if (layer) { const u32x4 xx = *(const u32x4*)(dst + off + cc); xa = (f32x4){bflo(xx.x), bfhi(xx.x), bflo(xx.y), bfhi(xx.y)}; xb = (f32x4){bflo(xx.z), bfhi(xx.z), bflo(xx.w), bfhi(xx.w)}; }
                    else { xa = *(const f32x4*)(srcf + off + cc); xb = *(const f32x4*)(srcf + off + cc + 4); }
                    const f32x4 ra = xa + ga * acc[ai][bj][m][0], rb = xb + gb * acc[ai][bj][m][1];
                    u32x4 w; w.x = cvtpk(ra[0], ra[1]); w.y = cvtpk(ra[2], ra[3]); w.z = cvtpk(rb[0], rb[1]); w.w = cvtpk(rb[2], rb[3]);
                    *(u32x4*)(dst + off + cc) = w; } }
    }
};
struct EpiSwiglu {
    static constexpr bool PERM = true, HALFN = false;
    bf16_t* ACT; const float* bgu;
    __device__ __forceinline__ void operator()(const f32x4 (&acc)[2][2][4][2], const Unit& u, int wr, int wc, int fr, int fq) const {
        const int row0 = u.pm * BM + wr * 64 + fr, j0 = u.pn * 128 + wc * 32 + 8 * fq;
        const float* bg = bgu + (size_t)u.ex * 2048 + j0;
        f32x4 bgv[2], buv[2];
#pragma unroll
        for (int n = 0; n < 2; ++n) { bgv[n] = *(const f32x4*)(bg + 4 * n); buv[n] = *(const f32x4*)(bg + 1024 + 4 * n); }
#pragma unroll
        for (int ai = 0; ai < 2; ++ai)
#pragma unroll
            for (int m = 0; m < 4; ++m) { bf16_t* rowp = ACT + (size_t)(row0 + ai * HALF + m * 16) * DM + j0;
                float o[8];
#pragma unroll
                for (int n = 0; n < 2; ++n)
#pragma unroll
                    for (int q = 0; q < 4; ++q) { float g = acc[ai][0][m][n][q] + bgv[n][q], up = acc[ai][1][m][n][q] + buv[n][q];
                        g = fminf(g, 7.0f); up = fminf(fmaxf(up, -7.0f), 7.0f);
                        o[n * 4 + q] = g * sigmoidf_(1.702f * g) * (up + 1.0f); }
                u32x4 w; w.x = cvtpk(o[0], o[1]); w.y = cvtpk(o[2], o[3]); w.z = cvtpk(o[4], o[5]); w.w = cvtpk(o[6], o[7]);
                *(u32x4*)rowp = w; }
    }
};
struct EpiDown {
    static constexpr bool PERM = true, HALFN = false;
    bf16_t* Y; const float* bd;
    __device__ __forceinline__ void operator()(const f32x4 (&acc)[2][2][4][2], const Unit& u, int wr, int wc, int fr, int fq) const {
        const int row0 = u.pm * BM + wr * 64 + fr, col0 = u.pn * 256 + wc * 32 + 8 * fq;
        const float* bp = bd + (size_t)u.ex * 1024 + col0;
        f32x4 bv[2][2];
#pragma unroll
        for (int bj = 0; bj < 2; ++bj)
#pragma unroll
            for (int n = 0; n < 2; ++n) bv[bj][n] = *(const f32x4*)(bp + bj * HALF + 4 * n);
#pragma unroll
        for (int ai = 0; ai < 2; ++ai)
#pragma unroll
            for (int m = 0; m < 4; ++m) { bf16_t* rowp = Y + (size_t)(row0 + ai * HALF + m * 16) * DM + col0;
#pragma unroll
                for (int bj = 0; bj < 2; ++bj) { const f32x4 v0 = acc[ai][bj][m][0] + bv[bj][0], v1 = acc[ai][bj][m][1] + bv[bj][1];
                    u32x4 w; w.x = cvtpk(v0[0], v0[1]); w.y = cvtpk(v0[2], v0[3]); w.z = cvtpk(v1[0], v1[1]); w.w = cvtpk(v1[2], v1[3]);
                    *(u32x4*)(rowp + bj * HALF) = w; } }
    }
};
}

namespace att {
constexpr int SLOTB = 8192, LDS_K = 0, LDS_V = 3 * SLOTB, LDS_BIAS = 7 * SLOTB, LDS_Q = 7 * SLOTB + 2048;
__device__ __forceinline__ int crow(int r, int hi) { return (r & 3) + 8 * (r >> 2) + 4 * hi; }
__device__ __forceinline__ void glds16(const void* gsrc, unsigned lds_dst) { unsigned keep;
    asm volatile("s_mov_b32 %0, m0\n\ts_mov_b32 m0, %2\n\ts_nop 0\n\tglobal_load_lds_dwordx4 %1, off\n\ts_mov_b32 m0, %0" : "=&s"(keep) : "v"(gsrc), "s"(lds_dst) : "memory"); }
typedef LAS const char* lds_cptr;
typedef short v4i16_t __attribute__((ext_vector_type(4)));
__device__ __forceinline__ s16x4 vtr(lds_cptr p) { return __builtin_bit_cast(s16x4, __builtin_amdgcn_ds_read_tr16_b64_v4i16((LAS v4i16_t*)p)); }
#define ATT_WAIT_BAR(N) do { __builtin_amdgcn_sched_barrier(0); asm volatile("s_waitcnt vmcnt(" #N ") lgkmcnt(0)\n\ts_barrier" ::: "memory"); __builtin_amdgcn_sched_barrier(0); } while (0)
#define ATT_BAR() do { __builtin_amdgcn_sched_barrier(0); asm volatile("s_waitcnt lgkmcnt(0)\n\ts_barrier" ::: "memory"); __builtin_amdgcn_sched_barrier(0); } while (0)
#define ATT_MFMA(a, b, c) __builtin_amdgcn_mfma_f32_32x32x16_bf16(a, b, c, 0, 0, 0)

struct UnitP {
    int qrow0;
    int qcol, kcol, vcol, ocol;
    int locrow0, nloc;
    int ctxrow0;
    int qpos0;
    int kpos0;
    float linit;
    float lam, outscale;
    const float* subln;
    const float* qgain;
    const f32x2* rope;
};

template <int MODE>
__device__ __forceinline__ void attn_unit(LAS unsigned char* shm, const bf16_t* __restrict__ QKV, bf16_t* BR, const UnitP& P) {
    int tid_ = threadIdx.x; asm volatile("" : "+v"(tid_));
    const int tid = tid_, lane = tid & 63, r32 = lane & 31, hi = lane >> 5; const int wid = __builtin_amdgcn_readfirstlane(tid >> 6);
    const int grp = wid >> 2;
    const unsigned lds0 = (unsigned)(uintptr_t)shm;
    const char* kbase = (const char*)QKV + (size_t)P.kcol * 2 + wid * 16 + (size_t)lane * (NQKV * 2);
    const char* vbase = (const char*)QKV + (size_t)P.vcol * 2 + ((wid >> 2) * 32 + (lane & 3) * 8) * 2 + (size_t)(16 * (wid & 3) + (lane >> 2)) * (NQKV * 2);
    const unsigned kdst = lds0 + LDS_K + wid * 1024, vdst = lds0 + LDS_V + wid * 1024;
    const int nloc = P.nloc, NT = nloc + 4;
#define ATT_TROW(t) ((t) < nloc ? P.locrow0 + 64 * (t) : P.ctxrow0 + 64 * ((t) - nloc))
#define ATT_DMA(t, ks, vs) do { const size_t ro_ = (size_t)ATT_TROW(t) * (NQKV * 2); \
        glds16(kbase + ro_, (unsigned)__builtin_amdgcn_readfirstlane(kdst + (ks) * SLOTB)); glds16(vbase + ro_, (unsigned)__builtin_amdgcn_readfirstlane(vdst + (vs) * SLOTB)); } while (0)
    ATT_DMA(0, 0, 0); ATT_DMA(1, 1, 1);
    bf16x8 qr[4];
    LAS bf16x8* qlds = (LAS bf16x8*)(shm + LDS_Q + wid * 4096) + lane;
    {
      const bf16_t* Qw = QKV + (size_t)(P.qrow0 + r32) * NQKV + P.qcol + hi * 8;
      u32x4 raw[4];
#pragma unroll
      for (int d0 = 0; d0 < 4; ++d0) raw[d0] = *reinterpret_cast<const u32x4*>(Qw + d0 * 16);
      float x[4][8];
#pragma unroll
      for (int d0 = 0; d0 < 4; ++d0) { x[d0][0] = bflo(raw[d0].x); x[d0][1] = bfhi(raw[d0].x); x[d0][2] = bflo(raw[d0].y); x[d0][3] = bfhi(raw[d0].y);
          x[d0][4] = bflo(raw[d0].z); x[d0][5] = bfhi(raw[d0].z); x[d0][6] = bflo(raw[d0].w); x[d0][7] = bfhi(raw[d0].w); }
      const f32x2* rt = P.rope ? P.rope + (size_t)(P.qpos0 + r32) * 48 : nullptr;
      if (MODE == 1) {
#pragma unroll
          for (int c = 0; c < 2; ++c) { float ss = 0.f;
#pragma unroll
              for (int dd = 0; dd < 2; ++dd)
#pragma unroll
                  for (int e = 0; e < 8; ++e) ss += x[2 * c + dd][e] * x[2 * c + dd][e];
              ss += shx(ss, 32, lane);
              const float rs = __builtin_amdgcn_rsqf(ss * (1.0f / 32.0f) + EPSN);
#pragma unroll
              for (int dd = 0; dd < 2; ++dd)
#pragma unroll
                  for (int e = 0; e < 8; ++e) x[2 * c + dd][e] *= rs * P.qgain[16 * dd + 8 * hi + e];
              if (rt) {
#pragma unroll
                  for (int e = 0; e < 8; ++e) { const f32x2 cs = rt[32 + 8 * hi + e]; const float a = x[2 * c][e], b = x[2 * c + 1][e];
                      x[2 * c][e] = a * cs.x - b * cs.y; x[2 * c + 1][e] = a * cs.y + b * cs.x; } } }
      } else {
          float ss = 0.f;
#pragma unroll
          for (int d0 = 0; d0 < 4; ++d0)
#pragma unroll
              for (int e = 0; e < 8; ++e) ss += x[d0][e] * x[d0][e];
          ss += shx(ss, 32, lane);
          const float rs = __builtin_amdgcn_rsqf(ss * (1.0f / 64.0f) + EPSN);
#pragma unroll
          for (int d0 = 0; d0 < 4; ++d0)
#pragma unroll
              for (int e = 0; e < 8; ++e) x[d0][e] *= rs * P.qgain[16 * d0 + 8 * hi + e];
          if (rt) {
#pragma unroll
              for (int d0 = 0; d0 < 2; ++d0)
#pragma unroll
                  for (int e = 0; e < 8; ++e) { const f32x2 cs = rt[16 * d0 + 8 * hi + e]; const float a = x[d0][e], b = x[d0 + 2][e];
                      x[d0][e] = a * cs.x - b * cs.y; x[d0 + 2][e] = a * cs.y + b * cs.x; } }
      }
      const float qs = (MODE == 1 ? 0.17677669529663687f : 0.125f) * LOG2E;
#pragma unroll
      for (int d0 = 0; d0 < 4; ++d0) { u32x4 w; w.x = cvtpk(x[d0][0] * qs, x[d0][1] * qs); w.y = cvtpk(x[d0][2] * qs, x[d0][3] * qs); w.z = cvtpk(x[d0][4] * qs, x[d0][5] * qs); w.w = cvtpk(x[d0][6] * qs, x[d0][7] * qs);
          qr[d0] = __builtin_bit_cast(bf16x8, w); if (MODE == 1) qlds[d0 * 64] = qr[d0]; } }
    f32x16 o[2], o2[2]; o[0] = f32x16{}; o[1] = f32x16{}; o2[0] = f32x16{}; o2[1] = f32x16{};
    float l1 = (hi == 0) ? P.linit : 0.f, l2 = 0.f;
    f32x16 pa0 = f32x16{}, pa1 = f32x16{}, pb0 = f32x16{}, pb1 = f32x16{};
    u32x4 pw[4], pv2[4];
#pragma unroll
    for (int i = 0; i < 4; ++i) { pw[i] = (u32x4){0u, 0u, 0u, 0u}; pv2[i] = (u32x4){0u, 0u, 0u, 0u}; }
    const int qpos = P.qpos0 + r32;
    const int qrow_w = P.qpos0 >> 6, r0w = min(max(qrow_w - 4, 0), 120);
    const int qc = qpos & 63, c0q = min(max(qc - 8, 0), 48);
    const LAS float* biasT = (const LAS float*)(shm + LDS_BIAS);
    const lds_cptr kp0 = (lds_cptr)shm + LDS_K + hi * 1024 + r32 * 16;
    const lds_cptr vp0 = (lds_cptr)shm + LDS_V + ((lane >> 4) & 1) * 32 + (lane & 3) * 8 + (4 * hi + ((lane & 15) >> 2)) * 64;
#define ATT_ACTIVE(t) ( (MODE == 2 && (t) < nloc) ? ((P.kpos0 + 64 * (t) <= P.qpos0 + 31 + 128) && (P.kpos0 + 64 * (t) + 63 >= P.qpos0 - 128)) : \
                        (MODE == 3 && (t) < nloc) ? ((((P.kpos0 >> 6) + (t)) >= r0w) && (((P.kpos0 >> 6) + (t)) < r0w + 8)) : true )
#define ATT_SOFT(P0, P1, LS, PW, t) do { \
        if (MODE == 2 && (t) < nloc) { const int kb_ = P.kpos0 + 64 * (t) - qpos; \
            _Pragma("unroll") for (int r = 0; r < 16; ++r) { const int d = kb_ + crow(r, hi); \
                if (d > 128 || d < -128) P0[r] = -INFINITY; \
                if (d + 32 > 128 || d + 32 < -128) P1[r] = -INFINITY; } } \
        if (MODE == 3 && (t) < nloc) { const int kr_ = (P.kpos0 >> 6) + (t); const int rb_ = (kr_ - qrow_w + 7) * 31 + 15 - qc; \
            _Pragma("unroll") for (int r = 0; r < 16; ++r) { const int kc = crow(r, hi); \
                { const bool ok = (unsigned)(kc - c0q) < 16u; const float bz = biasT[ok ? rb_ + kc : 0]; P0[r] = ok ? P0[r] + bz : -INFINITY; } \
                { const bool ok = (unsigned)(kc + 32 - c0q) < 16u; const float bz = biasT[ok ? rb_ + kc + 32 : 0]; P1[r] = ok ? P1[r] + bz : -INFINITY; } } } \
        float s_ = 0.f; \
        _Pragma("unroll") for (int r = 0; r < 16; ++r) { P0[r] = __builtin_amdgcn_exp2f(P0[r]); P1[r] = __builtin_amdgcn_exp2f(P1[r]); s_ += P0[r] + P1[r]; } \
        LS += s_; \
        PW[0] = (u32x4){cvtpk(P0[0], P0[1]), cvtpk(P0[2], P0[3]), cvtpk(P0[4], P0[5]), cvtpk(P0[6], P0[7])}; \
        PW[1] = (u32x4){cvtpk(P0[8], P0[9]), cvtpk(P0[10], P0[11]), cvtpk(P0[12], P0[13]), cvtpk(P0[14], P0[15])}; \
        PW[2] = (u32x4){cvtpk(P1[0], P1[1]), cvtpk(P1[2], P1[3]), cvtpk(P1[4], P1[5]), cvtpk(P1[6], P1[7])}; \
        PW[3] = (u32x4){cvtpk(P1[8], P1[9]), cvtpk(P1[10], P1[11]), cvtpk(P1[12], P1[13]), cvtpk(P1[14], P1[15])}; } while (0)
#define ATT_S(t) do { if (ATT_ACTIVE(t)) { ATT_SOFT(pa0, pa1, l1, pw, t); if (MODE == 1) ATT_SOFT(pb0, pb1, l2, pv2, t); } } while (0)
#define ATT_PV(tp, vsp) do { if (MODE < 2 || ATT_ACTIVE(tp)) { const lds_cptr vp = vp0 + (vsp) * SLOTB; \
            _Pragma("unroll") for (int dh = 0; dh < 2; ++dh) { _Pragma("unroll") for (int ks = 0; ks < 4; ++ks) { \
                const s16x4 vl = vtr(vp + dh * 4096 + ks * 1024), vh = vtr(vp + dh * 4096 + ks * 1024 + 512); \
                const bf16x8 vf = (bf16x8){vl[0], vl[1], vl[2], vl[3], vh[0], vh[1], vh[2], vh[3]}; \
                o[dh] = ATT_MFMA(vf, __builtin_bit_cast(bf16x8, pw[ks]), o[dh]); \
                if (MODE == 1) o2[dh] = ATT_MFMA(vf, __builtin_bit_cast(bf16x8, pv2[ks]), o2[dh]); } \
                } } \
        } while (0)
#define ATT_QK(t, ksc) do { if (MODE < 2 || ATT_ACTIVE(t)) { const lds_cptr kp = kp0 + (ksc) * SLOTB; \
            if (MODE == 1) { \
                _Pragma("unroll") for (int d0 = 0; d0 < 2; ++d0) { const bf16x8 k0 = *(const LAS bf16x8*)(kp + d0 * 2048), k1 = *(const LAS bf16x8*)(kp + d0 * 2048 + 512); const bf16x8 qf = qlds[d0 * 64]; \
                    pa0 = ATT_MFMA(k0, qf, d0 == 0 ? f32x16{} : pa0); pa1 = ATT_MFMA(k1, qf, d0 == 0 ? f32x16{} : pa1); } \
                _Pragma("unroll") for (int d0 = 2; d0 < 4; ++d0) { const bf16x8 k0 = *(const LAS bf16x8*)(kp + d0 * 2048), k1 = *(const LAS bf16x8*)(kp + d0 * 2048 + 512); const bf16x8 qf = qlds[d0 * 64]; \
                    pb0 = ATT_MFMA(k0, qf, d0 == 2 ? f32x16{} : pb0); pb1 = ATT_MFMA(k1, qf, d0 == 2 ? f32x16{} : pb1); } \
            } else { \
                _Pragma("unroll") for (int d0 = 0; d0 < 4; ++d0) { const bf16x8 k0 = *(const LAS bf16x8*)(kp + d0 * 2048), k1 = *(const LAS bf16x8*)(kp + d0 * 2048 + 512); \
                    pa0 = ATT_MFMA(k0, qr[d0], d0 == 0 ? f32x16{} : pa0); pa1 = ATT_MFMA(k1, qr[d0], d0 == 0 ? f32x16{} : pa1); } } } } while (0)
#define ATT_TOP(t) do { if ((t) + 1 < NT) { ATT_WAIT_BAR(2); } else { ATT_WAIT_BAR(0); } \
        if ((t) + 2 < NT) { ATT_DMA((t) + 2, (k3 == 0) ? 2 : k3 - 1, ((t) + 2) & 3); } } while (0)
    int k3 = 0;
    if (grp == 0) {
        ATT_TOP(0); ATT_QK(0, 0); ATT_BAR(); ATT_S(0);
        k3 = 1;
        for (int t = 1; t < NT; ++t) {
            ATT_TOP(t);
            __builtin_amdgcn_s_setprio(1); ATT_PV(t - 1, (t + 3) & 3); ATT_QK(t, k3); __builtin_amdgcn_s_setprio(0);
            ATT_BAR();
            ATT_S(t);
            k3 = (k3 == 2) ? 0 : k3 + 1;
        }
        ATT_BAR();
        ATT_PV(NT - 1, (NT + 3) & 3);
        ATT_BAR();
    } else {
        ATT_TOP(0); ATT_BAR(); ATT_QK(0, 0);
        k3 = 1;
        for (int t = 1; t < NT; ++t) {
            ATT_TOP(t);
            ATT_S(t - 1);
            ATT_BAR();
            __builtin_amdgcn_s_setprio(1); ATT_PV(t - 1, (t + 3) & 3); ATT_QK(t, k3); __builtin_amdgcn_s_setprio(0);
            k3 = (k3 == 2) ? 0 : k3 + 1;
        }
        ATT_BAR();
        ATT_S(NT - 1);
        ATT_BAR();
        ATT_PV(NT - 1, (NT + 3) & 3);
    }
    l1 += shx(l1, 32, lane);
    const float i1 = 1.0f / l1;
    bf16_t* orow = BR + (size_t)(P.qrow0 + r32) * DM + P.ocol + 4 * hi;
    if (MODE == 1) {
        l2 += shx(l2, 32, lane);
        const float i2 = P.lam / l2;
        float ss = 0.f;
#pragma unroll
        for (int dh = 0; dh < 2; ++dh)
#pragma unroll
            for (int r = 0; r < 16; ++r) { const float v = o[dh][r] * i1 - o2[dh][r] * i2; o[dh][r] = v; ss += v * v; }
        ss += shx(ss, 32, lane);
        const float rs = __builtin_amdgcn_rsqf(ss * (1.0f / 64.0f) + EPSN) * P.outscale;
#pragma unroll
        for (int dh = 0; dh < 2; ++dh)
#pragma unroll
            for (int g = 0; g < 4; ++g) { const f32x4 sg = *(const f32x4*)(P.subln + dh * 32 + 8 * g + 4 * hi);
                u32x2 w; w.x = cvtpk(o[dh][4 * g] * rs * sg[0], o[dh][4 * g + 1] * rs * sg[1]); w.y = cvtpk(o[dh][4 * g + 2] * rs * sg[2], o[dh][4 * g + 3] * rs * sg[3]);
                *(u32x2*)(orow + dh * 32 + 8 * g) = w; }
    } else {
#pragma unroll
        for (int dh = 0; dh < 2; ++dh)
#pragma unroll
            for (int g = 0; g < 4; ++g) { u32x2 w; w.x = cvtpk(o[dh][4 * g] * i1, o[dh][4 * g + 1] * i1); w.y = cvtpk(o[dh][4 * g + 2] * i1, o[dh][4 * g + 3] * i1);
                *(u32x2*)(orow + dh * 32 + 8 * g) = w; }
    }
    ATT_BAR();
#undef ATT_TROW
#undef ATT_DMA
#undef ATT_ACTIVE
#undef ATT_SOFT
#undef ATT_S
#undef ATT_PV
#undef ATT_TOP
#undef ATT_QK
}

__device__ __forceinline__ void attn_unit_a2(LAS unsigned char* shm, const bf16_t* __restrict__ QKV, bf16_t* BR, const UnitP& P) {
    int tid_ = threadIdx.x; asm volatile("" : "+v"(tid_));
    const int tid = tid_, lane = tid & 63, r32 = lane & 31, hi = lane >> 5; const int wid = __builtin_amdgcn_readfirstlane(tid >> 6);
    const int grp = wid >> 2;
    const unsigned lds0 = (unsigned)(uintptr_t)shm;
    const char* kbase = (const char*)QKV + (size_t)P.kcol * 2 + wid * 16 + (size_t)lane * (NQKV * 2);
    const char* vbase = (const char*)QKV + (size_t)P.vcol * 2 + ((wid >> 2) * 32 + (lane & 3) * 8) * 2 + (size_t)(16 * (wid & 3) + (lane >> 2)) * (NQKV * 2);
    const unsigned kdst = lds0 + LDS_K + wid * 1024, vdst = lds0 + LDS_V + wid * 1024;
    const int nloc = P.nloc, NT = nloc + 4;
#define A2_TROW(t) ((t) < nloc ? P.locrow0 + 64 * (t) : P.ctxrow0 + 64 * ((t) - nloc))
#define A2_DMA(t, ks, vs) do { const size_t ro_ = (size_t)A2_TROW(t) * (NQKV * 2); \
        glds16(kbase + ro_, (unsigned)__builtin_amdgcn_readfirstlane(kdst + (ks) * SLOTB)); glds16(vbase + ro_, (unsigned)__builtin_amdgcn_readfirstlane(vdst + (vs) * SLOTB)); } while (0)
    A2_DMA(0, 0, 0); A2_DMA(1, 1, 1);
    bf16x8 qr[2][4];
    LAS bf16x8* qlds = (LAS bf16x8*)(shm + LDS_Q + wid * 8192) + lane;
#pragma unroll
    for (int j = 0; j < 2; ++j) {
        const bf16_t* Qw = QKV + (size_t)(P.qrow0 + 32 * j + r32) * NQKV + P.qcol + hi * 8;
        u32x4 raw[4];
#pragma unroll
        for (int d0 = 0; d0 < 4; ++d0) raw[d0] = *reinterpret_cast<const u32x4*>(Qw + d0 * 16);
        float x[4][8];
#pragma unroll
        for (int d0 = 0; d0 < 4; ++d0) { x[d0][0] = bflo(raw[d0].x); x[d0][1] = bfhi(raw[d0].x); x[d0][2] = bflo(raw[d0].y); x[d0][3] = bfhi(raw[d0].y);
            x[d0][4] = bflo(raw[d0].z); x[d0][5] = bfhi(raw[d0].z); x[d0][6] = bflo(raw[d0].w); x[d0][7] = bfhi(raw[d0].w); }
        const f32x2* rt = P.rope ? P.rope + (size_t)(P.qpos0 + 32 * j + r32) * 48 : nullptr;
        float ss = 0.f;
#pragma unroll
        for (int d0 = 0; d0 < 4; ++d0)
#pragma unroll
            for (int e = 0; e < 8; ++e) ss += x[d0][e] * x[d0][e];
        ss += shx(ss, 32, lane);
        const float rs = __builtin_amdgcn_rsqf(ss * (1.0f / 64.0f) + EPSN);
#pragma unroll
        for (int d0 = 0; d0 < 4; ++d0)
#pragma unroll
            for (int e = 0; e < 8; ++e) x[d0][e] *= rs * P.qgain[16 * d0 + 8 * hi + e];
        if (rt) {
#pragma unroll
            for (int d0 = 0; d0 < 2; ++d0)
#pragma unroll
                for (int e = 0; e < 8; ++e) { const f32x2 cs = rt[16 * d0 + 8 * hi + e]; const float a = x[d0][e], b = x[d0 + 2][e];
                    x[d0][e] = a * cs.x - b * cs.y; x[d0 + 2][e] = a * cs.y + b * cs.x; } }
        const float qs = 0.125f * LOG2E;
#pragma unroll
        for (int d0 = 0; d0 < 4; ++d0) { u32x4 w; w.x = cvtpk(x[d0][0] * qs, x[d0][1] * qs); w.y = cvtpk(x[d0][2] * qs, x[d0][3] * qs); w.z = cvtpk(x[d0][4] * qs, x[d0][5] * qs); w.w = cvtpk(x[d0][6] * qs, x[d0][7] * qs);
            qr[j][d0] = __builtin_bit_cast(bf16x8, w); qlds[(j * 4 + d0) * 64] = qr[j][d0]; }
    }
    f32x16 o[2][2]; float l1[2] = {0.f, 0.f};
#pragma unroll
    for (int j = 0; j < 2; ++j) { o[j][0] = f32x16{}; o[j][1] = f32x16{}; }
    f32x16 pa[2][2];
#pragma unroll
    for (int j = 0; j < 2; ++j) { pa[j][0] = f32x16{}; pa[j][1] = f32x16{}; }
    u32x4 pw[2][4];
#pragma unroll
    for (int j = 0; j < 2; ++j)
#pragma unroll
        for (int i = 0; i < 4; ++i) pw[j][i] = (u32x4){0u, 0u, 0u, 0u};
    const lds_cptr kp0 = (lds_cptr)shm + LDS_K + hi * 1024 + r32 * 16;
    const lds_cptr vp0 = (lds_cptr)shm + LDS_V + ((lane >> 4) & 1) * 32 + (lane & 3) * 8 + (4 * hi + ((lane & 15) >> 2)) * 64;
#define A2_S() do { _Pragma("unroll") for (int j = 0; j < 2; ++j) { float s_ = 0.f; \
        _Pragma("unroll") for (int r = 0; r < 16; ++r) { pa[j][0][r] = __builtin_amdgcn_exp2f(pa[j][0][r]); pa[j][1][r] = __builtin_amdgcn_exp2f(pa[j][1][r]); s_ += pa[j][0][r] + pa[j][1][r]; } \
        l1[j] += s_; \
        pw[j][0] = (u32x4){cvtpk(pa[j][0][0], pa[j][0][1]), cvtpk(pa[j][0][2], pa[j][0][3]), cvtpk(pa[j][0][4], pa[j][0][5]), cvtpk(pa[j][0][6], pa[j][0][7])}; \
        pw[j][1] = (u32x4){cvtpk(pa[j][0][8], pa[j][0][9]), cvtpk(pa[j][0][10], pa[j][0][11]), cvtpk(pa[j][0][12], pa[j][0][13]), cvtpk(pa[j][0][14], pa[j][0][15])}; \
        pw[j][2] = (u32x4){cvtpk(pa[j][1][0], pa[j][1][1]), cvtpk(pa[j][1][2], pa[j][1][3]), cvtpk(pa[j][1][4], pa[j][1][5]), cvtpk(pa[j][1][6], pa[j][1][7])}; \
        pw[j][3] = (u32x4){cvtpk(pa[j][1][8], pa[j][1][9]), cvtpk(pa[j][1][10], pa[j][1][11]), cvtpk(pa[j][1][12], pa[j][1][13]), cvtpk(pa[j][1][14], pa[j][1][15])}; } } while (0)
#define A2_PV(vsp) do { const lds_cptr vp = vp0 + (vsp) * SLOTB; \
        _Pragma("unroll") for (int dh = 0; dh < 2; ++dh) _Pragma("unroll") for (int ks = 0; ks < 4; ++ks) { \
            const s16x4 vl = vtr(vp + dh * 4096 + ks * 1024), vh = vtr(vp + dh * 4096 + ks * 1024 + 512); \
            const bf16x8 vf = (bf16x8){vl[0], vl[1], vl[2], vl[3], vh[0], vh[1], vh[2], vh[3]}; \
            o[0][dh] = ATT_MFMA(vf, __builtin_bit_cast(bf16x8, pw[0][ks]), o[0][dh]); o[1][dh] = ATT_MFMA(vf, __builtin_bit_cast(bf16x8, pw[1][ks]), o[1][dh]); } } while (0)
#define A2_QK(ksc) do { const lds_cptr kp = kp0 + (ksc) * SLOTB; \
        _Pragma("unroll") for (int d0 = 0; d0 < 4; ++d0) { const bf16x8 k0 = *(const LAS bf16x8*)(kp + d0 * 2048), k1 = *(const LAS bf16x8*)(kp + d0 * 2048 + 512); \
            const bf16x8 q0_ = qlds[d0 * 64], q1_ = qlds[(4 + d0) * 64]; \
            pa[0][0] = ATT_MFMA(k0, q0_, d0 == 0 ? f32x16{} : pa[0][0]); pa[1][0] = ATT_MFMA(k0, q1_, d0 == 0 ? f32x16{} : pa[1][0]); \
            pa[0][1] = ATT_MFMA(k1, q0_, d0 == 0 ? f32x16{} : pa[0][1]); pa[1][1] = ATT_MFMA(k1, q1_, d0 == 0 ? f32x16{} : pa[1][1]); } } while (0)
#define A2_TOP(t) do { if ((t) + 1 < NT) { ATT_WAIT_BAR(2); } else { ATT_WAIT_BAR(0); } \
        if ((t) + 2 < NT) { A2_DMA((t) + 2, (k3 == 0) ? 2 : k3 - 1, ((t) + 2) & 3); } } while (0)
    int k3 = 0;
    if (grp == 0) {
        A2_TOP(0); A2_QK(0); ATT_BAR(); A2_S();
        k3 = 1;
        for (int t = 1; t < NT; ++t) {
            A2_TOP(t);
            __builtin_amdgcn_s_setprio(1); A2_PV((t + 3) & 3); A2_QK(k3); __builtin_amdgcn_s_setprio(0);
            ATT_BAR();
            A2_S();
            k3 = (k3 == 2) ? 0 : k3 + 1;
        }
        ATT_BAR();
        A2_PV((NT + 3) & 3);
        ATT_BAR();
    } else {
        A2_TOP(0); ATT_BAR(); A2_QK(0);
        k3 = 1;
        for (int t = 1; t < NT; ++t) {
            A2_TOP(t);
            A2_S();
            ATT_BAR();
            __builtin_amdgcn_s_setprio(1); A2_PV((t + 3) & 3); A2_QK(k3); __builtin_amdgcn_s_setprio(0);
            k3 = (k3 == 2) ? 0 : k3 + 1;
        }
        ATT_BAR();
        A2_S();
        ATT_BAR();
        A2_PV((NT + 3) & 3);
    }
#pragma unroll
    for (int j = 0; j < 2; ++j) {
        float lt = l1[j]; lt += shx(lt, 32, lane);
        const float i1 = 1.0f / lt;
        bf16_t* orow = BR + (size_t)(P.qrow0 + 32 * j + r32) * DM + P.ocol + 4 * hi;
#pragma unroll
        for (int dh = 0; dh < 2; ++dh)
#pragma unroll
            for (int g = 0; g < 4; ++g) { u32x2 w; w.x = cvtpk(o[j][dh][4 * g] * i1, o[j][dh][4 * g + 1] * i1); w.y = cvtpk(o[j][dh][4 * g + 2] * i1, o[j][dh][4 * g + 3] * i1);
                *(u32x2*)(orow + dh * 32 + 8 * g) = w; }
    }
    ATT_BAR();
#undef A2_TROW
#undef A2_DMA
#undef A2_S
#undef A2_PV
#undef A2_QK
#undef A2_TOP
}
}

struct Args { const float* in[33]; float* out; unsigned char* ws; int ph_lo, ph_hi; };
enum { I_X = 0, I_C, I_CTX, I_CCTX, I_N1G, I_N2G, I_WADA, I_BADA, I_WIN, I_BGATE, I_AQN, I_AKN, I_BQN, I_BKN, I_LQ1, I_LK1, I_LQ2, I_LK2, I_SUBLN, I_CQN, I_CKN, I_SINK, I_DQN, I_DKN, I_RPB,
       I_WBR, I_WOUT, I_RW, I_RB, I_WGU, I_BGU, I_WD, I_BD };
constexpr int N_PHASES = 22;

__device__ __forceinline__ void p0_transpose_item(const float* __restrict__ W, int K, int N, bf16_t* WT, int item, int lane, LAS float* scr, bool gu_perm) {
    const int nblk = N >> 5, kb = item / nblk, nb = item - kb * nblk, k0 = 64 * kb, n0 = 32 * nb;
#pragma unroll 8
    for (int i = 0; i < 32; ++i) { const int kk = 2 * i + (lane >> 5); scr[kk * 33 + (lane & 31)] = W[(size_t)(k0 + kk) * N + n0 + (lane & 31)]; }
    LDS_WAIT();
    const int c = lane & 7;
    const int rowbase = gu_perm ? (((n0 & 1023) >> 7) * 256 + (n0 >> 10) * 128 + (n0 & 127)) : n0;
#pragma unroll
    for (int j = 0; j < 4; ++j) { const int n = (lane >> 3) + 8 * j; const LAS float* s = scr + (8 * c) * 33 + n;
        u32x4 o; o.x = cvtpk(s[0 * 33], s[1 * 33]); o.y = cvtpk(s[2 * 33], s[3 * 33]); o.z = cvtpk(s[4 * 33], s[5 * 33]); o.w = cvtpk(s[6 * 33], s[7 * 33]);
        *(u32x4*)(WT + (size_t)(rowbase + n) * K + k0 + 8 * c) = o; }
    LDS_WAIT();
}

__device__ __forceinline__ void moe_tables(LAS int* tb, const unsigned* gcount) {
    if (threadIdx.x == 0) { int s = 0;
        for (int e = 0; e < 32; ++e) { const int c = (int)gcount[e]; tb[e] = s; tb[64 + e] = c; s += (c + 255) >> 8; }
        tb[32] = s; }
    __syncthreads();
}
__device__ __forceinline__ void moe_gather_row(f32x4 (&a)[4], int row, const unsigned* tokep, const float* tokw, const LAS int* tb, const bf16_t* Y, int lane) {
#pragma unroll
    for (int k = 0; k < 4; ++k) { const unsigned ep = tokep[row * 4 + k]; const float w = tokw[row * 4 + k];
        const int e = (int)(ep >> 24), pos = (int)(ep & 0xffffffu); const size_t slot = (size_t)tb[e] * 256 + pos;
        const u32x2* yp = (const u32x2*)(Y + slot * DM) + lane;
#pragma unroll
        for (int j = 0; j < 4; ++j) { const u32x2 u = yp[64 * j]; a[j][0] += w * bflo(u.x); a[j][1] += w * bfhi(u.x); a[j][2] += w * bflo(u.y); a[j][3] += w * bfhi(u.y); } }
}

__global__ void __launch_bounds__(NTHR, 2) hdb_fwd(Args args) {
    extern __shared__ __attribute__((aligned(16))) unsigned char lds_raw[];
    LAS unsigned char* lds = (LAS unsigned char*)lds_raw;
    const int tid0 = threadIdx.x, wid = __builtin_amdgcn_readfirstlane(tid0 >> 6);
    const int G = gridDim.x, bx = blockIdx.x;
typedef const __attribute__((address_space(4))) char* K4;
#define INP(i) (*(const float* const __attribute__((address_space(4)))*)(kargs_ + 8 * (i)))
#define PH_LOCALS_X PH_LOCALS const float* modl = MOD + l * 5 * 6144; (void)modl;
#define PH_LOCALS K4 kargs_ = (K4)__builtin_amdgcn_kernarg_segment_ptr(); asm volatile("" : "+s"(kargs_)); unsigned char* wsl = *(unsigned char* const __attribute__((address_space(4)))*)(kargs_ + 272); int tid = tid0; asm volatile("" : "+v"(tid)); const int lane = tid & 63; const int gw = bx * NWAVES + wid, NGW = G * NWAVES; (void)lane; (void)gw; (void)NGW;
    unsigned char* ws = args.ws;
    unsigned* ctl = (unsigned*)(ws + WS_CTL);
    LAS int* tb = (LAS int*)(lds + MISC_OFF);
    volatile LAS unsigned* barst = (volatile LAS unsigned*)(lds + MISC_OFF + 512);
    if (tid0 < 4) barst[tid0] = 0u;
    __syncthreads();
    XcdBarrier bar; bar.bar = ctl + CW_BAR; bar.x = 0; bar.st = nullptr;
    if (!MK_PER_PHASE) bar = xcd_barrier_post(ctl + CW_BAR, barst);
    const int lo = args.ph_lo, hi_ph = args.ph_hi;
#ifndef PHMASK
#define PHMASK 0xfff
#endif
#define PHON(b) (((PHMASK) >> (b)) & 1)
#ifndef REPMASK
#define REPMASK 0
#endif
#define NREP(b) ((((REPMASK) >> (b)) & 1) ? 2 : 1)
#define IN(k) (lo <= (k) && (k) < hi_ph)
#define SEAM(k) do { if (!MK_PER_PHASE && IN(k) && IN((k) + 1)) xcd_barrier(bar); } while (0)

#define MOD ((float*)(wsl + WS_MOD))
#define ROPE ((f32x2*)(wsl + WS_ROPE))
#define TOKEP ((unsigned*)(wsl + WS_TOKEP))
#define TOKW ((float*)(wsl + WS_TOKW))
#define TOKMAP ((int*)(wsl + WS_TOKMAP))
#define WIN ((bf16_t*)(wsl + WS_WIN))
#define WB ((bf16_t*)(wsl + WS_WB))
#define WO ((bf16_t*)(wsl + WS_WO))
#define WGU ((bf16_t*)(wsl + WS_WGU))
#define WD ((bf16_t*)(wsl + WS_WD))
#define H ((bf16_t*)(wsl + WS_H))
#define QKV ((bf16_t*)(wsl + WS_QKV))
#define GT ((bf16_t*)(wsl + WS_G))
#define BR ((bf16_t*)(wsl + WS_BR))
#define XRB ((bf16_t*)(wsl + WS_XR))
#define ACT ((bf16_t*)(wsl + WS_ACT))
#define Y ((bf16_t*)(wsl + WS_Y))

    if (PHON(10) && IN(0)) {
        PH_LOCALS
        for (int it = bx; it < 192; it += G) {
            const int l = it / 96, col0 = (it % 96) * 64;
            LAS float* sl = (LAS float*)lds; LAS float* part = (LAS float*)(lds + 20480);
            for (int i = tid; i < 5 * 1024; i += NTHR) { const int r = i >> 10, k = i & 1023; const float v = (r < 4) ? INP(I_C)[r * 1024 + k] : INP(I_CCTX)[k]; sl[i] = v / (1.0f + __expf(-v)); }
            __syncthreads();
            float acc[5] = {0.f, 0.f, 0.f, 0.f, 0.f};
            const float* wp = INP(I_WADA) + ((size_t)l * 1024 + wid * 128) * 6144 + col0 + lane;
#pragma unroll 16
            for (int kk = 0; kk < 128; ++kk) { const float w = wp[(size_t)kk * 6144];
#pragma unroll
                for (int r = 0; r < 5; ++r) acc[r] += sl[r * 1024 + wid * 128 + kk] * w; }
#pragma unroll
            for (int r = 0; r < 5; ++r) part[(wid * 5 + r) * 64 + lane] = acc[r];
            __syncthreads();
            if (tid < 320) { const int r = tid >> 6, ln = tid & 63; float s = 0.f;
#pragma unroll
                for (int w = 0; w < 8; ++w) s += part[(w * 5 + r) * 64 + ln];
                MOD[(l * 5 + r) * 6144 + col0 + ln] = s + INP(I_BADA)[l * 6144 + col0 + ln]; }
            __syncthreads();
        }
        for (int i = bx * NTHR + tid; i < SEQ * 48; i += G * NTHR) {
            const int t = i / 48, j = i - t * 48; const float row = (float)(t >> 6), col = (float)(t & 63);
            float ang;
            if (j < 32) { const int jj = j & 15; const float inv = powf(10000.0f, -(float)jj / 16.0f); ang = (j < 16 ? row : col) * inv; }
            else { const int j2 = j - 32, jj = j2 & 7; const float inv = powf(10000.0f, -(float)jj / 8.0f); ang = (j2 < 8 ? row : col) * inv; }
            float sn, cs; sincosf(ang, &sn, &cs);
            ROPE[i] = (f32x2){cs, sn};
        }
        if (bx == 0) for (int i = tid; i < DM / 2; i += NTHR) ((unsigned*)(H + (size_t)TT * DM))[i] = 0u;
        {
            LAS float* scr = (LAS float*)(lds + wid * 16384);
            constexpr int I_IN = 2 * 16 * 208, I_BRN = 8 * 4 * 32, I_OUT = 2 * 16 * 32, I_GU = 64 * 16 * 64, I_DN = 64 * 16 * 32;
            constexpr int NITEMS = I_IN + I_BRN + I_OUT + I_GU + I_DN;
            unsigned* qhead = ctl + 3100; LAS int* qslot = (LAS int*)(lds + MISC_OFF + 768);
            for (;;) {
                __syncthreads();
                if (tid == 0) qslot[0] = (int)__hip_atomic_fetch_add(qhead, 64u, __ATOMIC_RELAXED, __HIP_MEMORY_SCOPE_AGENT);
                __syncthreads();
                const int c0 = qslot[0];
                if (c0 >= NITEMS) break;
                const int c1 = min(c0 + 64, NITEMS);
            for (int it = c0 + wid; it < c1; it += NWAVES) {
                int r = it;
                if (r < I_IN) { const int l = r / 3328, q = r % 3328; p0_transpose_item(INP(I_WIN) + (size_t)l * 1024 * NIN, 1024, NIN, WIN + (size_t)l * NIN * 1024, q, lane, scr, false); continue; } r -= I_IN;
                if (r < I_BRN) { const int mtx = r / 128, q = r % 128; p0_transpose_item(INP(I_WBR) + (size_t)mtx * 256 * 1024, 256, 1024, WB + (size_t)mtx * 1024 * 256, q, lane, scr, false); continue; } r -= I_BRN;
                if (r < I_OUT) { const int l = r / 512, q = r % 512; p0_transpose_item(INP(I_WOUT) + (size_t)l * 1024 * 1024, 1024, 1024, WO + (size_t)l * 1024 * 1024, q, lane, scr, false); continue; } r -= I_OUT;
                if (r < I_GU) { const int mtx = r / 1024, q = r % 1024; p0_transpose_item(INP(I_WGU) + (size_t)mtx * 1024 * 2048, 1024, 2048, WGU + (size_t)mtx * 2048 * 1024, q, lane, scr, true); continue; } r -= I_GU;
                { const int mtx = r / 512, q = r % 512; p0_transpose_item(INP(I_WD) + (size_t)mtx * 1024 * 1024, 1024, 1024, WD + (size_t)mtx * 1024 * 1024, q, lane, scr, false); }
            }
            }
        }
    }
    SEAM(0);
#ifdef PROBE_BARS
    for (int i_ = 0; i_ < PROBE_BARS; ++i_) xcd_barrier(bar);
#endif

    for (int l = 0; l < 2; ++l) {
        const int pb = 1 + 10 * l;
        const int nrows_m = l == 0 ? TT : TL;
        unsigned* gcount = ctl + CW_GCOUNT + 64 * l;

        if (PHON(0) && IN(pb + 0)) {
            PH_LOCALS_X
            if (l == 1) moe_tables(tb, ctl + CW_GCOUNT);
            const float* g2prev = MOD + 0 * 5 * 6144;
            const f32x4* gn = (const f32x4*)(INP(I_N1G) + l * DM) + lane;
            for (int rowA = gw; rowA < TT; rowA += 2 * NGW) {
                const bool hasB = rowA + NGW < TT; const int rowB = hasB ? rowA + NGW : rowA;
                f32x4 v[2][4], a[2][4];
#pragma unroll
                for (int r = 0; r < 2; ++r) { const int row = r ? rowB : rowA;
                    if (l == 0) { const f32x4* xr = (const f32x4*)(row < TL ? INP(I_X) + (size_t)row * DM : INP(I_CTX) + (size_t)(row - TL) * DM) + lane;
#pragma unroll
                        for (int j = 0; j < 4; ++j) v[r][j] = xr[64 * j]; }
                    else { const u32x2* xr = (const u32x2*)(XRB + (size_t)row * DM) + lane;
#pragma unroll
                        for (int j = 0; j < 4; ++j) { const u32x2 t2 = xr[64 * j]; v[r][j] = (f32x4){bflo(t2.x), bfhi(t2.x), bflo(t2.y), bfhi(t2.y)}; } }
#pragma unroll
                    for (int j = 0; j < 4; ++j) a[r][j] = (f32x4){0.f, 0.f, 0.f, 0.f}; }
                if (l == 1) {
                    moe_gather_row(a[0], rowA, TOKEP, TOKW, tb, Y, lane);
                    moe_gather_row(a[1], rowB, TOKEP, TOKW, tb, Y, lane);
                }
#pragma unroll
                for (int r = 0; r < 2; ++r) { const int row = r ? rowB : rowA; const int ridx = row < TL ? (row >> 13) : 4;
                    if (r == 1 && !hasB) break;
                    if (l == 1) { u32x2* xw = (u32x2*)(XRB + (size_t)row * DM) + lane; const f32x4* g2 = (const f32x4*)(g2prev + ridx * 6144 + 5 * 1024) + lane;
#pragma unroll
                        for (int j = 0; j < 4; ++j) { v[r][j] += g2[64 * j] * a[r][j]; u32x2 w2; w2.x = cvtpk(v[r][j][0], v[r][j][1]); w2.y = cvtpk(v[r][j][2], v[r][j][3]); xw[64 * j] = w2; } }
                    float ss = 0.f;
#pragma unroll
                    for (int j = 0; j < 4; ++j) ss += (v[r][j][0] * v[r][j][0] + v[r][j][1] * v[r][j][1]) + (v[r][j][2] * v[r][j][2] + v[r][j][3] * v[r][j][3]);
                    const float rstd = __builtin_amdgcn_rsqf(wave_sum(ss, lane) * (1.0f / DM) + EPSN);
                    const f32x4* sh = (const f32x4*)(modl + ridx * 6144) + lane; const f32x4* sc = (const f32x4*)(modl + ridx * 6144 + 1024) + lane;
                    u32x2* o8 = (u32x2*)(H + (size_t)row * DM) + lane;
#pragma unroll
                    for (int j = 0; j < 4; ++j) { const f32x4 y = (v[r][j] * rstd * gn[64 * j]) * (sc[64 * j] + 1.0f) + sh[64 * j];
                        u32x2 w; w.x = cvtpk(y[0], y[1]); w.y = cvtpk(y[2], y[3]); o8[64 * j] = w; } }
            }
        }
        SEAM(pb + 0);

        if (PHON(1) && IN(pb + 1)) {
            PH_LOCALS_X
            pg8::DenseSched S; S.nM = TT / 256; S.nN = NIN / 256; S.nwg = S.nM * S.nN; S.G = G; S.c = bx; S.Bt = (const char*)(WIN + (size_t)l * NIN * 1024); S.ldb2 = 2048; S.kmul = 0;
            pg8::EpiIn E{QKV, GT, INP(I_BGATE) + l * NGATE};
            pg8::gemm_phase<pg8::EpiIn, pg8::DenseSched>(lds, (const char*)H, 2048u, 2048u, 1024, S, E);
        }
        SEAM(pb + 1);

        if (PHON(2) && IN(pb + 2)) {
            PH_LOCALS_X
            const int total = TT * 96, S4 = G * NTHR;
            for (int i0 = bx * NTHR + tid; i0 < total; i0 += 4 * S4) {
                u32x4 uu[4]; f32x4 gg[4][2], rr[4][4]; int rows[4], prs[4]; bool ok[4];
#pragma unroll
                for (int q = 0; q < 4; ++q) { const int i = i0 + q * S4; ok[q] = i < total; const int ii = ok[q] ? i : i0;
                    rows[q] = ii / 96; prs[q] = ii - rows[q] * 96;
                    const int kc = prs[q] >> 3, p = prs[q] & 7; const int mixer = kc < 2 ? 0 : (kc < 6 ? 1 : (kc < 8 ? 2 : 3)); const bool is32 = mixer == 1;
                    uu[q] = *(const u32x4*)(QKV + (size_t)rows[q] * NQKV + 1024 + kc * 64 + p * 8);
                    const int gi = mixer == 0 ? I_AKN : mixer == 1 ? I_BKN : mixer == 2 ? I_CKN : I_DKN;
                    const float* gain = INP(gi) + l * (is32 ? 32 : 64) + (is32 ? (p & 3) : p) * 8;
                    gg[q][0] = *(const f32x4*)gain; gg[q][1] = *(const f32x4*)(gain + 4);
                    const f32x4* rt = (const f32x4*)(ROPE + (size_t)(rows[q] & (SEQ - 1)) * 48 + (is32 ? 32 + (p & 1) * 8 : (p & 3) * 8));
#pragma unroll
                    for (int e = 0; e < 4; ++e) rr[q][e] = rt[e]; }
#pragma unroll
                for (int q = 0; q < 4; ++q) {
                    const int row = rows[q], kc = prs[q] >> 3, p = prs[q] & 7;
                    const int mixer = kc < 2 ? 0 : (kc < 6 ? 1 : (kc < 8 ? 2 : 3));
                    const u32x4 u = uu[q];
                    float x[8] = {bflo(u.x), bfhi(u.x), bflo(u.y), bfhi(u.y), bflo(u.z), bfhi(u.z), bflo(u.w), bfhi(u.w)};
                    float ss = 0.f;
#pragma unroll
                    for (int e = 0; e < 8; ++e) ss += x[e] * x[e];
                    ss += shx(ss, 1, lane); ss += shx(ss, 2, lane);
                    const float s4 = shx(ss, 4, lane);
                    const bool is32 = mixer == 1;
                    if (!is32) ss += s4;
                    const float rs = __builtin_amdgcn_rsqf(ss * (is32 ? 1.0f / 32.0f : 1.0f / 64.0f) + EPSN);
#pragma unroll
                    for (int e = 0; e < 4; ++e) { x[e] *= rs * gg[q][0][e]; x[4 + e] *= rs * gg[q][1][e]; }
                    const bool rope = (row < TL) && (mixer != 3);
                    const float sgn = (is32 ? (p & 2) : (p & 4)) ? 1.0f : -1.0f;
#pragma unroll
                    for (int e = 0; e < 8; ++e) { const float p2 = shx(x[e], 2, lane), p4 = shx(x[e], 4, lane); const float pt = is32 ? p2 : p4;
                        const float cs = rr[q][e >> 1][(e & 1) * 2], sn = rr[q][e >> 1][(e & 1) * 2 + 1];
                        if (rope) x[e] = x[e] * cs + sgn * pt * sn; }
                    u32x4 w; w.x = cvtpk(x[0], x[1]); w.y = cvtpk(x[2], x[3]); w.z = cvtpk(x[4], x[5]); w.w = cvtpk(x[6], x[7]);
                    if (ok[q]) *(u32x4*)(QKV + (size_t)row * NQKV + 1024 + kc * 64 + p * 8) = w;
                }
            }
        }
        SEAM(pb + 2);

        if (PHON(3) && IN(pb + 3)) {
            PH_LOCALS_X
            const float lam_init = 0.8f - 0.6f * __expf(-0.3f * (float)l);
            float lam;
            { const float a = (lane < 32) ? INP(I_LQ1)[l * 32 + lane] * INP(I_LK1)[l * 32 + lane] : 0.f, b = (lane < 32) ? INP(I_LQ2)[l * 32 + lane] * INP(I_LK2)[l * 32 + lane] : 0.f;
              lam = __expf(wave_sum(a, lane)) - __expf(wave_sum(b, lane)) + lam_init; lam = __builtin_bit_cast(float, __builtin_amdgcn_readfirstlane(__builtin_bit_cast(int, lam))); }
            const float* subln = INP(I_SUBLN) + l * 64;
            const int ctxb = TL;
#if !defined(ATT_ONLY) || ATT_ONLY == 0
            for (int u = bx; u < 512; u += G) {
                att::UnitP P; P.linit = 0.f; P.lam = lam; P.outscale = 1.0f - lam_init; P.subln = subln;
                const int bh = (u & 7) * 2 + ((u >> 8) & 1), blk = (u >> 3) & 31, b = bh >> 2, h = bh & 3;
                P.qrow0 = b * SEQ + blk * 256 + wid * 32; P.qpos0 = blk * 256 + wid * 32;
                P.qcol = QB_ + h * 64; P.kcol = KB_ + h * 64; P.vcol = VB_ + h * 64; P.ocol = 256 + h * 64; P.qgain = INP(I_BQN) + l * 32; P.rope = ROPE;
                P.locrow0 = b * SEQ; P.nloc = 128; P.kpos0 = 0; P.ctxrow0 = ctxb + b * CTXL;
                att::attn_unit<1>(lds, QKV, BR, P);
            }
#endif
#if !defined(ATT_ONLY) || ATT_ONLY == 1
            for (int u = bx; u < 256; u += G) {
                att::UnitP P; P.linit = 0.f; P.lam = lam; P.outscale = 1.0f; P.subln = subln;
                const int bk = u & 7, blk = u >> 3, b = bk >> 1, kvh = bk & 1, h = kvh * 2 + (wid >> 2);
                P.qrow0 = b * SEQ + blk * 256 + (wid & 3) * 64; P.qpos0 = blk * 256 + (wid & 3) * 64;
                P.qcol = QA + h * 64; P.kcol = KA + kvh * 64; P.vcol = VA + kvh * 64; P.ocol = 0 + h * 64; P.qgain = INP(I_AQN) + l * 64; P.rope = ROPE;
                P.locrow0 = b * SEQ; P.nloc = 128; P.kpos0 = 0; P.ctxrow0 = ctxb + b * CTXL;
                att::attn_unit_a2(lds, QKV, BR, P);
            }
#endif
#if !defined(ATT_ONLY) || ATT_ONLY == 2
            for (int u = bx; u < 512; u += G) {
                att::UnitP P; P.lam = lam; P.outscale = 1.0f; P.subln = subln;
                const int bk = u & 7, blk = u >> 3, b = bk >> 1, kvh = bk & 1, h = kvh * 2 + (wid >> 2);
                P.qrow0 = b * SEQ + blk * 128 + (wid & 3) * 32; P.qpos0 = blk * 128 + (wid & 3) * 32;
                P.qcol = QC + h * 64; P.kcol = KC + kvh * 64; P.vcol = VC + kvh * 64; P.ocol = 512 + h * 64; P.qgain = INP(I_CQN) + l * 64; P.rope = ROPE;
                const int k0 = max(blk * 128 - 128, 0), k1 = min(blk * 128 + 256, SEQ);
                P.locrow0 = b * SEQ + k0; P.nloc = (k1 - k0) >> 6; P.kpos0 = k0; P.ctxrow0 = ctxb + b * CTXL;
                P.linit = __builtin_amdgcn_exp2f(INP(I_SINK)[l * 4 + h] * LOG2E);
                att::attn_unit<2>(lds, QKV, BR, P);
            }
#endif
#if !defined(ATT_ONLY) || ATT_ONLY == 3
            for (int u = bx; u < 512; u += G) {
                att::UnitP P; P.linit = 0.f; P.lam = lam; P.outscale = 1.0f; P.subln = subln;
                const int bh = (u & 7) * 2 + ((u >> 8) & 1), blk = (u >> 3) & 31, b = bh >> 2, h = bh & 3;
                { LAS float* bt = (LAS float*)(lds + att::LDS_BIAS); const float* rp = INP(I_RPB) + ((size_t)l * 4 + h) * 465;
                  for (int i = tid; i < 465; i += NTHR) bt[i] = rp[i] * LOG2E; }
                P.qrow0 = b * SEQ + blk * 256 + wid * 32; P.qpos0 = blk * 256 + wid * 32;
                P.qcol = QD + h * 64; P.kcol = KD + h * 64; P.vcol = VD + h * 64; P.ocol = 768 + h * 64; P.qgain = INP(I_DQN) + l * 64; P.rope = nullptr;
                const int ra = min(max(4 * blk - 4, 0), 120), rb = min(max(4 * blk + 3 - 4, 0), 120) + 8;
                P.locrow0 = b * SEQ + ra * 64; P.nloc = rb - ra; P.kpos0 = ra * 64; P.ctxrow0 = ctxb + b * CTXL;
                att::attn_unit<3>(lds, QKV, BR, P);
            }
#endif
#ifndef ATT_ONLY
            if (l == 0) {
                for (int u = bx; u < 64; u += G) if ((u >> 4) == 0) {
                    const int v = u & 15, b = v >> 2, kvh = (v >> 1) & 1, blk = v & 1, h = kvh * 2 + (wid >> 2);
                    att::UnitP P; P.linit = 0.f; P.lam = lam; P.outscale = 1.0f; P.subln = subln; P.nloc = 0; P.locrow0 = 0; P.kpos0 = 0; P.qpos0 = 0;
                    P.qrow0 = ctxb + b * CTXL + blk * 128 + (wid & 3) * 32; P.ctxrow0 = ctxb + b * CTXL;
                    P.qcol = QA + h * 64; P.kcol = KA + kvh * 64; P.vcol = VA + kvh * 64; P.ocol = h * 64; P.qgain = INP(I_AQN) + l * 64; P.rope = nullptr;
                    att::attn_unit<0>(lds, QKV, BR, P);
                }
                for (int u = bx; u < 64; u += G) if ((u >> 4) == 1) {
                    const int v = u & 15, b = v >> 2, h = v & 3;
                    att::UnitP P; P.linit = 0.f; P.lam = lam; P.outscale = 1.0f - lam_init; P.subln = subln; P.nloc = 0; P.locrow0 = 0; P.kpos0 = 0; P.qpos0 = 0;
                    P.qrow0 = ctxb + b * CTXL + wid * 32; P.ctxrow0 = ctxb + b * CTXL;
                    P.qcol = QB_ + h * 64; P.kcol = KB_ + h * 64; P.vcol = VB_ + h * 64; P.ocol = 256 + h * 64; P.qgain = INP(I_BQN) + l * 32; P.rope = nullptr;
                    att::attn_unit<1>(lds, QKV, BR, P);
                }
                for (int u = bx; u < 64; u += G) if ((u >> 4) == 2) {
                    const int v = u & 15, b = v >> 2, kvh = (v >> 1) & 1, blk = v & 1, h = kvh * 2 + (wid >> 2);
                    att::UnitP P; P.lam = lam; P.outscale = 1.0f; P.subln = subln; P.nloc = 0; P.locrow0 = 0; P.kpos0 = 0; P.qpos0 = 0;
                    P.qrow0 = ctxb + b * CTXL + blk * 128 + (wid & 3) * 32; P.ctxrow0 = ctxb + b * CTXL;
                    P.qcol = QC + h * 64; P.kcol = KC + kvh * 64; P.vcol = VC + kvh * 64; P.ocol = 512 + h * 64; P.qgain = INP(I_CQN) + l * 64; P.rope = nullptr;
                    P.linit = __builtin_amdgcn_exp2f(INP(I_SINK)[l * 4 + h] * LOG2E);
                    att::attn_unit<0>(lds, QKV, BR, P);
                }
                for (int u = bx; u < 64; u += G) if ((u >> 4) == 3) {
                    const int v = u & 15, b = v >> 2, h = v & 3;
                    att::UnitP P; P.linit = 0.f; P.lam = lam; P.outscale = 1.0f; P.subln = subln; P.nloc = 0; P.locrow0 = 0; P.kpos0 = 0; P.qpos0 = 0;
                    P.qrow0 = ctxb + b * CTXL + wid * 32; P.ctxrow0 = ctxb + b * CTXL;
                    P.qcol = QD + h * 64; P.kcol = KD + h * 64; P.vcol = VD + h * 64; P.ocol = 768 + h * 64; P.qgain = INP(I_DQN) + l * 64; P.rope = nullptr;
                    att::attn_unit<0>(lds, QKV, BR, P);
                }
            }
#endif
        }
        SEAM(pb + 3);

        if (PHON(4) && IN(pb + 4)) {
            PH_LOCALS_X
            pg8::BranchSchedH S; S.nM = nrows_m / 256; S.nwg = S.nM * 8; S.G = G; S.c = bx; S.Bt = (const char*)(WB + (size_t)l * 4096 * 256);
            pg8::EpiBranchH E{}; E.Gt = GT; E.SUMB = H;
            pg8::gemm_phase<pg8::EpiBranchH, pg8::BranchSchedH>(lds, (const char*)BR, 2048u, 512u, 256, S, E);
        }
        SEAM(pb + 4);

        if (PHON(5) && IN(pb + 5)) {
            PH_LOCALS_X
        }

        if (PHON(6) && IN(pb + 6)) {
            PH_LOCALS_X
            pg8::DenseSched S; S.nM = nrows_m / 256; S.nN = 4; S.nwg = S.nM * S.nN; S.G = G; S.c = bx; S.Bt = (const char*)(WO + (size_t)l * 1024 * 1024); S.ldb2 = 2048; S.kmul = 0;
            pg8::EpiOut E{INP(I_X), INP(I_CTX), XRB, modl, l};
            pg8::gemm_phase<pg8::EpiOut, pg8::DenseSched>(lds, (const char*)H, 2048u, 2048u, 1024, S, E);
        }
        SEAM(pb + 6);

        if (PHON(7) && IN(pb + 7)) {
            PH_LOCALS_X
            LAS float* wrt = (LAS float*)lds;
            constexpr int WRP = 1028;
            LAS int* lcount = (LAS int*)(lds + 32 * WRP * 4);
            LAS float* lgl = (LAS float*)(lds + 32 * WRP * 4 + 256);
            LAS unsigned* ent = (LAS unsigned*)lgl;
            const float* rw = INP(I_RW) + (size_t)l * 1024 * 32;
            for (int i = tid; i < 1024 * 32; i += NTHR) { const int k = i >> 5, e = i & 31; wrt[e * WRP + k] = rw[i]; }
            if (tid < 64) lcount[tid] = 0;
            __syncthreads();
            const int nloc_rows = (nrows_m - bx + G - 1) / G;
            const f32x4* gn = (const f32x4*)(INP(I_N2G) + l * DM) + lane;
            const float rbias = INP(I_RB)[l * 32 + (lane >> 1)];
            for (int li0 = wid; li0 < nloc_rows; li0 += 2 * NWAVES) {
                const int li1 = li0 + NWAVES; const bool has1 = li1 < nloc_rows;
                const int row0 = bx + li0 * G, row1 = bx + (has1 ? li1 : li0) * G;
                f32x4 v[2][4]; float ss[2] = {0.f, 0.f};
#pragma unroll
                for (int r = 0; r < 2; ++r) { const u32x2* xr = (const u32x2*)(XRB + (size_t)(r ? row1 : row0) * DM) + lane;
#pragma unroll
                    for (int j = 0; j < 4; ++j) { const u32x2 t2 = xr[64 * j]; v[r][j] = (f32x4){bflo(t2.x), bfhi(t2.x), bflo(t2.y), bfhi(t2.y)}; } }
#pragma unroll
                for (int r = 0; r < 2; ++r) {
#pragma unroll
                    for (int j = 0; j < 4; ++j) ss[r] += (v[r][j][0] * v[r][j][0] + v[r][j][1] * v[r][j][1]) + (v[r][j][2] * v[r][j][2] + v[r][j][3] * v[r][j][3]); }
#pragma unroll
                for (int r = 0; r < 2; ++r) { const int row = r ? row1 : row0; const int ridx = row < TL ? (row >> 13) : 4;
                    const float rstd = __builtin_amdgcn_rsqf(wave_sum(ss[r], lane) * (1.0f / DM) + EPSN);
                    const f32x4* sh = (const f32x4*)(modl + ridx * 6144 + 3 * 1024) + lane; const f32x4* sc = (const f32x4*)(modl + ridx * 6144 + 4 * 1024) + lane;
                    u32x2* o8 = (u32x2*)(H + (size_t)row * DM) + lane;
#pragma unroll
                    for (int j = 0; j < 4; ++j) { v[r][j] = (v[r][j] * rstd * gn[64 * j]) * (sc[64 * j] + 1.0f) + sh[64 * j];
                        u32x2 w; w.x = cvtpk(v[r][j][0], v[r][j][1]); w.y = cvtpk(v[r][j][2], v[r][j][3]); if (r == 0 || has1) o8[64 * j] = w; } }
                float p[2][32];
                f32x2 vv[4][4];
#pragma unroll
                for (int j = 0; j < 4; ++j)
#pragma unroll
                    for (int c = 0; c < 4; ++c) vv[j][c] = (f32x2){v[0][j][c], v[1][j][c]};
#pragma unroll
                for (int e = 0; e < 32; ++e) { f32x2 a = (f32x2){0.f, 0.f}, a2 = (f32x2){0.f, 0.f};
#pragma unroll
                    for (int j = 0; j < 4; ++j) { const f32x4 w = *(const LAS f32x4*)(wrt + e * WRP + 4 * lane + 256 * j);
                        a = __builtin_elementwise_fma(vv[j][0], (f32x2){w[0], w[0]}, a); a2 = __builtin_elementwise_fma(vv[j][1], (f32x2){w[1], w[1]}, a2);
                        a = __builtin_elementwise_fma(vv[j][2], (f32x2){w[2], w[2]}, a); a2 = __builtin_elementwise_fma(vv[j][3], (f32x2){w[3], w[3]}, a2); }
                    a += a2; p[0][e] = a[0]; p[1][e] = a[1]; if ((e & 1) == 1) __builtin_amdgcn_sched_barrier(0); }
#pragma unroll
                for (int st = 0; st < 5; ++st) { const int half = 16 >> st, msk = 32 >> st; const bool up = (lane & msk) != 0;
#pragma unroll
                    for (int r = 0; r < 2; ++r)
#pragma unroll
                        for (int i = 0; i < half; ++i) { const float send = up ? p[r][i] : p[r][i + half], keep = up ? p[r][i + half] : p[r][i]; p[r][i] = keep + shx(send, msk, lane); } }
                const float lg0 = p[0][0] + shx(p[0][0], 1, lane) + rbias, lg1 = p[1][0] + shx(p[1][0], 1, lane) + rbias;
                if ((lane & 1) == 0) { lgl[li0 * 32 + (lane >> 1)] = lg0; if (has1) lgl[li1 * 32 + (lane >> 1)] = lg1; }
            }
            __syncthreads();
            for (int li = tid; li < nloc_rows; li += NTHR) {
                float q[32];
#pragma unroll
                for (int i = 0; i < 8; ++i) { const f32x4 t4 = *(const LAS f32x4*)(lgl + li * 32 + 4 * i); q[4 * i] = t4[0]; q[4 * i + 1] = t4[1]; q[4 * i + 2] = t4[2]; q[4 * i + 3] = t4[3]; }
                int te[4]; float tv[4];
#pragma unroll
                for (int k = 0; k < 4; ++k) { float best = q[0]; int bi = 0;
#pragma unroll
                    for (int e = 1; e < 32; ++e) { const bool gt = q[e] > best; best = gt ? q[e] : best; bi = gt ? e : bi; }
                    te[k] = bi; tv[k] = best;
#pragma unroll
                    for (int e = 0; e < 32; ++e) q[e] = (e == bi) ? -INFINITY : q[e]; }
                float ew[4], es = 0.f;
#pragma unroll
                for (int k = 0; k < 4; ++k) { ew[k] = __expf(tv[k] - tv[0]); es += ew[k]; }
                const float ies = 1.0f / es;
#pragma unroll
                for (int k = 0; k < 4; ++k) { const int lp = __hip_atomic_fetch_add(&lcount[te[k]], 1, __ATOMIC_RELAXED, __HIP_MEMORY_SCOPE_WORKGROUP);
                    ent[li * 32 + 2 * k] = (unsigned)te[k] | ((unsigned)lp << 8); ent[li * 32 + 2 * k + 1] = __float_as_uint(ew[k] * ies); }
            }
            __syncthreads();
            if (tid < 32) lcount[32 + tid] = (int)atomicAdd(&gcount[tid], (unsigned)lcount[tid]);
            __syncthreads();
            for (int i = tid; i < nloc_rows * 4; i += NTHR) { const int li = i >> 2, k = i & 3, row = bx + li * G;
                const unsigned ev = ent[li * 32 + 2 * k]; const int e = (int)(ev & 255u), pos = lcount[32 + e] + (int)(ev >> 8);
                TOKMAP[(size_t)e * ECAP + pos] = row; TOKEP[row * 4 + k] = ((unsigned)e << 24) | (unsigned)pos; TOKW[row * 4 + k] = __uint_as_float(ent[li * 32 + 2 * k + 1]); }
            __syncthreads();
        }
        SEAM(pb + 7);

        if (PHON(8) && IN(pb + 8)) {
            PH_LOCALS_X
            moe_tables(tb, gcount);
            pg8::MoeSched S; S.G = G; S.c = bx; S.npn = 8; S.gather = 1; S.tb = tb; S.tokmap = TOKMAP; S.Bt = (const char*)(WGU + (size_t)l * 32 * 2048 * 1024); S.bexp = (size_t)2048 * 1024 * 2; S.ldb2 = 2048; S.zrow = TT;
            pg8::EpiSwiglu E{ACT, INP(I_BGU) + (size_t)l * 32 * 2048};
            pg8::gemm_phase<pg8::EpiSwiglu, pg8::MoeSched>(lds, (const char*)H, 2048u, 2048u, 1024, S, E);
        }
        SEAM(pb + 8);

        if (PHON(9) && IN(pb + 9)) {
            PH_LOCALS_X
            moe_tables(tb, gcount);
            pg8::MoeSched S; S.G = G; S.c = bx; S.npn = 4; S.gather = 0; S.tb = tb; S.tokmap = TOKMAP; S.Bt = (const char*)(WD + (size_t)l * 32 * 1024 * 1024); S.bexp = (size_t)1024 * 1024 * 2; S.ldb2 = 2048; S.zrow = TT;
            pg8::EpiDown E{Y, INP(I_BD) + (size_t)l * 32 * 1024};
            pg8::gemm_phase<pg8::EpiDown, pg8::MoeSched>(lds, (const char*)ACT, 2048u, 2048u, 1024, S, E);
        }
        SEAM(pb + 9);
    }

    if (PHON(11) && IN(21)) {
        PH_LOCALS
        moe_tables(tb, ctl + CW_GCOUNT + 64);
        const float* mod1 = MOD + 1 * 5 * 6144;
        for (int rowA = gw; rowA < TL; rowA += 2 * NGW) {
            const bool hasB = rowA + NGW < TL; const int rowB = hasB ? rowA + NGW : rowA;
            f32x4 v[2][4], a[2][4];
#pragma unroll
            for (int r = 0; r < 2; ++r) { const u32x2* xr = (const u32x2*)(XRB + (size_t)(r ? rowB : rowA) * DM) + lane;
#pragma unroll
                for (int j = 0; j < 4; ++j) { const u32x2 t2 = xr[64 * j]; v[r][j] = (f32x4){bflo(t2.x), bfhi(t2.x), bflo(t2.y), bfhi(t2.y)}; a[r][j] = (f32x4){0.f, 0.f, 0.f, 0.f}; } }
            moe_gather_row(a[0], rowA, TOKEP, TOKW, tb, Y, lane);
            moe_gather_row(a[1], rowB, TOKEP, TOKW, tb, Y, lane);
#pragma unroll
            for (int r = 0; r < 2; ++r) { const int row = r ? rowB : rowA;
                if (r == 1 && !hasB) break;
                const f32x4* g2 = (const f32x4*)(mod1 + (row >> 13) * 6144 + 5 * 1024) + lane;
                f32x4* op = (f32x4*)(args.out + (size_t)row * DM) + lane;
#pragma unroll
                for (int j = 0; j < 4; ++j) op[64 * j] = v[r][j] + g2[64 * j] * a[r][j]; }
        }
    }
#undef IN
#undef SEAM
}

extern "C" void kernel_launch(void* const* d_in, const int* in_sizes, int n_in, void* d_out, int out_size, void* d_ws, size_t ws_size, hipStream_t stream) {
    static int grid = 0;
    if (grid == 0) {
        if (n_in != 33 || out_size != TL * DM || ws_size < WS_END) { fprintf(stderr, "kernel_launch: unexpected shapes (n_in %d out %d ws %zu)\n", n_in, out_size, ws_size); grid = -1; return; }
        int dev = 0, cus = 0, per_cu = 0;
        if (hipGetDevice(&dev) != hipSuccess || hipDeviceGetAttribute(&cus, hipDeviceAttributeMultiprocessorCount, dev) != hipSuccess) { grid = -1; return; }
        if (hipFuncSetAttribute((const void*)hdb_fwd, hipFuncAttributeMaxDynamicSharedMemorySize, LDS_BYTES) != hipSuccess) { fprintf(stderr, "kernel_launch: hipFuncSetAttribute failed\n"); grid = -1; return; }
        if (hipOccupancyMaxActiveBlocksPerMultiprocessor(&per_cu, (const void*)hdb_fwd, NTHR, LDS_BYTES) != hipSuccess || per_cu < 1) { fprintf(stderr, "kernel_launch: occupancy query reports %d\n", per_cu); }
        (void)hipGetLastError();
        grid = cus;
        if (grid > 256) grid = 256;
    }
    if (grid < 0) return;
    (void)hipMemsetAsync((char*)d_ws + WS_CTL, 0, CTL_ZERO_BYTES, stream);
    Args a{};
    for (int i = 0; i < 33; ++i) a.in[i] = (const float*)d_in[i];
    a.out = (float*)d_out; a.ws = (unsigned char*)d_ws;
#if MK_PER_PHASE
    for (int p = 0; p < N_PHASES; ++p) { a.ph_lo = p; a.ph_hi = p + 1; hipLaunchKernelGGL(hdb_fwd, dim3(grid), dim3(NTHR), LDS_BYTES, stream, a); }
#else
    a.ph_lo = 0; a.ph_hi = N_PHASES;
    hipLaunchKernelGGL(hdb_fwd, dim3(grid), dim3(NTHR), LDS_BYTES, stream, a);
#endif
}
```

```cpp
#include <hip/hip_runtime.h>
#include <cstdio>
#include <cstdint>

#ifndef MK_PER_PHASE
#define MK_PER_PHASE 0
#endif

#define LAS __attribute__((address_space(3)))
typedef unsigned short bf16_t;
typedef short bf16x8 __attribute__((ext_vector_type(8)));
typedef short s16x4 __attribute__((ext_vector_type(4)));
typedef float f32x4 __attribute__((ext_vector_type(4)));
typedef float f32x16 __attribute__((ext_vector_type(16)));
typedef float f32x2 __attribute__((ext_vector_type(2)));
typedef unsigned u32x4 __attribute__((ext_vector_type(4)));
typedef unsigned u32x2 __attribute__((ext_vector_type(2)));
typedef __bf16 bf16x2_t __attribute__((ext_vector_type(2)));

constexpr int DM = 1024, NB = 4, SEQ = 8192, CTXL = 256;
constexpr int TL = NB * SEQ;
constexpr int TC = NB * CTXL;
constexpr int TT = TL + TC;
constexpr int NQKV = 2560, NGATE = 4096, NIN = 6656;
constexpr int NEXP = 32, ECAP = TT;
constexpr int MAXTILES = 560;
constexpr float LOG2E = 1.4426950408889634f;
constexpr float EPSN = 1e-6f;
constexpr int QA = 0, QB_ = 256, QC = 512, QD = 768, KA = 1024, KB_ = 1152, KC = 1408, KD = 1536, VA = 1792, VB_ = 1920, VC = 2176, VD = 2304;

constexpr size_t MiB = 1u << 20;
constexpr size_t WS_CTL = 0, CTL_ZERO_BYTES = 1 * MiB;
constexpr size_t WS_MOD = 1 * MiB;
constexpr size_t WS_ROPE = 2 * MiB;
constexpr size_t WS_TOKEP = 6 * MiB;
constexpr size_t WS_TOKW = 7 * MiB;
constexpr size_t WS_TOKMAP = 8 * MiB;
constexpr size_t WS_WIN = 16 * MiB;
constexpr size_t WS_WB = 42 * MiB;
constexpr size_t WS_WO = 46 * MiB;
constexpr size_t WS_WGU = 50 * MiB;
constexpr size_t WS_WD = 306 * MiB;
constexpr size_t WS_H = 434 * MiB;
constexpr size_t WS_QKV = 501 * MiB;
constexpr size_t WS_G = 666 * MiB;
constexpr size_t WS_BR = 930 * MiB;
constexpr size_t WS_XR = 996 * MiB;
constexpr size_t WS_ACT = 1128 * MiB;
constexpr size_t WS_Y = 1408 * MiB;
constexpr size_t WS_END = 1688 * MiB;
constexpr int CW_GCOUNT = 64;
constexpr int CW_BAR = 4096;

constexpr int LDS_BYTES = 163840;
constexpr int MISC_OFF = LDS_BYTES - 1024;
constexpr int NWAVES = 8, NTHR = 512;

__device__ __forceinline__ unsigned cvtpk(float lo, float hi) { f32x2 v = {lo, hi}; bf16x2_t b = __builtin_convertvector(v, bf16x2_t); return __builtin_bit_cast(unsigned, b); }
__device__ __forceinline__ float bflo(unsigned u) { return __builtin_bit_cast(float, u << 16); }
__device__ __forceinline__ float bfhi(unsigned u) { return __builtin_bit_cast(float, u & 0xffff0000u); }
__device__ __forceinline__ float shx(float v, int m, int lane) { return __builtin_bit_cast(float, __builtin_amdgcn_ds_bpermute((lane ^ m) << 2, __builtin_bit_cast(int, v))); }
__device__ __forceinline__ float wave_sum(float v, int lane) {
#pragma unroll
    for (int o = 1; o < 64; o <<= 1) v += shx(v, o, lane);
    return v;
}
__device__ __forceinline__ float wave_max(float v, int lane) {
#pragma unroll
    for (int o = 1; o < 64; o <<= 1) v = fmaxf(v, shx(v, o, lane));
    return v;
}
#define LDS_WAIT() asm volatile("s_waitcnt lgkmcnt(0)" ::: "memory")
#define VM_WAIT() asm volatile("s_waitcnt vmcnt(0)" ::: "memory")

#define XB_TMO      128
#define XB_XCNT(j)  (256  + 64 * (j))
#define XB_XSUB(j)  (1280 + 64 * (j))
#define XB_XGEN(j)  (2304 + 64 * (j))
#define XB_TOP      3328
#define XB_TOPGEN   3392
#define XCD_BAR_WORDS 3456
#define XB_SPIN_CAP (1u << 24)

__device__ __forceinline__ unsigned xb_ld(unsigned* p)              { return __hip_atomic_load(p, __ATOMIC_RELAXED, __HIP_MEMORY_SCOPE_AGENT); }
__device__ __forceinline__ unsigned xb_add(unsigned* p, unsigned v) { return __hip_atomic_fetch_add(p, v, __ATOMIC_RELAXED, __HIP_MEMORY_SCOPE_AGENT); }
__device__ __forceinline__ unsigned xb_xcc_id() { return (unsigned)__builtin_amdgcn_s_getreg((3 << 11) | 20) & 0xFu; }
#define XB_SPIN(cond, bar) do { unsigned _sp = 0; while (cond) { __builtin_amdgcn_s_sleep(1); \
    if ((++_sp & 255u) == 0u) { if (xb_ld(&(bar)[XB_TMO])) break; if (_sp > XB_SPIN_CAP) { atomicAdd(&(bar)[XB_TMO], 1u); break; } } } } while (0)

struct XcdBarrier { unsigned* bar; unsigned x; volatile LAS unsigned* st; };

__device__ __forceinline__ XcdBarrier xcd_barrier_post(unsigned* bar, volatile LAS unsigned* st) {
    XcdBarrier b; b.bar = bar; b.x = xb_xcc_id(); b.st = st;
    if (threadIdx.x == 0) (void)xb_add(&bar[XB_XCNT(b.x)], 1u);
    return b;
}
__device__ __forceinline__ void xcd_barrier_complete(unsigned* bar, unsigned x, unsigned& nloc, unsigned& nx) {
    const unsigned G = gridDim.x * gridDim.y * gridDim.z;
    unsigned sum, cnt, mine, sp = 0u;
    for (;;) {
        sum = 0u; cnt = 0u; mine = 0u;
#pragma unroll
        for (unsigned j = 0; j < 16; ++j) { const unsigned c = xb_ld(&bar[XB_XCNT(j)]); sum += c; cnt += (c > 0u) ? 1u : 0u; mine = (j == x) ? c : mine; }
        if (sum == G) break;
        __builtin_amdgcn_s_sleep(1);
        if ((++sp & 255u) == 0u) { if (xb_ld(&bar[XB_TMO])) break; if (sp > XB_SPIN_CAP) { atomicAdd(&bar[XB_TMO], 1u); break; } }
    }
    nloc = mine > 0u ? mine : 1u; nx = cnt > 0u ? cnt : 1u;
}
__device__ __forceinline__ void xcd_barrier(const XcdBarrier& b) {
    asm volatile("s_waitcnt vmcnt(0)" ::: "memory");
    __syncthreads();
    if (threadIdx.x == 0) {
        unsigned* bar = b.bar;
        __builtin_amdgcn_s_waitcnt(0);
        unsigned nloc = b.st[0], nx = b.st[1];
        if (nloc == 0u) { xcd_barrier_complete(bar, b.x, nloc, nx); b.st[0] = nloc; b.st[1] = nx; }
        const unsigned old = xb_add(&bar[XB_XSUB(b.x)], 1u);
        const unsigned gen = old / nloc;
        if (old + 1u == (gen + 1u) * nloc) {
            __builtin_amdgcn_fence(__ATOMIC_RELEASE, "agent");
            asm volatile("s_waitcnt vmcnt(0)" ::: "memory");
            const unsigned og = xb_add(&bar[XB_TOP], 1u);
            const unsigned tg = og / nx;
            if (og + 1u == (tg + 1u) * nx) xb_add(&bar[XB_TOPGEN], 1u);
            else XB_SPIN(xb_ld(&bar[XB_TOPGEN]) == tg, bar);
            __builtin_amdgcn_fence(__ATOMIC_ACQUIRE, "agent");
            xb_add(&bar[XB_XGEN(b.x)], 1u);
            asm volatile("s_waitcnt vmcnt(0)" ::: "memory");
        } else {
            XB_SPIN(xb_ld(&bar[XB_XGEN(b.x)]) == gen, bar);
            __builtin_amdgcn_fence(__ATOMIC_ACQUIRE, "agent");
            asm volatile("s_waitcnt vmcnt(0)" ::: "memory");
        }
    }
    __syncthreads();
}

namespace pg8 {
constexpr int BM = 256, BK = 64, HALF = 128, HTB = HALF * BK * 2, STAGE_BYTES = 8 * HTB;
__host__ __device__ __forceinline__ int lds_byte(int r, int c) { const int st = (r >> 4) * 2 + (c >> 5), rr = r & 15, cc = c & 31, ob = rr * 64 + cc * 2; return st * 1024 + (ob ^ (((ob >> 9) & 1) << 5)); }
__host__ __device__ __forceinline__ void stage_rc(int b, int& R, int& C) { const int st = b / 1024, sb = b % 1024, swz = sb ^ (((sb >> 9) & 1) << 5); R = (st >> 1) * 16 + swz / 64; C = (st & 1) * 32 + (swz % 64) / 2; }
__host__ __device__ __forceinline__ int perm32(int rho) { const int n = rho >> 4, i = rho & 15; return 8 * (i >> 2) + 4 * n + (i & 3); }
struct Unit { int pm, pn, ex; };

template <class Epi, class Sched>
__device__ __forceinline__ void gemm_phase(LAS unsigned char* lds, const char* Abase, const unsigned lda2, const unsigned ldb2, const int K, const Sched& S, const Epi& E) {
    int tid_ = threadIdx.x; asm volatile("" : "+v"(tid_));
    const int tid = tid_, wid = __builtin_amdgcn_readfirstlane(tid >> 6), lane = tid & 63, wr = wid >> 2, wc = wid & 3, fr = lane & 15, fq = lane >> 4;
    const int nt = K / BK;
    int Rr[2]; unsigned Cc[2], voffB[2];
#pragma unroll
    for (int i = 0; i < 2; ++i) { int R, C; stage_rc(tid * 16 + i * 8192, R, C); const int Rb = Epi::PERM ? ((R & ~31) + perm32(R & 31)) : R;
        Rr[i] = R; Cc[i] = (unsigned)C * 2u; voffB[i] = (unsigned)Rb * ldb2 + (unsigned)C * 2u; }
    const size_t kstep = (size_t)(BK * 2);
    const size_t hstepB = (size_t)HALF * ldb2;
    const unsigned ldsw = (unsigned)wid * 1024u;
    const int aoff = lds_byte(wr * 64 + fr, fq * 8), boff = lds_byte(wc * 32 + fr, fq * 8);
#define PG8_SA(b, h) (((b) * 2 + (h)) * HTB)
#define PG8_SB(b, h) ((4 + (b) * 2 + (h)) * HTB)
#define PG8_STAGE_A(bufoff, kptr, V) do { _Pragma("unroll") for (int _i = 0; _i < 2; ++_i) \
        __builtin_amdgcn_global_load_lds((const unsigned*)((const char*)(kptr) + (V)[_i]), (LAS unsigned*)(lds + (bufoff) + ldsw + _i * 8192), 16, 0, 0); } while (0)
#define PG8_STAGE_B(bufoff, gbase) do { _Pragma("unroll") for (int _i = 0; _i < 2; ++_i) \
        __builtin_amdgcn_global_load_lds((const unsigned*)((const char*)(gbase) + voffB[_i]), (LAS unsigned*)(lds + (bufoff) + ldsw + _i * 8192), 16, 0, 0); } while (0)
#define PG8_LDA(dst, b, h) do { _Pragma("unroll") for (int m = 0; m < 4; ++m) _Pragma("unroll") for (int k = 0; k < 2; ++k) dst[m][k] = *(const LAS bf16x8*)(lds + PG8_SA(b, h) + aoff + m * 2048 + k * 1024); } while (0)
#define PG8_LDB(dst, b, h) do { _Pragma("unroll") for (int n = 0; n < 2; ++n) _Pragma("unroll") for (int k = 0; k < 2; ++k) dst[n][k] = *(const LAS bf16x8*)(lds + PG8_SB(b, h) + boff + n * 2048 + k * 1024); } while (0)
#define PG8_MMA(ai, bj, At, Bt) do { __builtin_amdgcn_s_setprio(1); _Pragma("unroll") for (int m = 0; m < 4; ++m) _Pragma("unroll") for (int n = 0; n < 2; ++n) _Pragma("unroll") for (int k = 0; k < 2; ++k) \
        acc[ai][bj][m][n] = __builtin_amdgcn_mfma_f32_16x16x32_bf16(Bt[n][k], At[m][k], acc[ai][bj][m][n], 0, 0, 0); __builtin_amdgcn_s_setprio(0); } while (0)
#define PG8_WAIT_V(n) asm volatile("s_waitcnt vmcnt(" #n ")" ::: "memory")
#define PG8_WAIT_L(n) asm volatile("s_waitcnt lgkmcnt(" #n ")" ::: "memory")
#define PG8_BAR __builtin_amdgcn_s_barrier()
#define PG8_SCHED __builtin_amdgcn_sched_barrier(0)
#define PG8_FILLA(dst, u) do { const unsigned ko_ = S.akoff(u); _Pragma("unroll") for (int h_ = 0; h_ < 2; ++h_) _Pragma("unroll") for (int i_ = 0; i_ < 2; ++i_) \
        dst[h_][i_] = (unsigned)S.arow(u, h_ * 128 + Rr[i_]) * lda2 + Cc[i_] + ko_; } while (0)
    Unit cur, nxt; int ui = 0;
    if (!S.next(0, cur)) return;
    f32x4 acc[2][2][4][2];
#pragma unroll
    for (int a = 0; a < 2; ++a)
#pragma unroll
        for (int b = 0; b < 2; ++b)
#pragma unroll
            for (int m = 0; m < 4; ++m)
#pragma unroll
                for (int n = 0; n < 2; ++n) acc[a][b][m][n] = (f32x4){0.f, 0.f, 0.f, 0.f};
    bf16x8 At[4][2], B0[2][2], B1[2][2];
    unsigned vA[2][2], nvA[2][2];
    PG8_FILLA(vA, cur);
    const char* cB = S.bptr(cur);
    constexpr bool HN = Epi::HALFN;
    if constexpr (HN) {
        PG8_STAGE_B(PG8_SB(0, 0), cB); PG8_STAGE_A(PG8_SA(0, 0), Abase, vA[0]); PG8_STAGE_A(PG8_SA(0, 1), Abase, vA[1]);
        if (wr == 1) PG8_BAR;
        PG8_WAIT_V(2); PG8_BAR;
        PG8_STAGE_B(PG8_SB(1, 0), cB + kstep); PG8_STAGE_A(PG8_SA(1, 0), Abase + kstep, vA[0]);
        PG8_WAIT_V(4); PG8_BAR;
    } else {
    PG8_STAGE_B(PG8_SB(0, 0), cB); PG8_STAGE_B(PG8_SB(0, 1), cB + hstepB); PG8_STAGE_A(PG8_SA(0, 0), Abase, vA[0]); PG8_STAGE_A(PG8_SA(0, 1), Abase, vA[1]);
    if (wr == 1) PG8_BAR;
    PG8_WAIT_V(2); PG8_BAR;
    PG8_STAGE_B(PG8_SB(1, 0), cB + kstep); PG8_STAGE_A(PG8_SA(1, 0), Abase + kstep, vA[0]); PG8_STAGE_B(PG8_SB(1, 1), cB + hstepB + kstep);
    PG8_WAIT_V(6); PG8_BAR;
    }
    for (;;) {
        const bool has_next = S.next(ui + 1, nxt);
        const char* nB = cB;
        if (has_next) { PG8_FILLA(nvA, nxt); nB = S.bptr(nxt); }
        else {
#pragma unroll
            for (int h = 0; h < 2; ++h)
#pragma unroll
                for (int i = 0; i < 2; ++i) nvA[h][i] = vA[h][i];
        }
        for (int t = 0; t < nt; t += 2) {
            const bool last = (t == nt - 2);
            const char* a1k = Abase + (size_t)(t + 1) * kstep;
            const char* a2k = last ? Abase : Abase + (size_t)(t + 2) * kstep; const char* b2 = last ? nB : cB + (size_t)(t + 2) * kstep;
            const char* a3k = a2k + kstep; const char* b3 = b2 + kstep;
            unsigned s0[2], s1[2];
#pragma unroll
            for (int i = 0; i < 2; ++i) { s0[i] = last ? nvA[0][i] : vA[0][i]; s1[i] = last ? nvA[1][i] : vA[1][i]; }
            if constexpr (HN) {
            PG8_LDB(B0, 0, 0); PG8_SCHED; PG8_LDA(At, 0, 0); PG8_STAGE_A(PG8_SA(1, 1), a1k, vA[1]);
            PG8_WAIT_V(6); PG8_WAIT_L(0); PG8_BAR; PG8_MMA(0, 0, At, B0); PG8_BAR; PG8_SCHED;
            PG8_LDA(At, 0, 1); PG8_STAGE_B(PG8_SB(0, 0), b2); PG8_STAGE_A(PG8_SA(0, 0), a2k, s0);
            PG8_WAIT_V(6); PG8_WAIT_L(0); PG8_BAR; PG8_MMA(1, 0, At, B0); PG8_BAR; PG8_SCHED;
            PG8_LDB(B0, 1, 0); PG8_SCHED; PG8_LDA(At, 1, 0); PG8_STAGE_A(PG8_SA(0, 1), a2k, s1);
            PG8_WAIT_V(6); PG8_WAIT_L(0); PG8_BAR; PG8_MMA(0, 0, At, B0); PG8_BAR; PG8_SCHED;
            PG8_LDA(At, 1, 1); PG8_STAGE_B(PG8_SB(1, 0), b3); PG8_STAGE_A(PG8_SA(1, 0), a3k, s0);
            PG8_WAIT_V(6); PG8_WAIT_L(0); PG8_BAR; PG8_MMA(1, 0, At, B0); PG8_BAR; PG8_SCHED;
            } else {
            PG8_LDB(B0, 0, 0); PG8_LDB(B1, 0, 1); PG8_SCHED; PG8_LDA(At, 0, 0); PG8_STAGE_A(PG8_SA(1, 1), a1k, vA[1]);
            PG8_WAIT_V(8); PG8_WAIT_L(0); PG8_BAR; PG8_MMA(0, 0, At, B0); PG8_MMA(0, 1, At, B1); PG8_BAR; PG8_SCHED;
            PG8_LDA(At, 0, 1); PG8_STAGE_B(PG8_SB(0, 0), b2); PG8_STAGE_B(PG8_SB(0, 1), b2 + hstepB); PG8_STAGE_A(PG8_SA(0, 0), a2k, s0);
            PG8_WAIT_V(8); PG8_WAIT_L(0); PG8_BAR; PG8_MMA(1, 0, At, B0); PG8_MMA(1, 1, At, B1); PG8_BAR; PG8_SCHED;
            PG8_LDB(B0, 1, 0); PG8_LDB(B1, 1, 1); PG8_SCHED; PG8_LDA(At, 1, 0); PG8_STAGE_A(PG8_SA(0, 1), a2k, s1);
            PG8_WAIT_V(8); PG8_WAIT_L(0); PG8_BAR; PG8_MMA(0, 0, At, B0); PG8_MMA(0, 1, At, B1); PG8_BAR; PG8_SCHED;
            PG8_LDA(At, 1, 1); PG8_STAGE_B(PG8_SB(1, 0), b3); PG8_STAGE_B(PG8_SB(1, 1), b3 + hstepB); PG8_STAGE_A(PG8_SA(1, 0), a3k, s0);
            PG8_WAIT_V(8); PG8_WAIT_L(0); PG8_BAR; PG8_MMA(1, 0, At, B0); PG8_MMA(1, 1, At, B1); PG8_BAR; PG8_SCHED;
            }
        }
        if (wr == 0) PG8_BAR;
        E(acc, cur, wr, wc, fr, fq);
        if (!has_next) break;
#pragma unroll
        for (int a = 0; a < 2; ++a)
#pragma unroll
            for (int b = 0; b < 2; ++b)
#pragma unroll
                for (int m = 0; m < 4; ++m)
#pragma unroll
                    for (int n = 0; n < 2; ++n) acc[a][b][m][n] = (f32x4){0.f, 0.f, 0.f, 0.f};
        cur = nxt; cB = nB; ++ui;
#pragma unroll
        for (int h = 0; h < 2; ++h)
#pragma unroll
            for (int i = 0; i < 2; ++i) vA[h][i] = nvA[h][i];
        if (wr == 1) PG8_BAR;
    }
    PG8_WAIT_V(0);
    PG8_BAR;
#undef PG8_SA
#undef PG8_SB
#undef PG8_STAGE_A
#undef PG8_STAGE_B
#undef PG8_LDA
#undef PG8_LDB
#undef PG8_MMA
#undef PG8_WAIT_V
#undef PG8_WAIT_L
#undef PG8_BAR
#undef PG8_SCHED
#undef PG8_FILLA
}

struct DenseSched {
    int nM, nN, nwg, G, c; const char* Bt; unsigned ldb2; int kmul;
    __device__ __forceinline__ bool next(int i, Unit& u) const {
        const long L = (long)i * G + c; if (L >= nwg) return false;
        int wgid = (int)L; { const int q = nwg / 8, r = nwg % 8, xcd = wgid % 8, off = wgid / 8; wgid = (xcd < r ? xcd * (q + 1) : r * (q + 1) + (xcd - r) * q) + off; }
        const int nig = 8 * nN, gid = wgid / nig, fm = gid * 8, gsz = (nM - fm) < 8 ? (nM - fm) : 8;
        u.pm = fm + ((wgid % nig) % gsz); u.pn = (wgid % nig) / gsz; u.ex = 0; return true;
    }
    __device__ __forceinline__ int arow(const Unit& u, int r) const { return u.pm * 256 + r; }
    __device__ __forceinline__ unsigned akoff(const Unit& u) const { return (unsigned)((u.pn >> 2) * kmul); }
    __device__ __forceinline__ const char* bptr(const Unit& u) const { return Bt + (size_t)u.pn * 256 * ldb2; }
};
struct BranchSched {
    int nM, nwg, G, c; const char* Bt;
    __device__ __forceinline__ bool next(int i, Unit& u) const {
        const long L = (long)(i >> 2) * G + c; if (L >= nwg) return false;
        int wgid = (int)L; { const int q = nwg / 8, r = nwg % 8, xcd = wgid % 8, off = wgid / 8; wgid = (xcd < r ? xcd * (q + 1) : r * (q + 1) + (xcd - r) * q) + off; }
        const int nig = 8 * 4, gid = wgid / nig, fm = gid * 8, gsz = (nM - fm) < 8 ? (nM - fm) : 8;
        u.pm = fm + ((wgid % nig) % gsz); u.pn = (i & 3) * 4 + (wgid % nig) / gsz; u.ex = 0; return true;
    }
    __device__ __forceinline__ int arow(const Unit& u, int r) const { return u.pm * 256 + r; }
    __device__ __forceinline__ unsigned akoff(const Unit& u) const { return (unsigned)((u.pn >> 2) * 512); }
    __device__ __forceinline__ const char* bptr(const Unit& u) const { return Bt + (size_t)u.pn * 256 * 512; }
};
struct BranchSchedH {
    int nM, nwg, G, c; const char* Bt;
    __device__ __forceinline__ bool next(int i, Unit& u) const {
        const long L = (long)(i >> 2) * G + c; if (L >= nwg) return false;
        int wgid = (int)L; { const int q = nwg / 8, r = nwg % 8, xcd = wgid % 8, off = wgid / 8; wgid = (xcd < r ? xcd * (q + 1) : r * (q + 1) + (xcd - r) * q) + off; }
        const int nig = 8 * 8, gid = wgid / nig, fm = gid * 8, gsz = (nM - fm) < 8 ? (nM - fm) : 8;
        u.pm = fm + ((wgid % nig) % gsz); u.pn = (wgid % nig) / gsz; u.ex = i & 3; return true;
    }
    __device__ __forceinline__ int arow(const Unit& u, int r) const { return u.pm * 256 + r; }
    __device__ __forceinline__ unsigned akoff(const Unit& u) const { return (unsigned)(u.ex * 512); }
    __device__ __forceinline__ const char* bptr(const Unit& u) const { return Bt + (size_t)(u.ex * 1024 + u.pn * 128) * 512; }
};
struct EpiBranchH {
    static constexpr bool PERM = true, HALFN = true;
    const bf16_t* Gt; bf16_t* SUMB; mutable f32x4 S[2][4][2];
    __device__ __forceinline__ void operator()(const f32x4 (&acc)[2][2][4][2], const Unit& u, int wr, int wc, int fr, int fq) const {
        const int row0 = u.pm * BM + wr * 64 + fr, scol0 = u.pn * 128 + wc * 32 + 8 * fq, gcol0 = u.ex * 1024 + scol0;
        const bool first = u.ex == 0, lastb = u.ex == 3; const int tid_ = (wr * 4 + wc) * 64 + fq * 16 + fr; (void)gcol0;
#pragma unroll
        for (int ai = 0; ai < 2; ++ai)
#pragma unroll
            for (int m = 0; m < 4; ++m) { const size_t row = (size_t)(row0 + ai * HALF + m * 16);
                const u32x4 g = *(const u32x4*)(Gt + ((((size_t)u.pm * 32 + (u.ex * 8 + u.pn)) * 8 + (ai * 4 + m)) * 512 + tid_) * 8);
                const f32x4 v0 = acc[ai][0][m][0], v1 = acc[ai][0][m][1];
                f32x4 s0 = (f32x4){v0[0] * bflo(g.x), v0[1] * bfhi(g.x), v0[2] * bflo(g.y), v0[3] * bfhi(g.y)};
                f32x4 s1 = (f32x4){v1[0] * bflo(g.z), v1[1] * bfhi(g.z), v1[2] * bflo(g.w), v1[3] * bfhi(g.w)};
                if (!first) { s0 += S[ai][m][0]; s1 += S[ai][m][1]; }
                S[ai][m][0] = s0; S[ai][m][1] = s1;
                if (lastb) { u32x4 w; w.x = cvtpk(s0[0], s0[1]); w.y = cvtpk(s0[2], s0[3]); w.z = cvtpk(s1[0], s1[1]); w.w = cvtpk(s1[2], s1[3]);
                    *(u32x4*)(SUMB + row * DM + scol0) = w; } }
    }
};
struct MoeSched {
    int G, c, npn, gather; const LAS int* tb; const int* tokmap; const char* Bt; size_t bexp; unsigned ldb2; int zrow;
    __device__ __forceinline__ bool next(int i, Unit& u) const {
        const int ntl = tb[32];
        int tile, pn;
        if ((G & 7) == 0 && (G >> 3) % npn == 0) {
            const int x = c & 7, j = c >> 3, tpr = (G >> 3) / npn;
            tile = (i * tpr + j / npn) * 8 + x; pn = j % npn;
            if (tile >= ntl) return false;
        } else { const int idx = i * G + c; if (idx >= ntl * npn) return false; tile = idx / npn; pn = idx - tile * npn; }
        u.pm = tile; u.pn = pn;
        int e = 0;
#pragma unroll 1
        for (int k = 1; k < 32; ++k) e = (tb[k] <= tile) ? k : e;
        u.ex = e; return true;
    }
    __device__ __forceinline__ int arow(const Unit& u, int r) const {
        if (!gather) return u.pm * 256 + r;
        const int p = (u.pm - tb[u.ex]) * 256 + r;
        return (p < tb[64 + u.ex]) ? tokmap[(size_t)u.ex * ECAP + p] : zrow;
    }
    __device__ __forceinline__ unsigned akoff(const Unit&) const { return 0u; }
    __device__ __forceinline__ const char* bptr(const Unit& u) const { return Bt + (size_t)u.ex * bexp + (size_t)u.pn * 256 * ldb2; }
};

__device__ __forceinline__ float sigmoidf_(float v) { return __builtin_amdgcn_rcpf(1.0f + __builtin_amdgcn_exp2f(-v * LOG2E)); }

struct EpiIn {
    static constexpr bool PERM = true, HALFN = false;
    bf16_t* QKV; bf16_t* Gt; const float* bgate;
    __device__ __forceinline__ void operator()(const f32x4 (&acc)[2][2][4][2], const Unit& u, int wr, int wc, int fr, int fq) const {
        const int row0 = u.pm * BM + wr * 64 + fr;
        const bool isg = u.pn >= 10;
        const int colt = isg ? (u.pn - 10) * 256 : u.pn * 256, ldc = isg ? NGATE : NQKV;
        bf16_t* base = isg ? Gt : QKV;
        const int col0 = colt + wc * 32 + 8 * fq;
        f32x4 bv[2][2];
#pragma unroll
        for (int bj = 0; bj < 2; ++bj)
#pragma unroll
            for (int n = 0; n < 2; ++n) bv[bj][n] = isg ? *(const f32x4*)(bgate + col0 + bj * HALF + 4 * n) : (f32x4){0.f, 0.f, 0.f, 0.f};
#pragma unroll
        for (int ai = 0; ai < 2; ++ai)
#pragma unroll
            for (int m = 0; m < 4; ++m) { bf16_t* rowp = base + (size_t)(row0 + ai * HALF + m * 16) * ldc + col0;
#pragma unroll
                for (int bj = 0; bj < 2; ++bj) { f32x4 v0 = acc[ai][bj][m][0] + bv[bj][0], v1 = acc[ai][bj][m][1] + bv[bj][1];
                    if (isg) {
#pragma unroll
                        for (int q = 0; q < 4; ++q) { v0[q] = sigmoidf_(v0[q]); v1[q] = sigmoidf_(v1[q]); } }
                    u32x4 w; w.x = cvtpk(v0[0], v0[1]); w.y = cvtpk(v0[2], v0[3]); w.z = cvtpk(v1[0], v1[1]); w.w = cvtpk(v1[2], v1[3]);
                    if (isg) { const int tid_ = (wr * 4 + wc) * 64 + fq * 16 + fr, ch = (u.pn - 10) * 2 + bj;
                        *(u32x4*)(Gt + ((((size_t)u.pm * 32 + ch) * 8 + (ai * 4 + m)) * 512 + tid_) * 8) = w; }
                    else *(u32x4*)(rowp + bj * HALF) = w; } }
    }
};
struct EpiBranch {
    static constexpr bool PERM = true, HALFN = false;
    const bf16_t* Gt; bf16_t* SUMB;
    __device__ __forceinline__ void operator()(const f32x4 (&acc)[2][2][4][2], const Unit& u, int wr, int wc, int fr, int fq) const {
        const int row0 = u.pm * BM + wr * 64 + fr, col0 = u.pn * 256 + wc * 32 + 8 * fq, scol0 = (u.pn & 3) * 256 + wc * 32 + 8 * fq;
        const bool first = (u.pn >> 2) == 0;
#pragma unroll
        for (int ai = 0; ai < 2; ++ai)
#pragma unroll
            for (int m = 0; m < 4; ++m) { const bf16_t* rowp = Gt + (size_t)(row0 + ai * HALF + m * 16) * NGATE + col0; bf16_t* outp = SUMB + (size_t)(row0 + ai * HALF + m * 16) * DM + scol0;
#pragma unroll
                for (int bj = 0; bj < 2; ++bj) { const u32x4 g = *(const u32x4*)(rowp + bj * HALF);
                    u32x4 so = (u32x4){0u, 0u, 0u, 0u}; if (!first) so = *(const u32x4*)(outp + bj * HALF);
                    const f32x4 v0 = acc[ai][bj][m][0], v1 = acc[ai][bj][m][1];
                    u32x4 w; w.x = cvtpk(v0[0] * bflo(g.x) + bflo(so.x), v0[1] * bfhi(g.x) + bfhi(so.x)); w.y = cvtpk(v0[2] * bflo(g.y) + bflo(so.y), v0[3] * bfhi(g.y) + bfhi(so.y));
                    w.z = cvtpk(v1[0] * bflo(g.z) + bflo(so.z), v1[1] * bfhi(g.z) + bfhi(so.z)); w.w = cvtpk(v1[2] * bflo(g.w) + bflo(so.w), v1[3] * bfhi(g.w) + bfhi(so.w));
                    *(u32x4*)(outp + bj * HALF) = w; } }
    }
};
struct EpiOut {
    static constexpr bool PERM = true, HALFN = false;
    const float* x0; const float* c0; bf16_t* XRB; const float* mod; int layer;
    __device__ __forceinline__ void operator()(const f32x4 (&acc)[2][2][4][2], const Unit& u, int wr, int wc, int fr, int fq) const {
        const int rt = u.pm * BM;
        const int ridx = rt < TL ? (rt >> 13) : 4;
        const float* srcf = rt < TL ? x0 + (size_t)rt * DM : c0 + (size_t)(rt - TL) * DM;
        bf16_t* dst = XRB + (size_t)rt * DM;
        const float* g1 = mod + ridx * 6144 + 2 * 1024;
        const int col0 = u.pn * BM + wc * 32 + 8 * fq;
#pragma unroll
        for (int ai = 0; ai < 2; ++ai)
#pragma unroll
            for (int m = 0; m < 4; ++m) { const size_t off = (size_t)(ai * HALF + wr * 64 + m * 16 + fr) * DM + col0;
#pragma unroll
                for (int bj = 0; bj < 2; ++bj) { const int cc = bj * HALF;
                    const f32x4 ga = *(const f32x4*)(g1 + col0 + cc), gb = *(const f32x4*)(g1 + col0 + cc + 4);
                    f32x4 xa, xb;
                    if (layer) { const u32x4 xx = *(const u32x4*)(dst + off + cc); xa = (f32x4){bflo(xx.x), bfhi(xx.x), bflo(xx.y), bfhi(xx.y)}; xb = (f32x4){bflo(xx.z), bfhi(xx.z), bflo(xx.w), bfhi(xx.w)}; }
                    else { xa = *(const f32x4*)(srcf + off + cc); xb = *(const f32x4*)(srcf + off + cc + 4); }
                    const f32x4 ra = xa + ga * acc[ai][bj][m][0], rb = xb + gb * acc[ai][bj][m][1];
                    u32x4 w; w.x = cvtpk(ra[0], ra[1]); w.y = cvtpk(ra[2], ra[3]); w.z = cvtpk(rb[0], rb[1]); w.w = cvtpk(rb[2], rb[3]);
                    *(u32x4*)(dst + off + cc) = w; } }
    }
};
struct EpiSwiglu {
    static constexpr bool PERM = true, HALFN = false;
    bf16_t* ACT; const float* bgu;
    __device__ __forceinline__ void operator()(const f32x4 (&acc)[2][2][4][2], const Unit& u, int wr, int wc, int fr, int fq) const {
        const int row0 = u.pm * BM + wr * 64 + fr, j0 = u.pn * 128 + wc * 32 + 8 * fq;
        const float* bg = bgu + (size_t)u.ex * 2048 + j0;
        f32x4 bgv[2], buv[2];
#pragma unroll
        for (int n = 0; n < 2; ++n) { bgv[n] = *(const f32x4*)(bg + 4 * n); buv[n] = *(const f32x4*)(bg + 1024 + 4 * n); }
#pragma unroll
        for (int ai = 0; ai < 2; ++ai)
#pragma unroll
            for (int m = 0; m < 4; ++m) { bf16_t* rowp = ACT + (size_t)(row0 + ai * HALF + m * 16) * DM + j0;
                float o[8];
#pragma unroll
                for (int n = 0; n < 2; ++n)
#pragma unroll
                    for (int q = 0; q < 4; ++q) { float g = acc[ai][0][m][n][q] + bgv[n][q], up = acc[ai][1][m][n][q] + buv[n][q];
                        g = fminf(g, 7.0f); up = fminf(fmaxf(up, -7.0f), 7.0f);
                        o[n * 4 + q] = g * sigmoidf_(1.702f * g) * (up + 1.0f); }
                u32x4 w; w.x = cvtpk(o[0], o[1]); w.y = cvtpk(o[2], o[3]); w.z = cvtpk(o[4], o[5]); w.w = cvtpk(o[6], o[7]);
                *(u32x4*)rowp = w; }
    }
};
struct EpiDown {
    static constexpr bool PERM = true, HALFN = false;
    bf16_t* Y; const float* bd;
    __device__ __forceinline__ void operator()(const f32x4 (&acc)[2][2][4][2], const Unit& u, int wr, int wc, int fr, int fq) const {
        const int row0 = u.pm * BM + wr * 64 + fr, col0 = u.pn * 256 + wc * 32 + 8 * fq;
        const float* bp = bd + (size_t)u.ex * 1024 + col0;
        f32x4 bv[2][2];
#pragma unroll
        for (int bj = 0; bj < 2; ++bj)
#pragma unroll
            for (int n = 0; n < 2; ++n) bv[bj][n] = *(const f32x4*)(bp + bj * HALF + 4 * n);
#pragma unroll
        for (int ai = 0; ai < 2; ++ai)
#pragma unroll
            for (int m = 0; m < 4; ++m) { bf16_t* rowp = Y + (size_t)(row0 + ai * HALF + m * 16) * DM + col0;
#pragma unroll
                for (int bj = 0; bj < 2; ++bj) { const f32x4 v0 = acc[ai][bj][m][0] + bv[bj][0], v1 = acc[ai][bj][m][1] + bv[bj][1];
                    u32x4 w; w.x = cvtpk(v0[0], v0[1]); w.y = cvtpk(v0[2], v0[3]); w.z = cvtpk(v1[0], v1[1]); w.w = cvtpk(v1[2], v1[3]);
                    *(u32x4*)(rowp + bj * HALF) = w; } }
    }
};
}

namespace att {
constexpr int SLOTB = 8192, LDS_K = 0, LDS_V = 3 * SLOTB, LDS_BIAS = 7 * SLOTB, LDS_Q = 7 * SLOTB + 2048;
__device__ __forceinline__ int crow(int r, int hi) { return (r & 3) + 8 * (r >> 2) + 4 * hi; }
__device__ __forceinline__ void glds16(const void* gsrc, unsigned lds_dst) { unsigned keep;
    asm volatile("s_mov_b32 %0, m0\n\ts_mov_b32 m0, %2\n\ts_nop 0\n\tglobal_load_lds_dwordx4 %1, off\n\ts_mov_b32 m0, %0" : "=&s"(keep) : "v"(gsrc), "s"(lds_dst) : "memory"); }
typedef LAS const char* lds_cptr;
typedef short v4i16_t __attribute__((ext_vector_type(4)));
__device__ __forceinline__ s16x4 vtr(lds_cptr p) { return __builtin_bit_cast(s16x4, __builtin_amdgcn_ds_read_tr16_b64_v4i16((LAS v4i16_t*)p)); }
#define ATT_WAIT_BAR(N) do { __builtin_amdgcn_sched_barrier(0); asm volatile("s_waitcnt vmcnt(" #N ") lgkmcnt(0)\n\ts_barrier" ::: "memory"); __builtin_amdgcn_sched_barrier(0); } while (0)
#define ATT_BAR() do { __builtin_amdgcn_sched_barrier(0); asm volatile("s_waitcnt lgkmcnt(0)\n\ts_barrier" ::: "memory"); __builtin_amdgcn_sched_barrier(0); } while (0)
#define ATT_MFMA(a, b, c) __builtin_amdgcn_mfma_f32_32x32x16_bf16(a, b, c, 0, 0, 0)

struct UnitP {
    int qrow0;
    int qcol, kcol, vcol, ocol;
    int locrow0, nloc;
    int ctxrow0;
    int qpos0;
    int kpos0;
    float linit;
    float lam, outscale;
    const float* subln;
    const float* qgain;
    const f32x2* rope;
};

template <int MODE>
__device__ __forceinline__ void attn_unit(LAS unsigned char* shm, const bf16_t* __restrict__ QKV, bf16_t* BR, const UnitP& P) {
    int tid_ = threadIdx.x; asm volatile("" : "+v"(tid_));
    const int tid = tid_, lane = tid & 63, r32 = lane & 31, hi = lane >> 5; const int wid = __builtin_amdgcn_readfirstlane(tid >> 6);
    const int grp = wid >> 2;
    const unsigned lds0 = (unsigned)(uintptr_t)shm;
    const char* kbase = (const char*)QKV + (size_t)P.kcol * 2 + wid * 16 + (size_t)lane * (NQKV * 2);
    const char* vbase = (const char*)QKV + (size_t)P.vcol * 2 + ((wid >> 2) * 32 + (lane & 3) * 8) * 2 + (size_t)(16 * (wid & 3) + (lane >> 2)) * (NQKV * 2);
    const unsigned kdst = lds0 + LDS_K + wid * 1024, vdst = lds0 + LDS_V + wid * 1024;
    const int nloc = P.nloc, NT = nloc + 4;
#define ATT_TROW(t) ((t) < nloc ? P.locrow0 + 64 * (t) : P.ctxrow0 + 64 * ((t) - nloc))
#define ATT_DMA(t, ks, vs) do { const size_t ro_ = (size_t)ATT_TROW(t) * (NQKV * 2); \
        glds16(kbase + ro_, (unsigned)__builtin_amdgcn_readfirstlane(kdst + (ks) * SLOTB)); glds16(vbase + ro_, (unsigned)__builtin_amdgcn_readfirstlane(vdst + (vs) * SLOTB)); } while (0)
    ATT_DMA(0, 0, 0); ATT_DMA(1, 1, 1);
    bf16x8 qr[4];
    LAS bf16x8* qlds = (LAS bf16x8*)(shm + LDS_Q + wid * 4096) + lane;
    {
      const bf16_t* Qw = QKV + (size_t)(P.qrow0 + r32) * NQKV + P.qcol + hi * 8;
      u32x4 raw[4];
#pragma unroll
      for (int d0 = 0; d0 < 4; ++d0) raw[d0] = *reinterpret_cast<const u32x4*>(Qw + d0 * 16);
      float x[4][8];
#pragma unroll
      for (int d0 = 0; d0 < 4; ++d0) { x[d0][0] = bflo(raw[d0].x); x[d0][1] = bfhi(raw[d0].x); x[d0][2] = bflo(raw[d0].y); x[d0][3] = bfhi(raw[d0].y);
          x[d0][4] = bflo(raw[d0].z); x[d0][5] = bfhi(raw[d0].z); x[d0][6] = bflo(raw[d0].w); x[d0][7] = bfhi(raw[d0].w); }
      const f32x2* rt = P.rope ? P.rope + (size_t)(P.qpos0 + r32) * 48 : nullptr;
      if (MODE == 1) {
#pragma unroll
          for (int c = 0; c < 2; ++c) { float ss = 0.f;
#pragma unroll
              for (int dd = 0; dd < 2; ++dd)
#pragma unroll
                  for (int e = 0; e < 8; ++e) ss += x[2 * c + dd][e] * x[2 * c + dd][e];
              ss += shx(ss, 32, lane);
              const float rs = __builtin_amdgcn_rsqf(ss * (1.0f / 32.0f) + EPSN);
#pragma unroll
              for (int dd = 0; dd < 2; ++dd)
#pragma unroll
                  for (int e = 0; e < 8; ++e) x[2 * c + dd][e] *= rs * P.qgain[16 * dd + 8 * hi + e];
              if (rt) {
#pragma unroll
                  for (int e = 0; e < 8; ++e) { const f32x2 cs = rt[32 + 8 * hi + e]; const float a = x[2 * c][e], b = x[2 * c + 1][e];
                      x[2 * c][e] = a * cs.x - b * cs.y; x[2 * c + 1][e] = a * cs.y + b * cs.x; } } }
      } else {
          float ss = 0.f;
#pragma unroll
          for (int d0 = 0; d0 < 4; ++d0)
#pragma unroll
              for (int e = 0; e < 8; ++e) ss += x[d0][e] * x[d0][e];
          ss += shx(ss, 32, lane);
          const float rs = __builtin_amdgcn_rsqf(ss * (1.0f / 64.0f) + EPSN);
#pragma unroll
          for (int d0 = 0; d0 < 4; ++d0)
#pragma unroll
              for (int e = 0; e < 8; ++e) x[d0][e] *= rs * P.qgain[16 * d0 + 8 * hi + e];
          if (rt) {
#pragma unroll
              for (int d0 = 0; d0 < 2; ++d0)
#pragma unroll
                  for (int e = 0; e < 8; ++e) { const f32x2 cs = rt[16 * d0 + 8 * hi + e]; const float a = x[d0][e], b = x[d0 + 2][e];
                      x[d0][e] = a * cs.x - b * cs.y; x[d0 + 2][e] = a * cs.y + b * cs.x; } }
      }
      const float qs = (MODE == 1 ? 0.17677669529663687f : 0.125f) * LOG2E;
#pragma unroll
      for (int d0 = 0; d0 < 4; ++d0) { u32x4 w; w.x = cvtpk(x[d0][0] * qs, x[d0][1] * qs); w.y = cvtpk(x[d0][2] * qs, x[d0][3] * qs); w.z = cvtpk(x[d0][4] * qs, x[d0][5] * qs); w.w = cvtpk(x[d0][6] * qs, x[d0][7] * qs);
          qr[d0] = __builtin_bit_cast(bf16x8, w); if (MODE == 1) qlds[d0 * 64] = qr[d0]; } }
    f32x16 o[2], o2[2]; o[0] = f32x16{}; o[1] = f32x16{}; o2[0] = f32x16{}; o2[1] = f32x16{};
    float l1 = (hi == 0) ? P.linit : 0.f, l2 = 0.f;
    f32x16 pa0 = f32x16{}, pa1 = f32x16{}, pb0 = f32x16{}, pb1 = f32x16{};
    u32x4 pw[4], pv2[4];
#pragma unroll
    for (int i = 0; i < 4; ++i) { pw[i] = (u32x4){0u, 0u, 0u, 0u}; pv2[i] = (u32x4){0u, 0u, 0u, 0u}; }
    const int qpos = P.qpos0 + r32;
    const int qrow_w = P.qpos0 >> 6, r0w = min(max(qrow_w - 4, 0), 120);
    const int qc = qpos & 63, c0q = min(max(qc - 8, 0), 48);
    const LAS float* biasT = (const LAS float*)(shm + LDS_BIAS);
    const lds_cptr kp0 = (lds_cptr)shm + LDS_K + hi * 1024 + r32 * 16;
    const lds_cptr vp0 = (lds_cptr)shm + LDS_V + ((lane >> 4) & 1) * 32 + (lane & 3) * 8 + (4 * hi + ((lane & 15) >> 2)) * 64;
#define ATT_ACTIVE(t) ( (MODE == 2 && (t) < nloc) ? ((P.kpos0 + 64 * (t) <= P.qpos0 + 31 + 128) && (P.kpos0 + 64 * (t) + 63 >= P.qpos0 - 128)) : \
                        (MODE == 3 && (t) < nloc) ? ((((P.kpos0 >> 6) + (t)) >= r0w) && (((P.kpos0 >> 6) + (t)) < r0w + 8)) : true )
#define ATT_SOFT(P0, P1, LS, PW, t) do { \
        if (MODE == 2 && (t) < nloc) { const int kb_ = P.kpos0 + 64 * (t) - qpos; \
            _Pragma("unroll") for (int r = 0; r < 16; ++r) { const int d = kb_ + crow(r, hi); \
                if (d > 128 || d < -128) P0[r] = -INFINITY; \
                if (d + 32 > 128 || d + 32 < -128) P1[r] = -INFINITY; } } \
        if (MODE == 3 && (t) < nloc) { const int kr_ = (P.kpos0 >> 6) + (t); const int rb_ = (kr_ - qrow_w + 7) * 31 + 15 - qc; \
            _Pragma("unroll") for (int r = 0; r < 16; ++r) { const int kc = crow(r, hi); \
                { const bool ok = (unsigned)(kc - c0q) < 16u; const float bz = biasT[ok ? rb_ + kc : 0]; P0[r] = ok ? P0[r] + bz : -INFINITY; } \
                { const bool ok = (unsigned)(kc + 32 - c0q) < 16u; const float bz = biasT[ok ? rb_ + kc + 32 : 0]; P1[r] = ok ? P1[r] + bz : -INFINITY; } } } \
        float s_ = 0.f; \
        _Pragma("unroll") for (int r = 0; r < 16; ++r) { P0[r] = __builtin_amdgcn_exp2f(P0[r]); P1[r] = __builtin_amdgcn_exp2f(P1[r]); s_ += P0[r] + P1[r]; } \
        LS += s_; \
        PW[0] = (u32x4){cvtpk(P0[0], P0[1]), cvtpk(P0[2], P0[3]), cvtpk(P0[4], P0[5]), cvtpk(P0[6], P0[7])}; \
        PW[1] = (u32x4){cvtpk(P0[8], P0[9]), cvtpk(P0[10], P0[11]), cvtpk(P0[12], P0[13]), cvtpk(P0[14], P0[15])}; \
        PW[2] = (u32x4){cvtpk(P1[0], P1[1]), cvtpk(P1[2], P1[3]), cvtpk(P1[4], P1[5]), cvtpk(P1[6], P1[7])}; \
        PW[3] = (u32x4){cvtpk(P1[8], P1[9]), cvtpk(P1[10], P1[11]), cvtpk(P1[12], P1[13]), cvtpk(P1[14], P1[15])}; } while (0)
#define ATT_S(t) do { if (ATT_ACTIVE(t)) { ATT_SOFT(pa0, pa1, l1, pw, t); if (MODE == 1) ATT_SOFT(pb0, pb1, l2, pv2, t); } } while (0)
#define ATT_PV(tp, vsp) do { if (MODE < 2 || ATT_ACTIVE(tp)) { const lds_cptr vp = vp0 + (vsp) * SLOTB; \
            _Pragma("unroll") for (int dh = 0; dh < 2; ++dh) { _Pragma("unroll") for (int ks = 0; ks < 4; ++ks) { \
                const s16x4 vl = vtr(vp + dh * 4096 + ks * 1024), vh = vtr(vp + dh * 4096 + ks * 1024 + 512); \
                const bf16x8 vf = (bf16x8){vl[0], vl[1], vl[2], vl[3], vh[0], vh[1], vh[2], vh[3]}; \
                o[dh] = ATT_MFMA(vf, __builtin_bit_cast(bf16x8, pw[ks]), o[dh]); \
                if (MODE == 1) o2[dh] = ATT_MFMA(vf, __builtin_bit_cast(bf16x8, pv2[ks]), o2[dh]); } \
                } } \
        } while (0)
#define ATT_QK(t, ksc) do { if (MODE < 2 || ATT_ACTIVE(t)) { const lds_cptr kp = kp0 + (ksc) * SLOTB; \
            if (MODE == 1) { \
                _Pragma("unroll") for (int d0 = 0; d0 < 2; ++d0) { const bf16x8 k0 = *(const LAS bf16x8*)(kp + d0 * 2048), k1 = *(const LAS bf16x8*)(kp + d0 * 2048 + 512); const bf16x8 qf = qlds[d0 * 64]; \
                    pa0 = ATT_MFMA(k0, qf, d0 == 0 ? f32x16{} : pa0); pa1 = ATT_MFMA(k1, qf, d0 == 0 ? f32x16{} : pa1); } \
                _Pragma("unroll") for (int d0 = 2; d0 < 4; ++d0) { const bf16x8 k0 = *(const LAS bf16x8*)(kp + d0 * 2048), k1 = *(const LAS bf16x8*)(kp + d0 * 2048 + 512); const bf16x8 qf = qlds[d0 * 64]; \
                    pb0 = ATT_MFMA(k0, qf, d0 == 2 ? f32x16{} : pb0); pb1 = ATT_MFMA(k1, qf, d0 == 2 ? f32x16{} : pb1); } \
            } else { \
                _Pragma("unroll") for (int d0 = 0; d0 < 4; ++d0) { const bf16x8 k0 = *(const LAS bf16x8*)(kp + d0 * 2048), k1 = *(const LAS bf16x8*)(kp + d0 * 2048 + 512); \
                    pa0 = ATT_MFMA(k0, qr[d0], d0 == 0 ? f32x16{} : pa0); pa1 = ATT_MFMA(k1, qr[d0], d0 == 0 ? f32x16{} : pa1); } } } } while (0)
#define ATT_TOP(t) do { if ((t) + 1 < NT) { ATT_WAIT_BAR(2); } else { ATT_WAIT_BAR(0); } \
        if ((t) + 2 < NT) { ATT_DMA((t) + 2, (k3 == 0) ? 2 : k3 - 1, ((t) + 2) & 3); } } while (0)
    int k3 = 0;
    if (grp == 0) {
        ATT_TOP(0); ATT_QK(0, 0); ATT_BAR(); ATT_S(0);
        k3 = 1;
        for (int t = 1; t < NT; ++t) {
            ATT_TOP(t);
            __builtin_amdgcn_s_setprio(1); ATT_PV(t - 1, (t + 3) & 3); ATT_QK(t, k3); __builtin_amdgcn_s_setprio(0);
            ATT_BAR();
            ATT_S(t);
            k3 = (k3 == 2) ? 0 : k3 + 1;
        }
        ATT_BAR();
        ATT_PV(NT - 1, (NT + 3) & 3);
        ATT_BAR();
    } else {
        ATT_TOP(0); ATT_BAR(); ATT_QK(0, 0);
        k3 = 1;
        for (int t = 1; t < NT; ++t) {
            ATT_TOP(t);
            ATT_S(t - 1);
            ATT_BAR();
            __builtin_amdgcn_s_setprio(1); ATT_PV(t - 1, (t + 3) & 3); ATT_QK(t, k3); __builtin_amdgcn_s_setprio(0);
            k3 = (k3 == 2) ? 0 : k3 + 1;
        }
        ATT_BAR();
        ATT_S(NT - 1);
        ATT_BAR();
        ATT_PV(NT - 1, (NT + 3) & 3);
    }
    l1 += shx(l1, 32, lane);
    const float i1 = 1.0f / l1;
    bf16_t* orow = BR + (size_t)(P.qrow0 + r32) * DM + P.ocol + 4 * hi;
    if (MODE == 1) {
        l2 += shx(l2, 32, lane);
        const float i2 = P.lam / l2;
        float ss = 0.f;
#pragma unroll
        for (int dh = 0; dh < 2; ++dh)
#pragma unroll
            for (int r = 0; r < 16; ++r) { const float v = o[dh][r] * i1 - o2[dh][r] * i2; o[dh][r] = v; ss += v * v; }
        ss += shx(ss, 32, lane);
        const float rs = __builtin_amdgcn_rsqf(ss * (1.0f / 64.0f) + EPSN) * P.outscale;
#pragma unroll
        for (int dh = 0; dh < 2; ++dh)
#pragma unroll
            for (int g = 0; g < 4; ++g) { const f32x4 sg = *(const f32x4*)(P.subln + dh * 32 + 8 * g + 4 * hi);
                u32x2 w; w.x = cvtpk(o[dh][4 * g] * rs * sg[0], o[dh][4 * g + 1] * rs * sg[1]); w.y = cvtpk(o[dh][4 * g + 2] * rs * sg[2], o[dh][4 * g + 3] * rs * sg[3]);
                *(u32x2*)(orow + dh * 32 + 8 * g) = w; }
    } else {
#pragma unroll
        for (int dh = 0; dh < 2; ++dh)
#pragma unroll
            for (int g = 0; g < 4; ++g) { u32x2 w; w.x = cvtpk(o[dh][4 * g] * i1, o[dh][4 * g + 1] * i1); w.y = cvtpk(o[dh][4 * g + 2] * i1, o[dh][4 * g + 3] * i1);
                *(u32x2*)(orow + dh * 32 + 8 * g) = w; }
    }
    ATT_BAR();
#undef ATT_TROW
#undef ATT_DMA
#undef ATT_ACTIVE
#undef ATT_SOFT
#undef ATT_S
#undef ATT_PV
#undef ATT_TOP
#undef ATT_QK
}

__device__ __forceinline__ void attn_unit_a2(LAS unsigned char* shm, const bf16_t* __restrict__ QKV, bf16_t* BR, const UnitP& P) {
    int tid_ = threadIdx.x; asm volatile("" : "+v"(tid_));
    const int tid = tid_, lane = tid & 63, r32 = lane & 31, hi = lane >> 5; const int wid = __builtin_amdgcn_readfirstlane(tid >> 6);
    const int grp = wid >> 2;
    const unsigned lds0 = (unsigned)(uintptr_t)shm;
    const char* kbase = (const char*)QKV + (size_t)P.kcol * 2 + wid * 16 + (size_t)lane * (NQKV * 2);
    const char* vbase = (const char*)QKV + (size_t)P.vcol * 2 + ((wid >> 2) * 32 + (lane & 3) * 8) * 2 + (size_t)(16 * (wid & 3) + (lane >> 2)) * (NQKV * 2);
    const unsigned kdst = lds0 + LDS_K + wid * 1024, vdst = lds0 + LDS_V + wid * 1024;
    const int nloc = P.nloc, NT = nloc + 4;
#define A2_TROW(t) ((t) < nloc ? P.locrow0 + 64 * (t) : P.ctxrow0 + 64 * ((t) - nloc))
#define A2_DMA(t, ks, vs) do { const size_t ro_ = (size_t)A2_TROW(t) * (NQKV * 2); \
        glds16(kbase + ro_, (unsigned)__builtin_amdgcn_readfirstlane(kdst + (ks) * SLOTB)); glds16(vbase + ro_, (unsigned)__builtin_amdgcn_readfirstlane(vdst + (vs) * SLOTB)); } while (0)
    A2_DMA(0, 0, 0); A2_DMA(1, 1, 1);
    bf16x8 qr[2][4];
    LAS bf16x8* qlds = (LAS bf16x8*)(shm + LDS_Q + wid * 8192) + lane;
#pragma unroll
    for (int j = 0; j < 2; ++j) {
        const bf16_t* Qw = QKV + (size_t)(P.qrow0 + 32 * j + r32) * NQKV + P.qcol + hi * 8;
        u32x4 raw[4];
#pragma unroll
        for (int d0 = 0; d0 < 4; ++d0) raw[d0] = *reinterpret_cast<const u32x4*>(Qw + d0 * 16);
        float x[4][8];
#pragma unroll
        for (int d0 = 0; d0 < 4; ++d0) { x[d0][0] = bflo(raw[d0].x); x[d0][1] = bfhi(raw[d0].x); x[d0][2] = bflo(raw[d0].y); x[d0][3] = bfhi(raw[d0].y);
            x[d0][4] = bflo(raw[d0].z); x[d0][5] = bfhi(raw[d0].z); x[d0][6] = bflo(raw[d0].w); x[d0][7] = bfhi(raw[d0].w); }
        const f32x2* rt = P.rope ? P.rope + (size_t)(P.qpos0 + 32 * j + r32) * 48 : nullptr;
        float ss = 0.f;
#pragma unroll
        for (int d0 = 0; d0 < 4; ++d0)
#pragma unroll
            for (int e = 0; e < 8; ++e) ss += x[d0][e] * x[d0][e];
        ss += shx(ss, 32, lane);
        const float rs = __builtin_amdgcn_rsqf(ss * (1.0f / 64.0f) + EPSN);
#pragma unroll
        for (int d0 = 0; d0 < 4; ++d0)
#pragma unroll
            for (int e = 0; e < 8; ++e) x[d0][e] *= rs * P.qgain[16 * d0 + 8 * hi + e];
        if (rt) {
#pragma unroll
            for (int d0 = 0; d0 < 2; ++d0)
#pragma unroll
                for (int e = 0; e < 8; ++e) { const f32x2 cs = rt[16 * d0 + 8 * hi + e]; const float a = x[d0][e], b = x[d0 + 2][e];
                    x[d0][e] = a * cs.x - b * cs.y; x[d0 + 2][e] = a * cs.y + b * cs.x; } }
        const float qs = 0.125f * LOG2E;
#pragma unroll
        for (int d0 = 0; d0 < 4; ++d0) { u32x4 w; w.x = cvtpk(x[d0][0] * qs, x[d0][1] * qs); w.y = cvtpk(x[d0][2] * qs, x[d0][3] * qs); w.z = cvtpk(x[d0][4] * qs, x[d0][5] * qs); w.w = cvtpk(x[d0][6] * qs, x[d0][7] * qs);
            qr[j][d0] = __builtin_bit_cast(bf16x8, w); qlds[(j * 4 + d0) * 64] = qr[j][d0]; }
    }
    f32x16 o[2][2]; float l1[2] = {0.f, 0.f};
#pragma unroll
    for (int j = 0; j < 2; ++j) { o[j][0] = f32x16{}; o[j][1] = f32x16{}; }
    f32x16 pa[2][2];
#pragma unroll
    for (int j = 0; j < 2; ++j) { pa[j][0] = f32x16{}; pa[j][1] = f32x16{}; }
    u32x4 pw[2][4];
#pragma unroll
    for (int j = 0; j < 2; ++j)
#pragma unroll
        for (int i = 0; i < 4; ++i) pw[j][i] = (u32x4){0u, 0u, 0u, 0u};
    const lds_cptr kp0 = (lds_cptr)shm + LDS_K + hi * 1024 + r32 * 16;
    const lds_cptr vp0 = (lds_cptr)shm + LDS_V + ((lane >> 4) & 1) * 32 + (lane & 3) * 8 + (4 * hi + ((lane & 15) >> 2)) * 64;
#define A2_S() do { _Pragma("unroll") for (int j = 0; j < 2; ++j) { float s_ = 0.f; \
        _Pragma("unroll") for (int r = 0; r < 16; ++r) { pa[j][0][r] = __builtin_amdgcn_exp2f(pa[j][0][r]); pa[j][1][r] = __builtin_amdgcn_exp2f(pa[j][1][r]); s_ += pa[j][0][r] + pa[j][1][r]; } \
        l1[j] += s_; \
        pw[j][0] = (u32x4){cvtpk(pa[j][0][0], pa[j][0][1]), cvtpk(pa[j][0][2], pa[j][0][3]), cvtpk(pa[j][0][4], pa[j][0][5]), cvtpk(pa[j][0][6], pa[j][0][7])}; \
        pw[j][1] = (u32x4){cvtpk(pa[j][0][8], pa[j][0][9]), cvtpk(pa[j][0][10], pa[j][0][11]), cvtpk(pa[j][0][12], pa[j][0][13]), cvtpk(pa[j][0][14], pa[j][0][15])}; \
        pw[j][2] = (u32x4){cvtpk(pa[j][1][0], pa[j][1][1]), cvtpk(pa[j][1][2], pa[j][1][3]), cvtpk(pa[j][1][4], pa[j][1][5]), cvtpk(pa[j][1][6], pa[j][1][7])}; \
        pw[j][3] = (u32x4){cvtpk(pa[j][1][8], pa[j][1][9]), cvtpk(pa[j][1][10], pa[j][1][11]), cvtpk(pa[j][1][12], pa[j][1][13]), cvtpk(pa[j][1][14], pa[j][1][15])}; } } while (0)
#define A2_PV(vsp) do { const lds_cptr vp = vp0 + (vsp) * SLOTB; \
        _Pragma("unroll") for (int dh = 0; dh < 2; ++dh) _Pragma("unroll") for (int ks = 0; ks < 4; ++ks) { \
            const s16x4 vl = vtr(vp + dh * 4096 + ks * 1024), vh = vtr(vp + dh * 4096 + ks * 1024 + 512); \
            const bf16x8 vf = (bf16x8){vl[0], vl[1], vl[2], vl[3], vh[0], vh[1], vh[2], vh[3]}; \
            o[0][dh] = ATT_MFMA(vf, __builtin_bit_cast(bf16x8, pw[0][ks]), o[0][dh]); o[1][dh] = ATT_MFMA(vf, __builtin_bit_cast(bf16x8, pw[1][ks]), o[1][dh]); } } while (0)
#define A2_QK(ksc) do { const lds_cptr kp = kp0 + (ksc) * SLOTB; \
        _Pragma("unroll") for (int d0 = 0; d0 < 4; ++d0) { const bf16x8 k0 = *(const LAS bf16x8*)(kp + d0 * 2048), k1 = *(const LAS bf16x8*)(kp + d0 * 2048 + 512); \
            const bf16x8 q0_ = qlds[d0 * 64], q1_ = qlds[(4 + d0) * 64]; \
            pa[0][0] = ATT_MFMA(k0, q0_, d0 == 0 ? f32x16{} : pa[0][0]); pa[1][0] = ATT_MFMA(k0, q1_, d0 == 0 ? f32x16{} : pa[1][0]); \
            pa[0][1] = ATT_MFMA(k1, q0_, d0 == 0 ? f32x16{} : pa[0][1]); pa[1][1] = ATT_MFMA(k1, q1_, d0 == 0 ? f32x16{} : pa[1][1]); } } while (0)
#define A2_TOP(t) do { if ((t) + 1 < NT) { ATT_WAIT_BAR(2); } else { ATT_WAIT_BAR(0); } \
        if ((t) + 2 < NT) { A2_DMA((t) + 2, (k3 == 0) ? 2 : k3 - 1, ((t) + 2) & 3); } } while (0)
    int k3 = 0;
    if (grp == 0) {
        A2_TOP(0); A2_QK(0); ATT_BAR(); A2_S();
        k3 = 1;
        for (int t = 1; t < NT; ++t) {
            A2_TOP(t);
            __builtin_amdgcn_s_setprio(1); A2_PV((t + 3) & 3); A2_QK(k3); __builtin_amdgcn_s_setprio(0);
            ATT_BAR();
            A2_S();
            k3 = (k3 == 2) ? 0 : k3 + 1;
        }
        ATT_BAR();
        A2_PV((NT + 3) & 3);
        ATT_BAR();
    } else {
        A2_TOP(0); ATT_BAR(); A2_QK(0);
        k3 = 1;
        for (int t = 1; t < NT; ++t) {
            A2_TOP(t);
            A2_S();
            ATT_BAR();
            __builtin_amdgcn_s_setprio(1); A2_PV((t + 3) & 3); A2_QK(k3); __builtin_amdgcn_s_setprio(0);
            k3 = (k3 == 2) ? 0 : k3 + 1;
        }
        ATT_BAR();
        A2_S();
        ATT_BAR();
        A2_PV((NT + 3) & 3);
    }
#pragma unroll
    for (int j = 0; j < 2; ++j) {
        float lt = l1[j]; lt += shx(lt, 32, lane);
        const float i1 = 1.0f / lt;
        bf16_t* orow = BR + (size_t)(P.qrow0 + 32 * j + r32) * DM + P.ocol + 4 * hi;
#pragma unroll
        for (int dh = 0; dh < 2; ++dh)
#pragma unroll
            for (int g = 0; g < 4; ++g) { u32x2 w; w.x = cvtpk(o[j][dh][4 * g] * i1, o[j][dh][4 * g + 1] * i1); w.y = cvtpk(o[j][dh][4 * g + 2] * i1, o[j][dh][4 * g + 3] * i1);
                *(u32x2*)(orow + dh * 32 + 8 * g) = w; }
    }
    ATT_BAR();
#undef A2_TROW
#undef A2_DMA
#undef A2_S
#undef A2_PV
#undef A2_QK
#undef A2_TOP
}
}

struct Args { const float* in[33]; float* out; unsigned char* ws; int ph_lo, ph_hi; };
enum { I_X = 0, I_C, I_CTX, I_CCTX, I_N1G, I_N2G, I_WADA, I_BADA, I_WIN, I_BGATE, I_AQN, I_AKN, I_BQN, I_BKN, I_LQ1, I_LK1, I_LQ2, I_LK2, I_SUBLN, I_CQN, I_CKN, I_SINK, I_DQN, I_DKN, I_RPB,
       I_WBR, I_WOUT, I_RW, I_RB, I_WGU, I_BGU, I_WD, I_BD };
constexpr int N_PHASES = 22;

__device__ __forceinline__ void p0_transpose_item(const float* __restrict__ W, int K, int N, bf16_t* WT, int item, int lane, LAS float* scr, bool gu_perm) {
    const int nblk = N >> 5, kb = item / nblk, nb = item - kb * nblk, k0 = 64 * kb, n0 = 32 * nb;
#pragma unroll 8
    for (int i = 0; i < 32; ++i) { const int kk = 2 * i + (lane >> 5); scr[kk * 33 + (lane & 31)] = W[(size_t)(k0 + kk) * N + n0 + (lane & 31)]; }
    LDS_WAIT();
    const int c = lane & 7;
    const int rowbase = gu_perm ? (((n0 & 1023) >> 7) * 256 + (n0 >> 10) * 128 + (n0 & 127)) : n0;
#pragma unroll
    for (int j = 0; j < 4; ++j) { const int n = (lane >> 3) + 8 * j; const LAS float* s = scr + (8 * c) * 33 + n;
        u32x4 o; o.x = cvtpk(s[0 * 33], s[1 * 33]); o.y = cvtpk(s[2 * 33], s[3 * 33]); o.z = cvtpk(s[4 * 33], s[5 * 33]); o.w = cvtpk(s[6 * 33], s[7 * 33]);
        *(u32x4*)(WT + (size_t)(rowbase + n) * K + k0 + 8 * c) = o; }
    LDS_WAIT();
}

__device__ __forceinline__ void moe_tables(LAS int* tb, const unsigned* gcount) {
    if (threadIdx.x == 0) { int s = 0;
        for (int e = 0; e < 32; ++e) { const int c = (int)gcount[e]; tb[e] = s; tb[64 + e] = c; s += (c + 255) >> 8; }
        tb[32] = s; }
    __syncthreads();
}
__device__ __forceinline__ void moe_gather_row(f32x4 (&a)[4], int row, const unsigned* tokep, const float* tokw, const LAS int* tb, const bf16_t* Y, int lane) {
#pragma unroll
    for (int k = 0; k < 4; ++k) { const unsigned ep = tokep[row * 4 + k]; const float w = tokw[row * 4 + k];
        const int e = (int)(ep >> 24), pos = (int)(ep & 0xffffffu); const size_t slot = (size_t)tb[e] * 256 + pos;
        const u32x2* yp = (const u32x2*)(Y + slot * DM) + lane;
#pragma unroll
        for (int j = 0; j < 4; ++j) { const u32x2 u = yp[64 * j]; a[j][0] += w * bflo(u.x); a[j][1] += w * bfhi(u.x); a[j][2] += w * bflo(u.y); a[j][3] += w * bfhi(u.y); } }
}

__global__ void __launch_bounds__(NTHR, 2) hdb_fwd(Args args) {
    extern __shared__ __attribute__((aligned(16))) unsigned char lds_raw[];
    LAS unsigned char* lds = (LAS unsigned char*)lds_raw;
    const int tid0 = threadIdx.x, wid = __builtin_amdgcn_readfirstlane(tid0 >> 6);
    const int G = gridDim.x, bx = blockIdx.x;
typedef const __attribute__((address_space(4))) char* K4;
#define INP(i) (*(const float* const __attribute__((address_space(4)))*)(kargs_ + 8 * (i)))
#define PH_LOCALS_X PH_LOCALS const float* modl = MOD + l * 5 * 6144; (void)modl;
#define PH_LOCALS K4 kargs_ = (K4)__builtin_amdgcn_kernarg_segment_ptr(); asm volatile("" : "+s"(kargs_)); unsigned char* wsl = *(unsigned char* const __attribute__((address_space(4)))*)(kargs_ + 272); int tid = tid0; asm volatile("" : "+v"(tid)); const int lane = tid & 63; const int gw = bx * NWAVES + wid, NGW = G * NWAVES; (void)lane; (void)gw; (void)NGW;
    unsigned char* ws = args.ws;
    unsigned* ctl = (unsigned*)(ws + WS_CTL);
    LAS int* tb = (LAS int*)(lds + MISC_OFF);
    volatile LAS unsigned* barst = (volatile LAS unsigned*)(lds + MISC_OFF + 512);
    if (tid0 < 4) barst[tid0] = 0u;
    __syncthreads();
    XcdBarrier bar; bar.bar = ctl + CW_BAR; bar.x = 0; bar.st = nullptr;
    if (!MK_PER_PHASE) bar = xcd_barrier_post(ctl + CW_BAR, barst);
    const int lo = args.ph_lo, hi_ph = args.ph_hi;
#ifndef PHMASK
#define PHMASK 0xfff
#endif
#define PHON(b) (((PHMASK) >> (b)) & 1)
#ifndef REPMASK
#define REPMASK 0
#endif
#define NREP(b) ((((REPMASK) >> (b)) & 1) ? 2 : 1)
#define IN(k) (lo <= (k) && (k) < hi_ph)
#define SEAM(k) do { if (!MK_PER_PHASE && IN(k) && IN((k) + 1)) xcd_barrier(bar); } while (0)

#define MOD ((float*)(wsl + WS_MOD))
#define ROPE ((f32x2*)(wsl + WS_ROPE))
#define TOKEP ((unsigned*)(wsl + WS_TOKEP))
#define TOKW ((float*)(wsl + WS_TOKW))
#define TOKMAP ((int*)(wsl + WS_TOKMAP))
#define WIN ((bf16_t*)(wsl + WS_WIN))
#define WB ((bf16_t*)(wsl + WS_WB))
#define WO ((bf16_t*)(wsl + WS_WO))
#define WGU ((bf16_t*)(wsl + WS_WGU))
#define WD ((bf16_t*)(wsl + WS_WD))
#define H ((bf16_t*)(wsl + WS_H))
#define QKV ((bf16_t*)(wsl + WS_QKV))
#define GT ((bf16_t*)(wsl + WS_G))
#define BR ((bf16_t*)(wsl + WS_BR))
#define XRB ((bf16_t*)(wsl + WS_XR))
#define ACT ((bf16_t*)(wsl + WS_ACT))
#define Y ((bf16_t*)(wsl + WS_Y))

    if (PHON(10) && IN(0)) {
        PH_LOCALS
        for (int it = bx; it < 192; it += G) {
            const int l = it / 96, col0 = (it % 96) * 64;
            LAS float* sl = (LAS float*)lds; LAS float* part = (LAS float*)(lds + 20480);
            for (int i = tid; i < 5 * 1024; i += NTHR) { const int r = i >> 10, k = i & 1023; const float v = (r < 4) ? INP(I_C)[r * 1024 + k] : INP(I_CCTX)[k]; sl[i] = v / (1.0f + __expf(-v)); }
            __syncthreads();
            float acc[5] = {0.f, 0.f, 0.f, 0.f, 0.f};
            const float* wp = INP(I_WADA) + ((size_t)l * 1024 + wid * 128) * 6144 + col0 + lane;
#pragma unroll 16
            for (int kk = 0; kk < 128; ++kk) { const float w = wp[(size_t)kk * 6144];
#pragma unroll
                for (int r = 0; r < 5; ++r) acc[r] += sl[r * 1024 + wid * 128 + kk] * w; }
#pragma unroll
            for (int r = 0; r < 5; ++r) part[(wid * 5 + r) * 64 + lane] = acc[r];
            __syncthreads();
            if (tid < 320) { const int r = tid >> 6, ln = tid & 63; float s = 0.f;
#pragma unroll
                for (int w = 0; w < 8; ++w) s += part[(w * 5 + r) * 64 + ln];
                MOD[(l * 5 + r) * 6144 + col0 + ln] = s + INP(I_BADA)[l * 6144 + col0 + ln]; }
            __syncthreads();
        }
        for (int i = bx * NTHR + tid; i < SEQ * 48; i += G * NTHR) {
            const int t = i / 48, j = i - t * 48; const float row = (float)(t >> 6), col = (float)(t & 63);
            float ang;
            if (j < 32) { const int jj = j & 15; const float inv = powf(10000.0f, -(float)jj / 16.0f); ang = (j < 16 ? row : col) * inv; }
            else { const int j2 = j - 32, jj = j2 & 7; const float inv = powf(10000.0f, -(float)jj / 8.0f); ang = (j2 < 8 ? row : col) * inv; }
            float sn, cs; sincosf(ang, &sn, &cs);
            ROPE[i] = (f32x2){cs, sn};
        }
        if (bx == 0) for (int i = tid; i < DM / 2; i += NTHR) ((unsigned*)(H + (size_t)TT * DM))[i] = 0u;
        {
            LAS float* scr = (LAS float*)(lds + wid * 16384);
            constexpr int I_IN = 2 * 16 * 208, I_BRN = 8 * 4 * 32, I_OUT = 2 * 16 * 32, I_GU = 64 * 16 * 64, I_DN = 64 * 16 * 32;
            constexpr int NITEMS = I_IN + I_BRN + I_OUT + I_GU + I_DN;
            unsigned* qhead = ctl + 3100; LAS int* qslot = (LAS int*)(lds + MISC_OFF + 768);
            for (;;) {
                __syncthreads();
                if (tid == 0) qslot[0] = (int)__hip_atomic_fetch_add(qhead, 64u, __ATOMIC_RELAXED, __HIP_MEMORY_SCOPE_AGENT);
                __syncthreads();
                const int c0 = qslot[0];
                if (c0 >= NITEMS) break;
                const int c1 = min(c0 + 64, NITEMS);
            for (int it = c0 + wid; it < c1; it += NWAVES) {
                int r = it;
                if (r < I_IN) { const int l = r / 3328, q = r % 3328; p0_transpose_item(INP(I_WIN) + (size_t)l * 1024 * NIN, 1024, NIN, WIN + (size_t)l * NIN * 1024, q, lane, scr, false); continue; } r -= I_IN;
                if (r < I_BRN) { const int mtx = r / 128, q = r % 128; p0_transpose_item(INP(I_WBR) + (size_t)mtx * 256 * 1024, 256, 1024, WB + (size_t)mtx * 1024 * 256, q, lane, scr, false); continue; } r -= I_BRN;
                if (r < I_OUT) { const int l = r / 512, q = r % 512; p0_transpose_item(INP(I_WOUT) + (size_t)l * 1024 * 1024, 1024, 1024, WO + (size_t)l * 1024 * 1024, q, lane, scr, false); continue; } r -= I_OUT;
                if (r < I_GU) { const int mtx = r / 1024, q = r % 1024; p0_transpose_item(INP(I_WGU) + (size_t)mtx * 1024 * 2048, 1024, 2048, WGU + (size_t)mtx * 2048 * 1024, q, lane, scr, true); continue; } r -= I_GU;
                { const int mtx = r / 512, q = r % 512; p0_transpose_item(INP(I_WD) + (size_t)mtx * 1024 * 1024, 1024, 1024, WD + (size_t)mtx * 1024 * 1024, q, lane, scr, false); }
            }
            }
        }
    }
    SEAM(0);
#ifdef PROBE_BARS
    for (int i_ = 0; i_ < PROBE_BARS; ++i_) xcd_barrier(bar);
#endif

    for (int l = 0; l < 2; ++l) {
        const int pb = 1 + 10 * l;
        const int nrows_m = l == 0 ? TT : TL;
        unsigned* gcount = ctl + CW_GCOUNT + 64 * l;

        if (PHON(0) && IN(pb + 0)) {
            PH_LOCALS_X
            if (l == 1) moe_tables(tb, ctl + CW_GCOUNT);
            const float* g2prev = MOD + 0 * 5 * 6144;
            const f32x4* gn = (const f32x4*)(INP(I_N1G) + l * DM) + lane;
            for (int rowA = gw; rowA < TT; rowA += 2 * NGW) {
                const bool hasB = rowA + NGW < TT; const int rowB = hasB ? rowA + NGW : rowA;
                f32x4 v[2][4], a[2][4];
#pragma unroll
                for (int r = 0; r < 2; ++r) { const int row = r ? rowB : rowA;
                    if (l == 0) { const f32x4* xr = (const f32x4*)(row < TL ? INP(I_X) + (size_t)row * DM : INP(I_CTX) + (size_t)(row - TL) * DM) + lane;
#pragma unroll
                        for (int j = 0; j < 4; ++j) v[r][j] = xr[64 * j]; }
                    else { const u32x2* xr = (const u32x2*)(XRB + (size_t)row * DM) + lane;
#pragma unroll
                        for (int j = 0; j < 4; ++j) { const u32x2 t2 = xr[64 * j]; v[r][j] = (f32x4){bflo(t2.x), bfhi(t2.x), bflo(t2.y), bfhi(t2.y)}; } }
#pragma unroll
                    for (int j = 0; j < 4; ++j) a[r][j] = (f32x4){0.f, 0.f, 0.f, 0.f}; }
                if (l == 1) {
                    moe_gather_row(a[0], rowA, TOKEP, TOKW, tb, Y, lane);
                    moe_gather_row(a[1], rowB, TOKEP, TOKW, tb, Y, lane);
                }
#pragma unroll
                for (int r = 0; r < 2; ++r) { const int row = r ? rowB : rowA; const int ridx = row < TL ? (row >> 13) : 4;
                    if (r == 1 && !hasB) break;
                    if (l == 1) { u32x2* xw = (u32x2*)(XRB + (size_t)row * DM) + lane; const f32x4* g2 = (const f32x4*)(g2prev + ridx * 6144 + 5 * 1024) + lane;
#pragma unroll
                        for (int j = 0; j < 4; ++j) { v[r][j] += g2[64 * j] * a[r][j]; u32x2 w2; w2.x = cvtpk(v[r][j][0], v[r][j][1]); w2.y = cvtpk(v[r][j][2], v[r][j][3]); xw[64 * j] = w2; } }
                    float ss = 0.f;
#pragma unroll
                    for (int j = 0; j < 4; ++j) ss += (v[r][j][0] * v[r][j][0] + v[r][j][1] * v[r][j][1]) + (v[r][j][2] * v[r][j][2] + v[r][j][3] * v[r][j][3]);
                    const float rstd = __builtin_amdgcn_rsqf(wave_sum(ss, lane) * (1.0f / DM) + EPSN);
                    const f32x4* sh = (const f32x4*)(modl + ridx * 6144) + lane; const f32x4* sc = (const f32x4*)(modl + ridx * 6144 + 1024) + lane;
                    u32x2* o8 = (u32x2*)(H + (size_t)row * DM) + lane;
#pragma unroll
                    for (int j = 0; j < 4; ++j) { const f32x4 y = (v[r][j] * rstd * gn[64 * j]) * (sc[64 * j] + 1.0f) + sh[64 * j];
                        u32x2 w; w.x = cvtpk(y[0], y[1]); w.y = cvtpk(y[2], y[3]); o8[64 * j] = w; } }
            }
        }
        SEAM(pb + 0);

        if (PHON(1) && IN(pb + 1)) {
            PH_LOCALS_X
            pg8::DenseSched S; S.nM = TT / 256; S.nN = NIN / 256; S.nwg = S.nM * S.nN; S.G = G; S.c = bx; S.Bt = (const char*)(WIN + (size_t)l * NIN * 1024); S.ldb2 = 2048; S.kmul = 0;
            pg8::EpiIn E{QKV, GT, INP(I_BGATE) + l * NGATE};
            pg8::gemm_phase<pg8::EpiIn, pg8::DenseSched>(lds, (const char*)H, 2048u, 2048u, 1024, S, E);
        }
        SEAM(pb + 1);

        if (PHON(2) && IN(pb + 2)) {
            PH_LOCALS_X
            const int total = TT * 96, S4 = G * NTHR;
            for (int i0 = bx * NTHR + tid; i0 < total; i0 += 4 * S4) {
                u32x4 uu[4]; f32x4 gg[4][2], rr[4][4]; int rows[4], prs[4]; bool ok[4];
#pragma unroll
                for (int q = 0; q < 4; ++q) { const int i = i0 + q * S4; ok[q] = i < total; const int ii = ok[q] ? i : i0;
                    rows[q] = ii / 96; prs[q] = ii - rows[q] * 96;
                    const int kc = prs[q] >> 3, p = prs[q] & 7; const int mixer = kc < 2 ? 0 : (kc < 6 ? 1 : (kc < 8 ? 2 : 3)); const bool is32 = mixer == 1;
                    uu[q] = *(const u32x4*)(QKV + (size_t)rows[q] * NQKV + 1024 + kc * 64 + p * 8);
                    const int gi = mixer == 0 ? I_AKN : mixer == 1 ? I_BKN : mixer == 2 ? I_CKN : I_DKN;
                    const float* gain = INP(gi) + l * (is32 ? 32 : 64) + (is32 ? (p & 3) : p) * 8;
                    gg[q][0] = *(const f32x4*)gain; gg[q][1] = *(const f32x4*)(gain + 4);
                    const f32x4* rt = (const f32x4*)(ROPE + (size_t)(rows[q] & (SEQ - 1)) * 48 + (is32 ? 32 + (p & 1) * 8 : (p & 3) * 8));
#pragma unroll
                    for (int e = 0; e < 4; ++e) rr[q][e] = rt[e]; }
#pragma unroll
                for (int q = 0; q < 4; ++q) {
                    const int row = rows[q], kc = prs[q] >> 3, p = prs[q] & 7;
                    const int mixer = kc < 2 ? 0 : (kc < 6 ? 1 : (kc < 8 ? 2 : 3));
                    const u32x4 u = uu[q];
                    float x[8] = {bflo(u.x), bfhi(u.x), bflo(u.y), bfhi(u.y), bflo(u.z), bfhi(u.z), bflo(u.w), bfhi(u.w)};
                    float ss = 0.f;
#pragma unroll
                    for (int e = 0; e < 8; ++e) ss += x[e] * x[e];
                    ss += shx(ss, 1, lane); ss += shx(ss, 2, lane);
                    const float s4 = shx(ss, 4, lane);
                    const bool is32 = mixer == 1;
                    if (!is32) ss += s4;
                    const float rs = __builtin_amdgcn_rsqf(ss * (is32 ? 1.0f / 32.0f : 1.0f / 64.0f) + EPSN);
#pragma unroll
                    for (int e = 0; e < 4; ++e) { x[e] *= rs * gg[q][0][e]; x[4 + e] *= rs * gg[q][1][e]; }
                    const bool rope = (row < TL) && (mixer != 3);
                    const float sgn = (is32 ? (p & 2) : (p & 4)) ? 1.0f : -1.0f;
#pragma unroll
                    for (int e = 0; e < 8; ++e) { const float p2 = shx(x[e], 2, lane), p4 = shx(x[e], 4, lane); const float pt = is32 ? p2 : p4;
                        const float cs = rr[q][e >> 1][(e & 1) * 2], sn = rr[q][e >> 1][(e & 1) * 2 + 1];
                        if (rope) x[e] = x[e] * cs + sgn * pt * sn; }
                    u32x4 w; w.x = cvtpk(x[0], x[1]); w.y = cvtpk(x[2], x[3]); w.z = cvtpk(x[4], x[5]); w.w = cvtpk(x[6], x[7]);
                    if (ok[q]) *(u32x4*)(QKV + (size_t)row * NQKV + 1024 + kc * 64 + p * 8) = w;
                }
            }
        }
        SEAM(pb + 2);

        if (PHON(3) && IN(pb + 3)) {
            PH_LOCALS_X
            const float lam_init = 0.8f - 0.6f * __expf(-0.3f * (float)l);
            float lam;
            { const float a = (lane < 32) ? INP(I_LQ1)[l * 32 + lane] * INP(I_LK1)[l * 32 + lane] : 0.f, b = (lane < 32) ? INP(I_LQ2)[l * 32 + lane] * INP(I_LK2)[l * 32 + lane] : 0.f;
              lam = __expf(wave_sum(a, lane)) - __expf(wave_sum(b, lane)) + lam_init; lam = __builtin_bit_cast(float, __builtin_amdgcn_readfirstlane(__builtin_bit_cast(int, lam))); }
            const float* subln = INP(I_SUBLN) + l * 64;
            const int ctxb = TL;
#if !defined(ATT_ONLY) || ATT_ONLY == 0
            for (int u = bx; u < 512; u += G) {
                att::UnitP P; P.linit = 0.f; P.lam = lam; P.outscale = 1.0f - lam_init; P.subln = subln;
                const int bh = (u & 7) * 2 + ((u >> 8) & 1), blk = (u >> 3) & 31, b = bh >> 2, h = bh & 3;
                P.qrow0 = b * SEQ + blk * 256 + wid * 32; P.qpos0 = blk * 256 + wid * 32;
                P.qcol = QB_ + h * 64; P.kcol = KB_ + h * 64; P.vcol = VB_ + h * 64; P.ocol = 256 + h * 64; P.qgain = INP(I_BQN) + l * 32; P.rope = ROPE;
                P.locrow0 = b * SEQ; P.nloc = 128; P.kpos0 = 0; P.ctxrow0 = ctxb + b * CTXL;
                att::attn_unit<1>(lds, QKV, BR, P);
            }
#endif
#if !defined(ATT_ONLY) || ATT_ONLY == 1
            for (int u = bx; u < 256; u += G) {
                att::UnitP P; P.linit = 0.f; P.lam = lam; P.outscale = 1.0f; P.subln = subln;
                const int bk = u & 7, blk = u >> 3, b = bk >> 1, kvh = bk & 1, h = kvh * 2 + (wid >> 2);
                P.qrow0 = b * SEQ + blk * 256 + (wid & 3) * 64; P.qpos0 = blk * 256 + (wid & 3) * 64;
                P.qcol = QA + h * 64; P.kcol = KA + kvh * 64; P.vcol = VA + kvh * 64; P.ocol = 0 + h * 64; P.qgain = INP(I_AQN) + l * 64; P.rope = ROPE;
                P.locrow0 = b * SEQ; P.nloc = 128; P.kpos0 = 0; P.ctxrow0 = ctxb + b * CTXL;
                att::attn_unit_a2(lds, QKV, BR, P);
            }
#endif
#if !defined(ATT_ONLY) || ATT_ONLY == 2
            for (;;) { LAS int* qs_ = (LAS int*)(lds + MISC_OFF + 772);
                __syncthreads(); if (tid == 0) qs_[0] = (int)__hip_atomic_fetch_add(ctl + 3200 + 8 * l, 1u, __ATOMIC_RELAXED, __HIP_MEMORY_SCOPE_AGENT); __syncthreads();
                const int u = qs_[0]; if (u >= 512) break;
                att::UnitP P; P.lam = lam; P.outscale = 1.0f; P.subln = subln;
                const int bk = u & 7, blk = u >> 3, b = bk >> 1, kvh = bk & 1, h = kvh * 2 + (wid >> 2);
                P.qrow0 = b * SEQ + blk * 128 + (wid & 3) * 32; P.qpos0 = blk * 128 + (wid & 3) * 32;
                P.qcol = QC + h * 64; P.kcol = KC + kvh * 64; P.vcol = VC + kvh * 64; P.ocol = 512 + h * 64; P.qgain = INP(I_CQN) + l * 64; P.rope = ROPE;
                const int k0 = max(blk * 128 - 128, 0), k1 = min(blk * 128 + 256, SEQ);
                P.locrow0 = b * SEQ + k0; P.nloc = (k1 - k0) >> 6; P.kpos0 = k0; P.ctxrow0 = ctxb + b * CTXL;
                P.linit = __builtin_amdgcn_exp2f(INP(I_SINK)[l * 4 + h] * LOG2E);
                att::attn_unit<2>(lds, QKV, BR, P);
            }
#endif
#if !defined(ATT_ONLY) || ATT_ONLY == 3
            for (;;) { LAS int* qs_ = (LAS int*)(lds + MISC_OFF + 772);
                __syncthreads(); if (tid == 0) qs_[0] = (int)__hip_atomic_fetch_add(ctl + 3201 + 8 * l, 1u, __ATOMIC_RELAXED, __HIP_MEMORY_SCOPE_AGENT); __syncthreads();
                const int u = qs_[0]; if (u >= 512) break;
                att::UnitP P; P.linit = 0.f; P.lam = lam; P.outscale = 1.0f; P.subln = subln;
                const int bh = (u & 7) * 2 + ((u >> 8) & 1), blk = (u >> 3) & 31, b = bh >> 2, h = bh & 3;
                { LAS float* bt = (LAS float*)(lds + att::LDS_BIAS); const float* rp = INP(I_RPB) + ((size_t)l * 4 + h) * 465;
                  for (int i = tid; i < 465; i += NTHR) bt[i] = rp[i] * LOG2E; }
                P.qrow0 = b * SEQ + blk * 256 + wid * 32; P.qpos0 = blk * 256 + wid * 32;
                P.qcol = QD + h * 64; P.kcol = KD + h * 64; P.vcol = VD + h * 64; P.ocol = 768 + h * 64; P.qgain = INP(I_DQN) + l * 64; P.rope = nullptr;
                const int ra = min(max(4 * blk - 4, 0), 120), rb = min(max(4 * blk + 3 - 4, 0), 120) + 8;
                P.locrow0 = b * SEQ + ra * 64; P.nloc = rb - ra; P.kpos0 = ra * 64; P.ctxrow0 = ctxb + b * CTXL;
                att::attn_unit<3>(lds, QKV, BR, P);
            }
#endif
#ifndef ATT_ONLY
            if (l == 0) {
                for (int u = bx; u < 64; u += G) if ((u >> 4) == 0) {
                    const int v = u & 15, b = v >> 2, kvh = (v >> 1) & 1, blk = v & 1, h = kvh * 2 + (wid >> 2);
                    att::UnitP P; P.linit = 0.f; P.lam = lam; P.outscale = 1.0f; P.subln = subln; P.nloc = 0; P.locrow0 = 0; P.kpos0 = 0; P.qpos0 = 0;
                    P.qrow0 = ctxb + b * CTXL + blk * 128 + (wid & 3) * 32; P.ctxrow0 = ctxb + b * CTXL;
                    P.qcol = QA + h * 64; P.kcol = KA + kvh * 64; P.vcol = VA + kvh * 64; P.ocol = h * 64; P.qgain = INP(I_AQN) + l * 64; P.rope = nullptr;
                    att::attn_unit<0>(lds, QKV, BR, P);
                }
                for (int u = bx; u < 64; u += G) if ((u >> 4) == 1) {
                    const int v = u & 15, b = v >> 2, h = v & 3;
                    att::UnitP P; P.linit = 0.f; P.lam = lam; P.outscale = 1.0f - lam_init; P.subln = subln; P.nloc = 0; P.locrow0 = 0; P.kpos0 = 0; P.qpos0 = 0;
                    P.qrow0 = ctxb + b * CTXL + wid * 32; P.ctxrow0 = ctxb + b * CTXL;
                    P.qcol = QB_ + h * 64; P.kcol = KB_ + h * 64; P.vcol = VB_ + h * 64; P.ocol = 256 + h * 64; P.qgain = INP(I_BQN) + l * 32; P.rope = nullptr;
                    att::attn_unit<1>(lds, QKV, BR, P);
                }
                for (int u = bx; u < 64; u += G) if ((u >> 4) == 2) {
                    const int v = u & 15, b = v >> 2, kvh = (v >> 1) & 1, blk = v & 1, h = kvh * 2 + (wid >> 2);
                    att::UnitP P; P.lam = lam; P.outscale = 1.0f; P.subln = subln; P.nloc = 0; P.locrow0 = 0; P.kpos0 = 0; P.qpos0 = 0;
                    P.qrow0 = ctxb + b * CTXL + blk * 128 + (wid & 3) * 32; P.ctxrow0 = ctxb + b * CTXL;
                    P.qcol = QC + h * 64; P.kcol = KC + kvh * 64; P.vcol = VC + kvh * 64; P.ocol = 512 + h * 64; P.qgain = INP(I_CQN) + l * 64; P.rope = nullptr;
                    P.linit = __builtin_amdgcn_exp2f(INP(I_SINK)[l * 4 + h] * LOG2E);
                    att::attn_unit<0>(lds, QKV, BR, P);
                }
                for (int u = bx; u < 64; u += G) if ((u >> 4) == 3) {
                    const int v = u & 15, b = v >> 2, h = v & 3;
                    att::UnitP P; P.linit = 0.f; P.lam = lam; P.outscale = 1.0f; P.subln = subln; P.nloc = 0; P.locrow0 = 0; P.kpos0 = 0; P.qpos0 = 0;
                    P.qrow0 = ctxb + b * CTXL + wid * 32; P.ctxrow0 = ctxb + b * CTXL;
                    P.qcol = QD + h * 64; P.kcol = KD + h * 64; P.vcol = VD + h * 64; P.ocol = 768 + h * 64; P.qgain = INP(I_DQN) + l * 64; P.rope = nullptr;
                    att::attn_unit<0>(lds, QKV, BR, P);
                }
            }
#endif
        }
        SEAM(pb + 3);

        if (PHON(4) && IN(pb + 4)) {
            PH_LOCALS_X
            pg8::BranchSchedH S; S.nM = nrows_m / 256; S.nwg = S.nM * 8; S.G = G; S.c = bx; S.Bt = (const char*)(WB + (size_t)l * 4096 * 256);
            pg8::EpiBranchH E{}; E.Gt = GT; E.SUMB = H;
            pg8::gemm_phase<pg8::EpiBranchH, pg8::BranchSchedH>(lds, (const char*)BR, 2048u, 512u, 256, S, E);
        }
        SEAM(pb + 4);

        if (PHON(5) && IN(pb + 5)) {
            PH_LOCALS_X
        }

        if (PHON(6) && IN(pb + 6)) {
            PH_LOCALS_X
            pg8::DenseSched S; S.nM = nrows_m / 256; S.nN = 4; S.nwg = S.nM * S.nN; S.G = G; S.c = bx; S.Bt = (const char*)(WO + (size_t)l * 1024 * 1024); S.ldb2 = 2048; S.kmul = 0;
            pg8::EpiOut E{INP(I_X), INP(I_CTX), XRB, modl, l};
            pg8::gemm_phase<pg8::EpiOut, pg8::DenseSched>(lds, (const char*)H, 2048u, 2048u, 1024, S, E);
        }
        SEAM(pb + 6);

        if (PHON(7) && IN(pb + 7)) {
            PH_LOCALS_X
            LAS float* wrt = (LAS float*)lds;
            constexpr int WRP = 1028;
            LAS int* lcount = (LAS int*)(lds + 32 * WRP * 4);
            LAS float* lgl = (LAS float*)(lds + 32 * WRP * 4 + 256);
            LAS unsigned* ent = (LAS unsigned*)lgl;
            const float* rw = INP(I_RW) + (size_t)l * 1024 * 32;
            for (int i = tid; i < 1024 * 32; i += NTHR) { const int k = i >> 5, e = i & 31; wrt[e * WRP + k] = rw[i]; }
            if (tid < 64) lcount[tid] = 0;
            __syncthreads();
            const int nloc_rows = (nrows_m - bx + G - 1) / G;
            const f32x4* gn = (const f32x4*)(INP(I_N2G) + l * DM) + lane;
            const float rbias = INP(I_RB)[l * 32 + (lane >> 1)];
            for (int li0 = wid; li0 < nloc_rows; li0 += 2 * NWAVES) {
                const int li1 = li0 + NWAVES; const bool has1 = li1 < nloc_rows;
                const int row0 = bx + li0 * G, row1 = bx + (has1 ? li1 : li0) * G;
                f32x4 v[2][4]; float ss[2] = {0.f, 0.f};
#pragma unroll
                for (int r = 0; r < 2; ++r) { const u32x2* xr = (const u32x2*)(XRB + (size_t)(r ? row1 : row0) * DM) + lane;
#pragma unroll
                    for (int j = 0; j < 4; ++j) { const u32x2 t2 = xr[64 * j]; v[r][j] = (f32x4){bflo(t2.x), bfhi(t2.x), bflo(t2.y), bfhi(t2.y)}; } }
#pragma unroll
                for (int r = 0; r < 2; ++r) {
#pragma unroll
                    for (int j = 0; j < 4; ++j) ss[r] += (v[r][j][0] * v[r][j][0] + v[r][j][1] * v[r][j][1]) + (v[r][j][2] * v[r][j][2] + v[r][j][3] * v[r][j][3]); }
#pragma unroll
                for (int r = 0; r < 2; ++r) { const int row = r ? row1 : row0; const int ridx = row < TL ? (row >> 13) : 4;
                    const float rstd = __builtin_amdgcn_rsqf(wave_sum(ss[r], lane) * (1.0f / DM) + EPSN);
                    const f32x4* sh = (const f32x4*)(modl + ridx * 6144 + 3 * 1024) + lane; const f32x4* sc = (const f32x4*)(modl + ridx * 6144 + 4 * 1024) + lane;
                    u32x2* o8 = (u32x2*)(H + (size_t)row * DM) + lane;
#pragma unroll
                    for (int j = 0; j < 4; ++j) { v[r][j] = (v[r][j] * rstd * gn[64 * j]) * (sc[64 * j] + 1.0f) + sh[64 * j];
                        u32x2 w; w.x = cvtpk(v[r][j][0], v[r][j][1]); w.y = cvtpk(v[r][j][2], v[r][j][3]); if (r == 0 || has1) o8[64 * j] = w; } }
                float p[2][32];
                f32x2 vv[4][4];
#pragma unroll
                for (int j = 0; j < 4; ++j)
#pragma unroll
                    for (int c = 0; c < 4; ++c) vv[j][c] = (f32x2){v[0][j][c], v[1][j][c]};
#pragma unroll
                for (int e = 0; e < 32; ++e) { f32x2 a = (f32x2){0.f, 0.f}, a2 = (f32x2){0.f, 0.f};
#pragma unroll
                    for (int j = 0; j < 4; ++j) { const f32x4 w = *(const LAS f32x4*)(wrt + e * WRP + 4 * lane + 256 * j);
                        a = __builtin_elementwise_fma(vv[j][0], (f32x2){w[0], w[0]}, a); a2 = __builtin_elementwise_fma(vv[j][1], (f32x2){w[1], w[1]}, a2);
                        a = __builtin_elementwise_fma(vv[j][2], (f32x2){w[2], w[2]}, a); a2 = __builtin_elementwise_fma(vv[j][3], (f32x2){w[3], w[3]}, a2); }
                    a += a2; p[0][e] = a[0]; p[1][e] = a[1]; if ((e & 1) == 1) __builtin_amdgcn_sched_barrier(0); }
#pragma unroll
                for (int st = 0; st < 5; ++st) { const int half = 16 >> st, msk = 32 >> st; const bool up = (lane & msk) != 0;
#pragma unroll
                    for (int r = 0; r < 2; ++r)
#pragma unroll
                        for (int i = 0; i < half; ++i) { const float send = up ? p[r][i] : p[r][i + half], keep = up ? p[r][i + half] : p[r][i]; p[r][i] = keep + shx(send, msk, lane); } }
                const float lg0 = p[0][0] + shx(p[0][0], 1, lane) + rbias, lg1 = p[1][0] + shx(p[1][0], 1, lane) + rbias;
                if ((lane & 1) == 0) { lgl[li0 * 32 + (lane >> 1)] = lg0; if (has1) lgl[li1 * 32 + (lane >> 1)] = lg1; }
            }
            __syncthreads();
            for (int li = tid; li < nloc_rows; li += NTHR) {
                float q[32];
#pragma unroll
                for (int i = 0; i < 8; ++i) { const f32x4 t4 = *(const LAS f32x4*)(lgl + li * 32 + 4 * i); q[4 * i] = t4[0]; q[4 * i + 1] = t4[1]; q[4 * i + 2] = t4[2]; q[4 * i + 3] = t4[3]; }
                int te[4]; float tv[4];
#pragma unroll
                for (int k = 0; k < 4; ++k) { float best = q[0]; int bi = 0;
#pragma unroll
                    for (int e = 1; e < 32; ++e) { const bool gt = q[e] > best; best = gt ? q[e] : best; bi = gt ? e : bi; }
                    te[k] = bi; tv[k] = best;
#pragma unroll
                    for (int e = 0; e < 32; ++e) q[e] = (e == bi) ? -INFINITY : q[e]; }
                float ew[4], es = 0.f;
#pragma unroll
                for (int k = 0; k < 4; ++k) { ew[k] = __expf(tv[k] - tv[0]); es += ew[k]; }
                const float ies = 1.0f / es;
#pragma unroll
                for (int k = 0; k < 4; ++k) { const int lp = __hip_atomic_fetch_add(&lcount[te[k]], 1, __ATOMIC_RELAXED, __HIP_MEMORY_SCOPE_WORKGROUP);
                    ent[li * 32 + 2 * k] = (unsigned)te[k] | ((unsigned)lp << 8); ent[li * 32 + 2 * k + 1] = __float_as_uint(ew[k] * ies); }
            }
            __syncthreads();
            if (tid < 32) lcount[32 + tid] = (int)atomicAdd(&gcount[tid], (unsigned)lcount[tid]);
            __syncthreads();
            for (int i = tid; i < nloc_rows * 4; i += NTHR) { const int li = i >> 2, k = i & 3, row = bx + li * G;
                const unsigned ev = ent[li * 32 + 2 * k]; const int e = (int)(ev & 255u), pos = lcount[32 + e] + (int)(ev >> 8);
                TOKMAP[(size_t)e * ECAP + pos] = row; TOKEP[row * 4 + k] = ((unsigned)e << 24) | (unsigned)pos; TOKW[row * 4 + k] = __uint_as_float(ent[li * 32 + 2 * k + 1]); }
            __syncthreads();
        }
        SEAM(pb + 7);

        if (PHON(8) && IN(pb + 8)) {
            PH_LOCALS_X
            moe_tables(tb, gcount);
            pg8::MoeSched S; S.G = G; S.c = bx; S.npn = 8; S.gather = 1; S.tb = tb; S.tokmap = TOKMAP; S.Bt = (const char*)(WGU + (size_t)l * 32 * 2048 * 1024); S.bexp = (size_t)2048 * 1024 * 2; S.ldb2 = 2048; S.zrow = TT;
            pg8::EpiSwiglu E{ACT, INP(I_BGU) + (size_t)l * 32 * 2048};
            pg8::gemm_phase<pg8::EpiSwiglu, pg8::MoeSched>(lds, (const char*)H, 2048u, 2048u, 1024, S, E);
        }
        SEAM(pb + 8);

        if (PHON(9) && IN(pb + 9)) {
            PH_LOCALS_X
            moe_tables(tb, gcount);
            pg8::MoeSched S; S.G = G; S.c = bx; S.npn = 4; S.gather = 0; S.tb = tb; S.tokmap = TOKMAP; S.Bt = (const char*)(WD + (size_t)l * 32 * 1024 * 1024); S.bexp = (size_t)1024 * 1024 * 2; S.ldb2 = 2048; S.zrow = TT;
            pg8::EpiDown E{Y, INP(I_BD) + (size_t)l * 32 * 1024};
            pg8::gemm_phase<pg8::EpiDown, pg8::MoeSched>(lds, (const char*)ACT, 2048u, 2048u, 1024, S, E);
        }
        SEAM(pb + 9);
    }

    if (PHON(11) && IN(21)) {
        PH_LOCALS
        moe_tables(tb, ctl + CW_GCOUNT + 64);
        const float* mod1 = MOD + 1 * 5 * 6144;
        for (int rowA = gw; rowA < TL; rowA += 2 * NGW) {
            const bool hasB = rowA + NGW < TL; const int rowB = hasB ? rowA + NGW : rowA;
            f32x4 v[2][4], a[2][4];
#pragma unroll
            for (int r = 0; r < 2; ++r) { const u32x2* xr = (const u32x2*)(XRB + (size_t)(r ? rowB : rowA) * DM) + lane;
#pragma unroll
                for (int j = 0; j < 4; ++j) { const u32x2 t2 = xr[64 * j]; v[r][j] = (f32x4){bflo(t2.x), bfhi(t2.x), bflo(t2.y), bfhi(t2.y)}; a[r][j] = (f32x4){0.f, 0.f, 0.f, 0.f}; } }
            moe_gather_row(a[0], rowA, TOKEP, TOKW, tb, Y, lane);
            moe_gather_row(a[1], rowB, TOKEP, TOKW, tb, Y, lane);
#pragma unroll
            for (int r = 0; r < 2; ++r) { const int row = r ? rowB : rowA;
                if (r == 1 && !hasB) break;
                const f32x4* g2 = (const f32x4*)(mod1 + (row >> 13) * 6144 + 5 * 1024) + lane;
                f32x4* op = (f32x4*)(args.out + (size_t)row * DM) + lane;
#pragma unroll
                for (int j = 0; j < 4; ++j) op[64 * j] = v[r][j] + g2[64 * j] * a[r][j]; }
        }
    }
#undef IN
#undef SEAM
}

extern "C" void kernel_launch(void* const* d_in, const int* in_sizes, int n_in, void* d_out, int out_size, void* d_ws, size_t ws_size, hipStream_t stream) {
    static int grid = 0;
    if (grid == 0) {
        if (n_in != 33 || out_size != TL * DM || ws_size < WS_END) { fprintf(stderr, "kernel_launch: unexpected shapes (n_in %d out %d ws %zu)\n", n_in, out_size, ws_size); grid = -1; return; }
        int dev = 0, cus = 0, per_cu = 0;
        if (hipGetDevice(&dev) != hipSuccess || hipDeviceGetAttribute(&cus, hipDeviceAttributeMultiprocessorCount, dev) != hipSuccess) { grid = -1; return; }
        if (hipFuncSetAttribute((const void*)hdb_fwd, hipFuncAttributeMaxDynamicSharedMemorySize, LDS_BYTES) != hipSuccess) { fprintf(stderr, "kernel_launch: hipFuncSetAttribute failed\n"); grid = -1; return; }
        if (hipOccupancyMaxActiveBlocksPerMultiprocessor(&per_cu, (const void*)hdb_fwd, NTHR, LDS_BYTES) != hipSuccess || per_cu < 1) { fprintf(stderr, "kernel_launch: occupancy query reports %d\n", per_cu); }
        (void)hipGetLastError();
        grid = cus;
        if (grid > 256) grid = 256;
    }
    if (grid < 0) return;
    (void)hipMemsetAsync((char*)d_ws + WS_CTL, 0, CTL_ZERO_BYTES, stream);
    Args a{};
    for (int i = 0; i < 33; ++i) a.in[i] = (const float*)d_in[i];
    a.out = (float*)d_out; a.ws = (unsigned char*)d_ws;
#if MK_PER_PHASE
    for (int p = 0; p < N_PHASES; ++p) { a.ph_lo = p; a.ph_hi = p + 1; hipLaunchKernelGGL(hdb_fwd, dim3(grid), dim3(NTHR), LDS_BYTES, stream, a); }
#else
    a.ph_lo = 0; a.ph_hi = N_PHASES;
    hipLaunchKernelGGL(hdb_fwd, dim3(grid), dim3(NTHR), LDS_BYTES, stream, a);
#endif
}
```

```cpp
#include <hip/hip_runtime.h>
#include <cstdio>
#include <cstdint>

#ifndef MK_PER_PHASE
#define MK_PER_PHASE 0
#endif

#define LAS __attribute__((address_space(3)))
typedef unsigned short bf16_t;
typedef short bf16x8 __attribute__((ext_vector_type(8)));
typedef short s16x4 __attribute__((ext_vector_type(4)));
typedef float f32x4 __attribute__((ext_vector_type(4)));
typedef float f32x16 __attribute__((ext_vector_type(16)));
typedef float f32x2 __attribute__((ext_vector_type(2)));
typedef unsigned u32x4 __attribute__((ext_vector_type(4)));
typedef unsigned u32x2 __attribute__((ext_vector_type(2)));
typedef __bf16 bf16x2_t __attribute__((ext_vector_type(2)));

constexpr int DM = 1024, NB = 4, SEQ = 8192, CTXL = 256;
constexpr int TL = NB * SEQ;
constexpr int TC = NB * CTXL;
constexpr int TT = TL + TC;
constexpr int NQKV = 2560, NGATE = 4096, NIN = 6656;
constexpr int NEXP = 32, ECAP = TT;
constexpr int MAXTILES = 560;
constexpr float LOG2E = 1.4426950408889634f;
constexpr float EPSN = 1e-6f;
constexpr int QA = 0, QB_ = 256, QC = 512, QD = 768, KA = 1024, KB_ = 1152, KC = 1408, KD = 1536, VA = 1792, VB_ = 1920, VC = 2176, VD = 2304;

constexpr size_t MiB = 1u << 20;
constexpr size_t WS_CTL = 0, CTL_ZERO_BYTES = 1 * MiB;
constexpr size_t WS_MOD = 1 * MiB;
constexpr size_t WS_ROPE = 2 * MiB;
constexpr size_t WS_TOKEP = 6 * MiB;
constexpr size_t WS_TOKW = 7 * MiB;
constexpr size_t WS_TOKMAP = 8 * MiB;
constexpr size_t WS_WIN = 16 * MiB;
constexpr size_t WS_WB = 42 * MiB;
constexpr size_t WS_WO = 46 * MiB;
constexpr size_t WS_WGU = 50 * MiB;
constexpr size_t WS_WD = 306 * MiB;
constexpr size_t WS_H = 434 * MiB;
constexpr size_t WS_QKV = 501 * MiB;
constexpr size_t WS_G = 666 * MiB;
constexpr size_t WS_BR = 930 * MiB;
constexpr size_t WS_XR = 996 * MiB;
constexpr size_t WS_ACT = 1128 * MiB;
constexpr size_t WS_Y = 1408 * MiB;
constexpr size_t WS_END = 1688 * MiB;
constexpr int CW_GCOUNT = 64;
constexpr int CW_BAR = 4096;

constexpr int LDS_BYTES = 163840;
constexpr int MISC_OFF = LDS_BYTES - 1024;
constexpr int NWAVES = 8, NTHR = 512;

__device__ __forceinline__ unsigned cvtpk(float lo, float hi) { f32x2 v = {lo, hi}; bf16x2_t b = __builtin_convertvector(v, bf16x2_t); return __builtin_bit_cast(unsigned, b); }
__device__ __forceinline__ float bflo(unsigned u) { return __builtin_bit_cast(float, u << 16); }
__device__ __forceinline__ float bfhi(unsigned u) { return __builtin_bit_cast(float, u & 0xffff0000u); }
__device__ __forceinline__ float shx(float v, int m, int lane) { return __builtin_bit_cast(float, __builtin_amdgcn_ds_bpermute((lane ^ m) << 2, __builtin_bit_cast(int, v))); }
__device__ __forceinline__ float wave_sum(float v, int lane) {
#pragma unroll
    for (int o = 1; o < 64; o <<= 1) v += shx(v, o, lane);
    return v;
}
__device__ __forceinline__ float wave_max(float v, int lane) {
#pragma unroll
    for (int o = 1; o < 64; o <<= 1) v = fmaxf(v, shx(v, o, lane));
    return v;
}
#define LDS_WAIT() asm volatile("s_waitcnt lgkmcnt(0)" ::: "memory")
#define VM_WAIT() asm volatile("s_waitcnt vmcnt(0)" ::: "memory")

#define XB_TMO      128
#define XB_XCNT(j)  (256  + 64 * (j))
#define XB_XSUB(j)  (1280 + 64 * (j))
#define XB_XGEN(j)  (2304 + 64 * (j))
#define XB_TOP      3328
#define XB_TOPGEN   3392
#define XCD_BAR_WORDS 3456
#define XB_SPIN_CAP (1u << 24)

__device__ __forceinline__ unsigned xb_ld(unsigned* p)              { return __hip_atomic_load(p, __ATOMIC_RELAXED, __HIP_MEMORY_SCOPE_AGENT); }
__device__ __forceinline__ unsigned xb_add(unsigned* p, unsigned v) { return __hip_atomic_fetch_add(p, v, __ATOMIC_RELAXED, __HIP_MEMORY_SCOPE_AGENT); }
__device__ __forceinline__ unsigned xb_xcc_id() { return (unsigned)__builtin_amdgcn_s_getreg((3 << 11) | 20) & 0xFu; }
#define XB_SPIN(cond, bar) do { unsigned _sp = 0; while (cond) { __builtin_amdgcn_s_sleep(1); \
    if ((++_sp & 255u) == 0u) { if (xb_ld(&(bar)[XB_TMO])) break; if (_sp > XB_SPIN_CAP) { atomicAdd(&(bar)[XB_TMO], 1u); break; } } } } while (0)

struct XcdBarrier { unsigned* bar; unsigned x; volatile LAS unsigned* st; };

__device__ __forceinline__ XcdBarrier xcd_barrier_post(unsigned* bar, volatile LAS unsigned* st) {
    XcdBarrier b; b.bar = bar; b.x = xb_xcc_id(); b.st = st;
    if (threadIdx.x == 0) (void)xb_add(&bar[XB_XCNT(b.x)], 1u);
    return b;
}
__device__ __forceinline__ void xcd_barrier_complete(unsigned* bar, unsigned x, unsigned& nloc, unsigned& nx) {
    const unsigned G = gridDim.x * gridDim.y * gridDim.z;
    unsigned sum, cnt, mine, sp = 0u;
    for (;;) {
        sum = 0u; cnt = 0u; mine = 0u;
#pragma unroll
        for (unsigned j = 0; j < 16; ++j) { const unsigned c = xb_ld(&bar[XB_XCNT(j)]); sum += c; cnt += (c > 0u) ? 1u : 0u; mine = (j == x) ? c : mine; }
        if (sum == G) break;
        __builtin_amdgcn_s_sleep(1);
        if ((++sp & 255u) == 0u) { if (xb_ld(&bar[XB_TMO])) break; if (sp > XB_SPIN_CAP) { atomicAdd(&bar[XB_TMO], 1u); break; } }
    }
    nloc = mine > 0u ? mine : 1u; nx = cnt > 0u ? cnt : 1u;
}
__device__ __forceinline__ void xcd_barrier(const XcdBarrier& b) {
    asm volatile("s_waitcnt vmcnt(0)" ::: "memory");
    __syncthreads();
    if (threadIdx.x == 0) {
        unsigned* bar = b.bar;
        __builtin_amdgcn_s_waitcnt(0);
        unsigned nloc = b.st[0], nx = b.st[1];
        if (nloc == 0u) { xcd_barrier_complete(bar, b.x, nloc, nx); b.st[0] = nloc; b.st[1] = nx; }
        const unsigned old = xb_add(&bar[XB_XSUB(b.x)], 1u);
        const unsigned gen = old / nloc;
        if (old + 1u == (gen + 1u) * nloc) {
            __builtin_amdgcn_fence(__ATOMIC_RELEASE, "agent");
            asm volatile("s_waitcnt vmcnt(0)" ::: "memory");
            const unsigned og = xb_add(&bar[XB_TOP], 1u);
            const unsigned tg = og / nx;
            if (og + 1u == (tg + 1u) * nx) xb_add(&bar[XB_TOPGEN], 1u);
            else XB_SPIN(xb_ld(&bar[XB_TOPGEN]) == tg, bar);
            __builtin_amdgcn_fence(__ATOMIC_ACQUIRE, "agent");
            xb_add(&bar[XB_XGEN(b.x)], 1u);
            asm volatile("s_waitcnt vmcnt(0)" ::: "memory");
        } else {
            XB_SPIN(xb_ld(&bar[XB_XGEN(b.x)]) == gen, bar);
            __builtin_amdgcn_fence(__ATOMIC_ACQUIRE, "agent");
            asm volatile("s_waitcnt vmcnt(0)" ::: "memory");
        }
    }
    __syncthreads();
}

namespace pg8 {
constexpr int BM = 256, BK = 64, HALF = 128, HTB = HALF * BK * 2, STAGE_BYTES = 8 * HTB;
__host__ __device__ __forceinline__ int lds_byte(int r, int c) { const int st = (r >> 4) * 2 + (c >> 5), rr = r & 15, cc = c & 31, ob = rr * 64 + cc * 2; return st * 1024 + (ob ^ (((ob >> 9) & 1) << 5)); }
__host__ __device__ __forceinline__ void stage_rc(int b, int& R, int& C) { const int st = b / 1024, sb = b % 1024, swz = sb ^ (((sb >> 9) & 1) << 5); R = (st >> 1) * 16 + swz / 64; C = (st & 1) * 32 + (swz % 64) / 2; }
__host__ __device__ __forceinline__ int perm32(int rho) { const int n = rho >> 4, i = rho & 15; return 8 * (i >> 2) + 4 * n + (i & 3); }
struct Unit { int pm, pn, ex; };

template <class Epi, class Sched>
__device__ __forceinline__ void gemm_phase(LAS unsigned char* lds, const char* Abase, const unsigned lda2, const unsigned ldb2, const int K, const Sched& S, const Epi& E) {
    int tid_ = threadIdx.x; asm volatile("" : "+v"(tid_));
    const int tid = tid_, wid = __builtin_amdgcn_readfirstlane(tid >> 6), lane = tid & 63, wr = wid >> 2, wc = wid & 3, fr = lane & 15, fq = lane >> 4;
    const int nt = K / BK;
    int Rr[2]; unsigned Cc[2], voffB[2];
#pragma unroll
    for (int i = 0; i < 2; ++i) { int R, C; stage_rc(tid * 16 + i * 8192, R, C); const int Rb = Epi::PERM ? ((R & ~31) + perm32(R & 31)) : R;
        Rr[i] = R; Cc[i] = (unsigned)C * 2u; voffB[i] = (unsigned)Rb * ldb2 + (unsigned)C * 2u; }
    const size_t kstep = (size_t)(BK * 2);
    const size_t hstepB = (size_t)HALF * ldb2;
    const unsigned ldsw = (unsigned)wid * 1024u;
    const int aoff = lds_byte(wr * 64 + fr, fq * 8), boff = lds_byte(wc * 32 + fr, fq * 8);
#define PG8_SA(b, h) (((b) * 2 + (h)) * HTB)
#define PG8_SB(b, h) ((4 + (b) * 2 + (h)) * HTB)
#define PG8_STAGE_A(bufoff, kptr, V) do { _Pragma("unroll") for (int _i = 0; _i < 2; ++_i) \
        __builtin_amdgcn_global_load_lds((const unsigned*)((const char*)(kptr) + (V)[_i]), (LAS unsigned*)(lds + (bufoff) + ldsw + _i * 8192), 16, 0, 0); } while (0)
#define PG8_STAGE_B(bufoff, gbase) do { _Pragma("unroll") for (int _i = 0; _i < 2; ++_i) \
        __builtin_amdgcn_global_load_lds((const unsigned*)((const char*)(gbase) + voffB[_i]), (LAS unsigned*)(lds + (bufoff) + ldsw + _i * 8192), 16, 0, 0); } while (0)
#define PG8_LDA(dst, b, h) do { _Pragma("unroll") for (int m = 0; m < 4; ++m) _Pragma("unroll") for (int k = 0; k < 2; ++k) dst[m][k] = *(const LAS bf16x8*)(lds + PG8_SA(b, h) + aoff + m * 2048 + k * 1024); } while (0)
#define PG8_LDB(dst, b, h) do { _Pragma("unroll") for (int n = 0; n < 2; ++n) _Pragma("unroll") for (int k = 0; k < 2; ++k) dst[n][k] = *(const LAS bf16x8*)(lds + PG8_SB(b, h) + boff + n * 2048 + k * 1024); } while (0)
#define PG8_MMA(ai, bj, At, Bt) do { __builtin_amdgcn_s_setprio(1); _Pragma("unroll") for (int m = 0; m < 4; ++m) _Pragma("unroll") for (int n = 0; n < 2; ++n) _Pragma("unroll") for (int k = 0; k < 2; ++k) \
        acc[ai][bj][m][n] = __builtin_amdgcn_mfma_f32_16x16x32_bf16(Bt[n][k], At[m][k], acc[ai][bj][m][n], 0, 0, 0); __builtin_amdgcn_s_setprio(0); } while (0)
#define PG8_WAIT_V(n) asm volatile("s_waitcnt vmcnt(" #n ")" ::: "memory")
#define PG8_WAIT_L(n) asm volatile("s_waitcnt lgkmcnt(" #n ")" ::: "memory")
#define PG8_BAR __builtin_amdgcn_s_barrier()
#define PG8_SCHED __builtin_amdgcn_sched_barrier(0)
#define PG8_FILLA(dst, u) do { const unsigned ko_ = S.akoff(u); _Pragma("unroll") for (int h_ = 0; h_ < 2; ++h_) _Pragma("unroll") for (int i_ = 0; i_ < 2; ++i_) \
        dst[h_][i_] = (unsigned)S.arow(u, h_ * 128 + Rr[i_]) * lda2 + Cc[i_] + ko_; } while (0)
    Unit cur, nxt; int ui = 0;
    if (!S.next(0, cur)) return;
    f32x4 acc[2][2][4][2];
#pragma unroll
    for (int a = 0; a < 2; ++a)
#pragma unroll
        for (int b = 0; b < 2; ++b)
#pragma unroll
            for (int m = 0; m < 4; ++m)
#pragma unroll
                for (int n = 0; n < 2; ++n) acc[a][b][m][n] = (f32x4){0.f, 0.f, 0.f, 0.f};
    bf16x8 At[4][2], B0[2][2], B1[2][2];
    unsigned vA[2][2], nvA[2][2];
    PG8_FILLA(vA, cur);
    const char* cB = S.bptr(cur);
    constexpr bool HN = Epi::HALFN;
    if constexpr (HN) {
        PG8_STAGE_B(PG8_SB(0, 0), cB); PG8_STAGE_A(PG8_SA(0, 0), Abase, vA[0]); PG8_STAGE_A(PG8_SA(0, 1), Abase, vA[1]);
        if (wr == 1) PG8_BAR;
        PG8_WAIT_V(2); PG8_BAR;
        PG8_STAGE_B(PG8_SB(1, 0), cB + kstep); PG8_STAGE_A(PG8_SA(1, 0), Abase + kstep, vA[0]);
        PG8_WAIT_V(4); PG8_BAR;
    } else {
    PG8_STAGE_B(PG8_SB(0, 0), cB); PG8_STAGE_B(PG8_SB(0, 1), cB + hstepB); PG8_STAGE_A(PG8_SA(0, 0), Abase, vA[0]); PG8_STAGE_A(PG8_SA(0, 1), Abase, vA[1]);
    if (wr == 1) PG8_BAR;
    PG8_WAIT_V(2); PG8_BAR;
    PG8_STAGE_B(PG8_SB(1, 0), cB + kstep); PG8_STAGE_A(PG8_SA(1, 0), Abase + kstep, vA[0]); PG8_STAGE_B(PG8_SB(1, 1), cB + hstepB + kstep);
    PG8_WAIT_V(6); PG8_BAR;
    }
    for (;;) {
        const bool has_next = S.next(ui + 1, nxt);
        const char* nB = cB;
        if (has_next) { PG8_FILLA(nvA, nxt); nB = S.bptr(nxt); }
        else {
#pragma unroll
            for (int h = 0; h < 2; ++h)
#pragma unroll
                for (int i = 0; i < 2; ++i) nvA[h][i] = vA[h][i];
        }
        for (int t = 0; t < nt; t += 2) {
            const bool last = (t == nt - 2);
            const char* a1k = Abase + (size_t)(t + 1) * kstep;
            const char* a2k = last ? Abase : Abase + (size_t)(t + 2) * kstep; const char* b2 = last ? nB : cB + (size_t)(t + 2) * kstep;
            const char* a3k = a2k + kstep; const char* b3 = b2 + kstep;
            unsigned s0[2], s1[2];
#pragma unroll
            for (int i = 0; i < 2; ++i) { s0[i] = last ? nvA[0][i] : vA[0][i]; s1[i] = last ? nvA[1][i] : vA[1][i]; }
            if constexpr (HN) {
            PG8_LDB(B0, 0, 0); PG8_SCHED; PG8_LDA(At, 0, 0); PG8_STAGE_A(PG8_SA(1, 1), a1k, vA[1]);
            PG8_WAIT_V(6); PG8_WAIT_L(0); PG8_BAR; PG8_MMA(0, 0, At, B0); PG8_BAR; PG8_SCHED;
            PG8_LDA(At, 0, 1); PG8_STAGE_B(PG8_SB(0, 0), b2); PG8_STAGE_A(PG8_SA(0, 0), a2k, s0);
            PG8_WAIT_V(6); PG8_WAIT_L(0); PG8_BAR; PG8_MMA(1, 0, At, B0); PG8_BAR; PG8_SCHED;
            PG8_LDB(B0, 1, 0); PG8_SCHED; PG8_LDA(At, 1, 0); PG8_STAGE_A(PG8_SA(0, 1), a2k, s1);
            PG8_WAIT_V(6); PG8_WAIT_L(0); PG8_BAR; PG8_MMA(0, 0, At, B0); PG8_BAR; PG8_SCHED;
            PG8_LDA(At, 1, 1); PG8_STAGE_B(PG8_SB(1, 0), b3); PG8_STAGE_A(PG8_SA(1, 0), a3k, s0);
            PG8_WAIT_V(6); PG8_WAIT_L(0); PG8_BAR; PG8_MMA(1, 0, At, B0); PG8_BAR; PG8_SCHED;
            } else {
            PG8_LDB(B0, 0, 0); PG8_LDB(B1, 0, 1); PG8_SCHED; PG8_LDA(At, 0, 0); PG8_STAGE_A(PG8_SA(1, 1), a1k, vA[1]);
            PG8_WAIT_V(8); PG8_WAIT_L(0); PG8_BAR; PG8_MMA(0, 0, At, B0); PG8_MMA(0, 1, At, B1); PG8_BAR; PG8_SCHED;
            PG8_LDA(At, 0, 1); PG8_STAGE_B(PG8_SB(0, 0), b2); PG8_STAGE_B(PG8_SB(0, 1), b2 + hstepB); PG8_STAGE_A(PG8_SA(0, 0), a2k, s0);
            PG8_WAIT_V(8); PG8_WAIT_L(0); PG8_BAR; PG8_MMA(1, 0, At, B0); PG8_MMA(1, 1, At, B1); PG8_BAR; PG8_SCHED;
            PG8_LDB(B0, 1, 0); PG8_LDB(B1, 1, 1); PG8_SCHED; PG8_LDA(At, 1, 0); PG8_STAGE_A(PG8_SA(0, 1), a2k, s1);
            PG8_WAIT_V(8); PG8_WAIT_L(0); PG8_BAR; PG8_MMA(0, 0, At, B0); PG8_MMA(0, 1, At, B1); PG8_BAR; PG8_SCHED;
            PG8_LDA(At, 1, 1); PG8_STAGE_B(PG8_SB(1, 0), b3); PG8_STAGE_B(PG8_SB(1, 1), b3 + hstepB); PG8_STAGE_A(PG8_SA(1, 0), a3k, s0);
            PG8_WAIT_V(8); PG8_WAIT_L(0); PG8_BAR; PG8_MMA(1, 0, At, B0); PG8_MMA(1, 1, At, B1); PG8_BAR; PG8_SCHED;
            }
        }
        if (wr == 0) PG8_BAR;
        E(acc, cur, wr, wc, fr, fq);
        if (!has_next) break;
#pragma unroll
        for (int a = 0; a < 2; ++a)
#pragma unroll
            for (int b = 0; b < 2; ++b)
#pragma unroll
                for (int m = 0; m < 4; ++m)
#pragma unroll
                    for (int n = 0; n < 2; ++n) acc[a][b][m][n] = (f32x4){0.f, 0.f, 0.f, 0.f};
        cur = nxt; cB = nB; ++ui;
#pragma unroll
        for (int h = 0; h < 2; ++h)
#pragma unroll
            for (int i = 0; i < 2; ++i) vA[h][i] = nvA[h][i];
        if (wr == 1) PG8_BAR;
    }
    PG8_WAIT_V(0);
    PG8_BAR;
#undef PG8_SA
#undef PG8_SB
#undef PG8_STAGE_A
#undef PG8_STAGE_B
#undef PG8_LDA
#undef PG8_LDB
#undef PG8_MMA
#undef PG8_WAIT_V
#undef PG8_WAIT_L
#undef PG8_BAR
#undef PG8_SCHED
#undef PG8_FILLA
}

struct DenseSched {
    int nM, nN, nwg, G, c; const char* Bt; unsigned ldb2; int kmul;
    __device__ __forceinline__ bool next(int i, Unit& u) const {
        const long L = (long)i * G + c; if (L >= nwg) return false;
        int wgid = (int)L; { const int q = nwg / 8, r = nwg % 8, xcd = wgid % 8, off = wgid / 8; wgid = (xcd < r ? xcd * (q + 1) : r * (q + 1) + (xcd - r) * q) + off; }
        const int nig = 8 * nN, gid = wgid / nig, fm = gid * 8, gsz = (nM - fm) < 8 ? (nM - fm) : 8;
        u.pm = fm + ((wgid % nig) % gsz); u.pn = (wgid % nig) / gsz; u.ex = 0; return true;
    }
    __device__ __forceinline__ int arow(const Unit& u, int r) const { return u.pm * 256 + r; }
    __device__ __forceinline__ unsigned akoff(const Unit& u) const { return (unsigned)((u.pn >> 2) * kmul); }
    __device__ __forceinline__ const char* bptr(const Unit& u) const { return Bt + (size_t)u.pn * 256 * ldb2; }
};
struct BranchSched {
    int nM, nwg, G, c; const char* Bt;
    __device__ __forceinline__ bool next(int i, Unit& u) const {
        const long L = (long)(i >> 2) * G + c; if (L >= nwg) return false;
        int wgid = (int)L; { const int q = nwg / 8, r = nwg % 8, xcd = wgid % 8, off = wgid / 8; wgid = (xcd < r ? xcd * (q + 1) : r * (q + 1) + (xcd - r) * q) + off; }
        const int nig = 8 * 4, gid = wgid / nig, fm = gid * 8, gsz = (nM - fm) < 8 ? (nM - fm) : 8;
        u.pm = fm + ((wgid % nig) % gsz); u.pn = (i & 3) * 4 + (wgid % nig) / gsz; u.ex = 0; return true;
    }
    __device__ __forceinline__ int arow(const Unit& u, int r) const { return u.pm * 256 + r; }
    __device__ __forceinline__ unsigned akoff(const Unit& u) const { return (unsigned)((u.pn >> 2) * 512); }
    __device__ __forceinline__ const char* bptr(const Unit& u) const { return Bt + (size_t)u.pn * 256 * 512; }
};
struct BranchSchedH {
    int nM, nwg, G, c; const char* Bt;
    __device__ __forceinline__ bool next(int i, Unit& u) const {
        const long L = (long)(i >> 2) * G + c; if (L >= nwg) return false;
        int wgid = (int)L; { const int q = nwg / 8, r = nwg % 8, xcd = wgid % 8, off = wgid / 8; wgid = (xcd < r ? xcd * (q + 1) : r * (q + 1) + (xcd - r) * q) + off; }
        const int nig = 8 * 8, gid = wgid / nig, fm = gid * 8, gsz = (nM - fm) < 8 ? (nM - fm) : 8;
        u.pm = fm + ((wgid % nig) % gsz); u.pn = (wgid % nig) / gsz; u.ex = i & 3; return true;
    }
    __device__ __forceinline__ int arow(const Unit& u, int r) const { return u.pm * 256 + r; }
    __device__ __forceinline__ unsigned akoff(const Unit& u) const { return (unsigned)(u.ex * 512); }
    __device__ __forceinline__ const char* bptr(const Unit& u) const { return Bt + (size_t)(u.ex * 1024 + u.pn * 128) * 512; }
};
struct EpiBranchH {
    static constexpr bool PERM = true, HALFN = true;
    const bf16_t* Gt; bf16_t* SUMB; mutable f32x4 S[2][4][2];
    __device__ __forceinline__ void operator()(const f32x4 (&acc)[2][2][4][2], const Unit& u, int wr, int wc, int fr, int fq) const {
        const int row0 = u.pm * BM + wr * 64 + fr, scol0 = u.pn * 128 + wc * 32 + 8 * fq, gcol0 = u.ex * 1024 + scol0;
        const bool first = u.ex == 0, lastb = u.ex == 3; const int tid_ = (wr * 4 + wc) * 64 + fq * 16 + fr; (void)gcol0;
#pragma unroll
        for (int ai = 0; ai < 2; ++ai)
#pragma unroll
            for (int m = 0; m < 4; ++m) { const size_t row = (size_t)(row0 + ai * HALF + m * 16);
                const u32x4 g = *(const u32x4*)(Gt + ((((size_t)u.pm * 32 + (u.ex * 8 + u.pn)) * 8 + (ai * 4 + m)) * 512 + tid_) * 8);
                const f32x4 v0 = acc[ai][0][m][0], v1 = acc[ai][0][m][1];
                f32x4 s0 = (f32x4){v0[0] * bflo(g.x), v0[1] * bfhi(g.x), v0[2] * bflo(g.y), v0[3] * bfhi(g.y)};
                f32x4 s1 = (f32x4){v1[0] * bflo(g.z), v1[1] * bfhi(g.z), v1[2] * bflo(g.w), v1[3] * bfhi(g.w)};
                if (!first) { s0 += S[ai][m][0]; s1 += S[ai][m][1]; }
                S[ai][m][0] = s0; S[ai][m][1] = s1;
                if (lastb) { u32x4 w; w.x = cvtpk(s0[0], s0[1]); w.y = cvtpk(s0[2], s0[3]); w.z = cvtpk(s1[0], s1[1]); w.w = cvtpk(s1[2], s1[3]);
                    *(u32x4*)(SUMB + row * DM + scol0) = w; } }
    }
};
struct MoeSched {
    int G, c, npn, gather; const LAS int* tb; const int* tokmap; const char* Bt; size_t bexp; unsigned ldb2; int zrow;
    __device__ __forceinline__ bool next(int i, Unit& u) const {
        const int ntl = tb[32];
        int tile, pn;
        if ((G & 7) == 0 && (G >> 3) % npn == 0) {
            const int x = c & 7, j = c >> 3, tpr = (G >> 3) / npn;
            tile = (i * tpr + j / npn) * 8 + x; pn = j % npn;
            if (tile >= ntl) return false;
        } else { const int idx = i * G + c; if (idx >= ntl * npn) return false; tile = idx / npn; pn = idx - tile * npn; }
        u.pm = tile; u.pn = pn;
        int e = 0;
#pragma unroll 1
        for (int k = 1; k < 32; ++k) e = (tb[k] <= tile) ? k : e;
        u.ex = e; return true;
    }
    __device__ __forceinline__ int arow(const Unit& u, int r) const {
        if (!gather) return u.pm * 256 + r;
        const int p = (u.pm - tb[u.ex]) * 256 + r;
        return (p < tb[64 + u.ex]) ? tokmap[(size_t)u.ex * ECAP + p] : zrow;
    }
    __device__ __forceinline__ unsigned akoff(const Unit&) const { return 0u; }
    __device__ __forceinline__ const char* bptr(const Unit& u) const { return Bt + (size_t)u.ex * bexp + (size_t)u.pn * 256 * ldb2; }
};

__device__ __forceinline__ float sigmoidf_(float v) { return __builtin_amdgcn_rcpf(1.0f + __builtin_amdgcn_exp2f(-v * LOG2E)); }

struct EpiIn {
    static constexpr bool PERM = true, HALFN = false;
    bf16_t* QKV; bf16_t* Gt; const float* bgate;
    __device__ __forceinline__ void operator()(const f32x4 (&acc)[2][2][4][2], const Unit& u, int wr, int wc, int fr, int fq) const {
        const int row0 = u.pm * BM + wr * 64 + fr;
        const bool isg = u.pn >= 10;
        const int colt = isg ? (u.pn - 10) * 256 : u.pn * 256, ldc = isg ? NGATE : NQKV;
        bf16_t* base = isg ? Gt : QKV;
        const int col0 = colt + wc * 32 + 8 * fq;
        f32x4 bv[2][2];
#pragma unroll
        for (int bj = 0; bj < 2; ++bj)
#pragma unroll
            for (int n = 0; n < 2; ++n) bv[bj][n] = isg ? *(const f32x4*)(bgate + col0 + bj * HALF + 4 * n) : (f32x4){0.f, 0.f, 0.f, 0.f};
#pragma unroll
        for (int ai = 0; ai < 2; ++ai)
#pragma unroll
            for (int m = 0; m < 4; ++m) { bf16_t* rowp = base + (size_t)(row0 + ai * HALF + m * 16) * ldc + col0;
#pragma unroll
                for (int bj = 0; bj < 2; ++bj) { f32x4 v0 = acc[ai][bj][m][0] + bv[bj][0], v1 = acc[ai][bj][m][1] + bv[bj][1];
                    if (isg) {
#pragma unroll
                        for (int q = 0; q < 4; ++q) { v0[q] = sigmoidf_(v0[q]); v1[q] = sigmoidf_(v1[q]); } }
                    u32x4 w; w.x = cvtpk(v0[0], v0[1]); w.y = cvtpk(v0[2], v0[3]); w.z = cvtpk(v1[0], v1[1]); w.w = cvtpk(v1[2], v1[3]);
                    if (isg) { const int tid_ = (wr * 4 + wc) * 64 + fq * 16 + fr, ch = (u.pn - 10) * 2 + bj;
                        *(u32x4*)(Gt + ((((size_t)u.pm * 32 + ch) * 8 + (ai * 4 + m)) * 512 + tid_) * 8) = w; }
                    else *(u32x4*)(rowp + bj * HALF) = w; } }
    }
};
struct EpiBranch {
    static constexpr bool PERM = true, HALFN = false;
    const bf16_t* Gt; bf16_t* SUMB;
    __device__ __forceinline__ void operator()(const f32x4 (&acc)[2][2][4][2], const Unit& u, int wr, int wc, int fr, int fq) const {
        const int row0 = u.pm * BM + wr * 64 + fr, col0 = u.pn * 256 + wc * 32 + 8 * fq, scol0 = (u.pn & 3) * 256 + wc * 32 + 8 * fq;
        const bool first = (u.pn >> 2) == 0;
#pragma unroll
        for (int ai = 0; ai < 2; ++ai)
#pragma unroll
            for (int m = 0; m < 4; ++m) { const bf16_t* rowp = Gt + (size_t)(row0 + ai * HALF + m * 16) * NGATE + col0; bf16_t* outp = SUMB + (size_t)(row0 + ai * HALF + m * 16) * DM + scol0;
#pragma unroll
                for (int bj = 0; bj < 2; ++bj) { const u32x4 g = *(const u32x4*)(rowp + bj * HALF);
                    u32x4 so = (u32x4){0u, 0u, 0u, 0u}; if (!first) so = *(const u32x4*)(outp + bj * HALF);
                    const f32x4 v0 = acc[ai][bj][m][0], v1 = acc[ai][bj][m][1];
                    u32x4 w; w.x = cvtpk(v0[0] * bflo(g.x) + bflo(so.x), v0[1] * bfhi(g.x) + bfhi(so.x)); w.y = cvtpk(v0[2] * bflo(g.y) + bflo(so.y), v0[3] * bfhi(g.y) + bfhi(so.y));
                    w.z = cvtpk(v1[0] * bflo(g.z) + bflo(so.z), v1[1] * bfhi(g.z) + bfhi(so.z)); w.w = cvtpk(v1[2] * bflo(g.w) + bflo(so.w), v1[3] * bfhi(g.w) + bfhi(so.w));
                    *(u32x4*)(outp + bj * HALF) = w; } }
    }
};
struct EpiOut {
    static constexpr bool PERM = true, HALFN = false;
    const float* x0; const float* c0; bf16_t* XRB; const float* mod; int layer;
    __device__ __forceinline__ void operator()(const f32x4 (&acc)[2][2][4][2], const Unit& u, int wr, int wc, int fr, int fq) const {
        const int rt = u.pm * BM;
        const int ridx = rt < TL ? (rt >> 13) : 4;
        const float* srcf = rt < TL ? x0 + (size_t)rt * DM : c0 + (size_t)(rt - TL) * DM;
        bf16_t* dst = XRB + (size_t)rt * DM;
        const float* g1 = mod + ridx * 6144 + 2 * 1024;
        const int col0 = u.pn * BM + wc * 32 + 8 * fq;
#pragma unroll
        for (int ai = 0; ai < 2; ++ai)
#pragma unroll
            for (int m = 0; m < 4; ++m) { const size_t off = (size_t)(ai * HALF + wr * 64 + m * 16 + fr) * DM + col0;
#pragma unroll
                for (int bj = 0; bj < 2; ++bj) { const int cc = bj * HALF;
                    const f32x4 ga = *(const f32x4*)(g1 + col0 + cc), gb = *(const f32x4*)(g1 + col0 + cc + 4);
                    f32x4 xa, xb;
                    if (layer) { const u32x4 xx = *(const u32x4*)(dst + off + cc); xa = (f32x4){bflo(xx.x), bfhi(xx.x), bflo(xx.y), bfhi(xx.y)}; xb = (f32x4){bflo(xx.z), bfhi(xx.z), bflo(xx.w), bfhi(xx.w)}; }
                    else { xa = *(const f32x4*)(srcf + off + cc); xb = *(const f32x4*)(srcf + off + cc + 4); }
                    const f32x4 ra = xa + ga * acc[ai][bj][m][0], rb = xb + gb * acc[ai][bj][m][1];
                    u32x4 w; w.x = cvtpk(ra[0], ra[1]); w.y = cvtpk(ra[2], ra[3]); w.z = cvtpk(rb[0], rb[1]); w.w = cvtpk(rb[2], rb[3]);
                    *(u32x4*)(dst + off + cc) = w; } }
    }
};
struct EpiSwiglu {
    static constexpr bool PERM = true, HALFN = false;
    bf16_t* ACT; const float* bgu;
    __device__ __forceinline__ void operator()(const f32x4 (&acc)[2][2][4][2], const Unit& u, int wr, int wc, int fr, int fq) const {
        const int row0 = u.pm * BM + wr * 64 + fr, j0 = u.pn * 128 + wc * 32 + 8 * fq;
        const float* bg = bgu + (size_t)u.ex * 2048 + j0;
        f32x4 bgv[2], buv[2];
#pragma unroll
        for (int n = 0; n < 2; ++n) { bgv[n] = *(const f32x4*)(bg + 4 * n); buv[n] = *(const f32x4*)(bg + 1024 + 4 * n); }
#pragma unroll
        for (int ai = 0; ai < 2; ++ai)
#pragma unroll
            for (int m = 0; m < 4; ++m) { bf16_t* rowp = ACT + (size_t)(row0 + ai * HALF + m * 16) * DM + j0;
                float o[8];
#pragma unroll
                for (int n = 0; n < 2; ++n)
#pragma unroll
                    for (int q = 0; q < 4; ++q) { float g = acc[ai][0][m][n][q] + bgv[n][q], up = acc[ai][1][m][n][q] + buv[n][q];
                        g = fminf(g, 7.0f); up = fminf(fmaxf(up, -7.0f), 7.0f);
                        o[n * 4 + q] = g * sigmoidf_(1.702f * g) * (up + 1.0f); }
                u32x4 w; w.x = cvtpk(o[0], o[1]); w.y = cvtpk(o[2], o[3]); w.z = cvtpk(o[4], o[5]); w.w = cvtpk(o[6], o[7]);
                *(u32x4*)rowp = w; }
    }
};
struct EpiDown {
    static constexpr bool PERM = true, HALFN = false;
    bf16_t* Y; const float* bd;
    __device__ __forceinline__ void operator()(const f32x4 (&acc)[2][2][4][2], const Unit& u, int wr, int wc, int fr, int fq) const {
        const int row0 = u.pm * BM + wr * 64 + fr, col0 = u.pn * 256 + wc * 32 + 8 * fq;
        const float* bp = bd + (size_t)u.ex * 1024 + col0;
        f32x4 bv[2][2];
#pragma unroll
        for (int bj = 0; bj < 2; ++bj)
#pragma unroll
            for (int n = 0; n < 2; ++n) bv[bj][n] = *(const f32x4*)(bp + bj * HALF + 4 * n);
#pragma unroll
        for (int ai = 0; ai < 2; ++ai)
#pragma unroll
            for (int m = 0; m < 4; ++m) { bf16_t* rowp = Y + (size_t)(row0 + ai * HALF + m * 16) * DM + col0;
#pragma unroll
                for (int bj = 0; bj < 2; ++bj) { const f32x4 v0 = acc[ai][bj][m][0] + bv[bj][0], v1 = acc[ai][bj][m][1] + bv[bj][1];
                    u32x4 w; w.x = cvtpk(v0[0], v0[1]); w.y = cvtpk(v0[2], v0[3]); w.z = cvtpk(v1[0], v1[1]); w.w = cvtpk(v1[2], v1[3]);
                    *(u32x4*)(rowp + bj * HALF) = w; } }
    }
};
}

namespace att {
constexpr int SLOTB = 8192, LDS_K = 0, LDS_V = 3 * SLOTB, LDS_BIAS = 7 * SLOTB, LDS_Q = 7 * SLOTB + 2048;
__device__ __forceinline__ int crow(int r, int hi) { return (r & 3) + 8 * (r >> 2) + 4 * hi; }
__device__ __forceinline__ void glds16(const void* gsrc, unsigned lds_dst) { unsigned keep;
    asm volatile("s_mov_b32 %0, m0\n\ts_mov_b32 m0, %2\n\ts_nop 0\n\tglobal_load_lds_dwordx4 %1, off\n\ts_mov_b32 m0, %0" : "=&s"(keep) : "v"(gsrc), "s"(lds_dst) : "memory"); }
typedef LAS const char* lds_cptr;
typedef short v4i16_t __attribute__((ext_vector_type(4)));
__device__ __forceinline__ s16x4 vtr(lds_cptr p) { return __builtin_bit_cast(s16x4, __builtin_amdgcn_ds_read_tr16_b64_v4i16((LAS v4i16_t*)p)); }
#define ATT_WAIT_BAR(N) do { __builtin_amdgcn_sched_barrier(0); asm volatile("s_waitcnt vmcnt(" #N ") lgkmcnt(0)\n\ts_barrier" ::: "memory"); __builtin_amdgcn_sched_barrier(0); } while (0)
#define ATT_BAR() do { __builtin_amdgcn_sched_barrier(0); asm volatile("s_waitcnt lgkmcnt(0)\n\ts_barrier" ::: "memory"); __builtin_amdgcn_sched_barrier(0); } while (0)
#define ATT_MFMA(a, b, c) __builtin_amdgcn_mfma_f32_32x32x16_bf16(a, b, c, 0, 0, 0)

struct UnitP {
    int qrow0;
    int qcol, kcol, vcol, ocol;
    int locrow0, nloc;
    int ctxrow0;
    int qpos0;
    int kpos0;
    float linit;
    float lam, outscale;
    const float* subln;
    const float* qgain;
    const f32x2* rope;
};

template <int MODE>
__device__ __forceinline__ void attn_unit(LAS unsigned char* shm, const bf16_t* __restrict__ QKV, bf16_t* BR, const UnitP& P) {
    int tid_ = threadIdx.x; asm volatile("" : "+v"(tid_));
    const int tid = tid_, lane = tid & 63, r32 = lane & 31, hi = lane >> 5; const int wid = __builtin_amdgcn_readfirstlane(tid >> 6);
    const int grp = wid >> 2;
    const unsigned lds0 = (unsigned)(uintptr_t)shm;
    const char* kbase = (const char*)QKV + (size_t)P.kcol * 2 + wid * 16 + (size_t)lane * (NQKV * 2);
    const char* vbase = (const char*)QKV + (size_t)P.vcol * 2 + ((wid >> 2) * 32 + (lane & 3) * 8) * 2 + (size_t)(16 * (wid & 3) + (lane >> 2)) * (NQKV * 2);
    const unsigned kdst = lds0 + LDS_K + wid * 1024, vdst = lds0 + LDS_V + wid * 1024;
    const int nloc = P.nloc, NT = nloc + 4;
#define ATT_TROW(t) ((t) < nloc ? P.locrow0 + 64 * (t) : P.ctxrow0 + 64 * ((t) - nloc))
#define ATT_DMA(t, ks, vs) do { const size_t ro_ = (size_t)ATT_TROW(t) * (NQKV * 2); \
        glds16(kbase + ro_, (unsigned)__builtin_amdgcn_readfirstlane(kdst + (ks) * SLOTB)); glds16(vbase + ro_, (unsigned)__builtin_amdgcn_readfirstlane(vdst + (vs) * SLOTB)); } while (0)
    ATT_DMA(0, 0, 0); ATT_DMA(1, 1, 1);
    bf16x8 qr[4];
    LAS bf16x8* qlds = (LAS bf16x8*)(shm + LDS_Q + wid * 4096) + lane;
    {
      const bf16_t* Qw = QKV + (size_t)(P.qrow0 + r32) * NQKV + P.qcol + hi * 8;
      u32x4 raw[4];
#pragma unroll
      for (int d0 = 0; d0 < 4; ++d0) raw[d0] = *reinterpret_cast<const u32x4*>(Qw + d0 * 16);
      float x[4][8];
#pragma unroll
      for (int d0 = 0; d0 < 4; ++d0) { x[d0][0] = bflo(raw[d0].x); x[d0][1] = bfhi(raw[d0].x); x[d0][2] = bflo(raw[d0].y); x[d0][3] = bfhi(raw[d0].y);
          x[d0][4] = bflo(raw[d0].z); x[d0][5] = bfhi(raw[d0].z); x[d0][6] = bflo(raw[d0].w); x[d0][7] = bfhi(raw[d0].w); }
      const f32x2* rt = P.rope ? P.rope + (size_t)(P.qpos0 + r32) * 48 : nullptr;
      if (MODE == 1) {
#pragma unroll
          for (int c = 0; c < 2; ++c) { float ss = 0.f;
#pragma unroll
              for (int dd = 0; dd < 2; ++dd)
#pragma unroll
                  for (int e = 0; e < 8; ++e) ss += x[2 * c + dd][e] * x[2 * c + dd][e];
              ss += shx(ss, 32, lane);
              const float rs = __builtin_amdgcn_rsqf(ss * (1.0f / 32.0f) + EPSN);
#pragma unroll
              for (int dd = 0; dd < 2; ++dd)
#pragma unroll
                  for (int e = 0; e < 8; ++e) x[2 * c + dd][e] *= rs * P.qgain[16 * dd + 8 * hi + e];
              if (rt) {
#pragma unroll
                  for (int e = 0; e < 8; ++e) { const f32x2 cs = rt[32 + 8 * hi + e]; const float a = x[2 * c][e], b = x[2 * c + 1][e];
                      x[2 * c][e] = a * cs.x - b * cs.y; x[2 * c + 1][e] = a * cs.y + b * cs.x; } } }
      } else {
          float ss = 0.f;
#pragma unroll
          for (int d0 = 0; d0 < 4; ++d0)
#pragma unroll
              for (int e = 0; e < 8; ++e) ss += x[d0][e] * x[d0][e];
          ss += shx(ss, 32, lane);
          const float rs = __builtin_amdgcn_rsqf(ss * (1.0f / 64.0f) + EPSN);
#pragma unroll
          for (int d0 = 0; d0 < 4; ++d0)
#pragma unroll
              for (int e = 0; e < 8; ++e) x[d0][e] *= rs * P.qgain[16 * d0 + 8 * hi + e];
          if (rt) {
#pragma unroll
              for (int d0 = 0; d0 < 2; ++d0)
#pragma unroll
                  for (int e = 0; e < 8; ++e) { const f32x2 cs = rt[16 * d0 + 8 * hi + e]; const float a = x[d0][e], b = x[d0 + 2][e];
                      x[d0][e] = a * cs.x - b * cs.y; x[d0 + 2][e] = a * cs.y + b * cs.x; } }
      }
      const float qs = (MODE == 1 ? 0.17677669529663687f : 0.125f) * LOG2E;
#pragma unroll
      for (int d0 = 0; d0 < 4; ++d0) { u32x4 w; w.x = cvtpk(x[d0][0] * qs, x[d0][1] * qs); w.y = cvtpk(x[d0][2] * qs, x[d0][3] * qs); w.z = cvtpk(x[d0][4] * qs, x[d0][5] * qs); w.w = cvtpk(x[d0][6] * qs, x[d0][7] * qs);
          qr[d0] = __builtin_bit_cast(bf16x8, w); if (MODE == 1) qlds[d0 * 64] = qr[d0]; } }
    f32x16 o[2], o2[2]; o[0] = f32x16{}; o[1] = f32x16{}; o2[0] = f32x16{}; o2[1] = f32x16{};
    float l1 = (hi == 0) ? P.linit : 0.f, l2 = 0.f;
    f32x16 pa0 = f32x16{}, pa1 = f32x16{}, pb0 = f32x16{}, pb1 = f32x16{};
    u32x4 pw[4], pv2[4];
#pragma unroll
    for (int i = 0; i < 4; ++i) { pw[i] = (u32x4){0u, 0u, 0u, 0u}; pv2[i] = (u32x4){0u, 0u, 0u, 0u}; }
    const int qpos = P.qpos0 + r32;
    const int qrow_w = P.qpos0 >> 6, r0w = min(max(qrow_w - 4, 0), 120);
    const int qc = qpos & 63, c0q = min(max(qc - 8, 0), 48);
    const LAS float* biasT = (const LAS float*)(shm + LDS_BIAS);
    const lds_cptr kp0 = (lds_cptr)shm + LDS_K + hi * 1024 + r32 * 16;
    const lds_cptr vp0 = (lds_cptr)shm + LDS_V + ((lane >> 4) & 1) * 32 + (lane & 3) * 8 + (4 * hi + ((lane & 15) >> 2)) * 64;
#define ATT_ACTIVE(t) ( (MODE == 2 && (t) < nloc) ? ((P.kpos0 + 64 * (t) <= P.qpos0 + 31 + 128) && (P.kpos0 + 64 * (t) + 63 >= P.qpos0 - 128)) : \
                        (MODE == 3 && (t) < nloc) ? ((((P.kpos0 >> 6) + (t)) >= r0w) && (((P.kpos0 >> 6) + (t)) < r0w + 8)) : true )
#define ATT_SOFT(P0, P1, LS, PW, t) do { \
        if (MODE == 2 && (t) < nloc) { const int kb_ = P.kpos0 + 64 * (t) - qpos; \
            _Pragma("unroll") for (int r = 0; r < 16; ++r) { const int d = kb_ + crow(r, hi); \
                if (d > 128 || d < -128) P0[r] = -INFINITY; \
                if (d + 32 > 128 || d + 32 < -128) P1[r] = -INFINITY; } } \
        if (MODE == 3 && (t) < nloc) { const int kr_ = (P.kpos0 >> 6) + (t); const int rb_ = (kr_ - qrow_w + 7) * 31 + 15 - qc; \
            _Pragma("unroll") for (int r = 0; r < 16; ++r) { const int kc = crow(r, hi); \
                { const bool ok = (unsigned)(kc - c0q) < 16u; const float bz = biasT[ok ? rb_ + kc : 0]; P0[r] = ok ? P0[r] + bz : -INFINITY; } \
                { const bool ok = (unsigned)(kc + 32 - c0q) < 16u; const float bz = biasT[ok ? rb_ + kc + 32 : 0]; P1[r] = ok ? P1[r] + bz : -INFINITY; } } } \
        float s_ = 0.f; \
        _Pragma("unroll") for (int r = 0; r < 16; ++r) { P0[r] = __builtin_amdgcn_exp2f(P0[r]); P1[r] = __builtin_amdgcn_exp2f(P1[r]); s_ += P0[r] + P1[r]; } \
        LS += s_; \
        PW[0] = (u32x4){cvtpk(P0[0], P0[1]), cvtpk(P0[2], P0[3]), cvtpk(P0[4], P0[5]), cvtpk(P0[6], P0[7])}; \
        PW[1] = (u32x4){cvtpk(P0[8], P0[9]), cvtpk(P0[10], P0[11]), cvtpk(P0[12], P0[13]), cvtpk(P0[14], P0[15])}; \
        PW[2] = (u32x4){cvtpk(P1[0], P1[1]), cvtpk(P1[2], P1[3]), cvtpk(P1[4], P1[5]), cvtpk(P1[6], P1[7])}; \
        PW[3] = (u32x4){cvtpk(P1[8], P1[9]), cvtpk(P1[10], P1[11]), cvtpk(P1[12], P1[13]), cvtpk(P1[14], P1[15])}; } while (0)
#define ATT_S(t) do { if (ATT_ACTIVE(t)) { ATT_SOFT(pa0, pa1, l1, pw, t); if (MODE == 1) ATT_SOFT(pb0, pb1, l2, pv2, t); } } while (0)
#define ATT_PV(tp, vsp) do { if (MODE < 2 || ATT_ACTIVE(tp)) { const lds_cptr vp = vp0 + (vsp) * SLOTB; \
            _Pragma("unroll") for (int dh = 0; dh < 2; ++dh) { _Pragma("unroll") for (int ks = 0; ks < 4; ++ks) { \
                const s16x4 vl = vtr(vp + dh * 4096 + ks * 1024), vh = vtr(vp + dh * 4096 + ks * 1024 + 512); \
                const bf16x8 vf = (bf16x8){vl[0], vl[1], vl[2], vl[3], vh[0], vh[1], vh[2], vh[3]}; \
                o[dh] = ATT_MFMA(vf, __builtin_bit_cast(bf16x8, pw[ks]), o[dh]); \
                if (MODE == 1) o2[dh] = ATT_MFMA(vf, __builtin_bit_cast(bf16x8, pv2[ks]), o2[dh]); } \
                } } \
        } while (0)
#define ATT_QK(t, ksc) do { if (MODE < 2 || ATT_ACTIVE(t)) { const lds_cptr kp = kp0 + (ksc) * SLOTB; \
            if (MODE == 1) { \
                _Pragma("unroll") for (int d0 = 0; d0 < 2; ++d0) { const bf16x8 k0 = *(const LAS bf16x8*)(kp + d0 * 2048), k1 = *(const LAS bf16x8*)(kp + d0 * 2048 + 512); const bf16x8 qf = qlds[d0 * 64]; \
                    pa0 = ATT_MFMA(k0, qf, d0 == 0 ? f32x16{} : pa0); pa1 = ATT_MFMA(k1, qf, d0 == 0 ? f32x16{} : pa1); } \
                _Pragma("unroll") for (int d0 = 2; d0 < 4; ++d0) { const bf16x8 k0 = *(const LAS bf16x8*)(kp + d0 * 2048), k1 = *(const LAS bf16x8*)(kp + d0 * 2048 + 512); const bf16x8 qf = qlds[d0 * 64]; \
                    pb0 = ATT_MFMA(k0, qf, d0 == 2 ? f32x16{} : pb0); pb1 = ATT_MFMA(k1, qf, d0 == 2 ? f32x16{} : pb1); } \
            } else { \
                _Pragma("unroll") for (int d0 = 0; d0 < 4; ++d0) { const bf16x8 k0 = *(const LAS bf16x8*)(kp + d0 * 2048), k1 = *(const LAS bf16x8*)(kp + d0 * 2048 + 512); \
                    pa0 = ATT_MFMA(k0, qr[d0], d0 == 0 ? f32x16{} : pa0); pa1 = ATT_MFMA(k1, qr[d0], d0 == 0 ? f32x16{} : pa1); } } } } while (0)
#define ATT_TOP(t) do { if ((t) + 1 < NT) { ATT_WAIT_BAR(2); } else { ATT_WAIT_BAR(0); } \
        if ((t) + 2 < NT) { ATT_DMA((t) + 2, (k3 == 0) ? 2 : k3 - 1, ((t) + 2) & 3); } } while (0)
    int k3 = 0;
    if (grp == 0) {
        ATT_TOP(0); ATT_QK(0, 0); ATT_BAR(); ATT_S(0);
        k3 = 1;
        for (int t = 1; t < NT; ++t) {
            ATT_TOP(t);
            __builtin_amdgcn_s_setprio(1); ATT_PV(t - 1, (t + 3) & 3); ATT_QK(t, k3); __builtin_amdgcn_s_setprio(0);
            ATT_BAR();
            ATT_S(t);
            k3 = (k3 == 2) ? 0 : k3 + 1;
        }
        ATT_BAR();
        ATT_PV(NT - 1, (NT + 3) & 3);
        ATT_BAR();
    } else {
        ATT_TOP(0); ATT_BAR(); ATT_QK(0, 0);
        k3 = 1;
        for (int t = 1; t < NT; ++t) {
            ATT_TOP(t);
            ATT_S(t - 1);
            ATT_BAR();
            __builtin_amdgcn_s_setprio(1); ATT_PV(t - 1, (t + 3) & 3); ATT_QK(t, k3); __builtin_amdgcn_s_setprio(0);
            k3 = (k3 == 2) ? 0 : k3 + 1;
        }
        ATT_BAR();
        ATT_S(NT - 1);
        ATT_BAR();
        ATT_PV(NT - 1, (NT + 3) & 3);
    }
    l1 += shx(l1, 32, lane);
    const float i1 = 1.0f / l1;
    bf16_t* orow = BR + (size_t)(P.qrow0 + r32) * DM + P.ocol + 4 * hi;
    if (MODE == 1) {
        l2 += shx(l2, 32, lane);
        const float i2 = P.lam / l2;
        float ss = 0.f;
#pragma unroll
        for (int dh = 0; dh < 2; ++dh)
#pragma unroll
            for (int r = 0; r < 16; ++r) { const float v = o[dh][r] * i1 - o2[dh][r] * i2; o[dh][r] = v; ss += v * v; }
        ss += shx(ss, 32, lane);
        const float rs = __builtin_amdgcn_rsqf(ss * (1.0f / 64.0f) + EPSN) * P.outscale;
#pragma unroll
        for (int dh = 0; dh < 2; ++dh)
#pragma unroll
            for (int g = 0; g < 4; ++g) { const f32x4 sg = *(const f32x4*)(P.subln + dh * 32 + 8 * g + 4 * hi);
                u32x2 w; w.x = cvtpk(o[dh][4 * g] * rs * sg[0], o[dh][4 * g + 1] * rs * sg[1]); w.y = cvtpk(o[dh][4 * g + 2] * rs * sg[2], o[dh][4 * g + 3] * rs * sg[3]);
                *(u32x2*)(orow + dh * 32 + 8 * g) = w; }
    } else {
#pragma unroll
        for (int dh = 0; dh < 2; ++dh)
#pragma unroll
            for (int g = 0; g < 4; ++g) { u32x2 w; w.x = cvtpk(o[dh][4 * g] * i1, o[dh][4 * g + 1] * i1); w.y = cvtpk(o[dh][4 * g + 2] * i1, o[dh][4 * g + 3] * i1);
                *(u32x2*)(orow + dh * 32 + 8 * g) = w; }
    }
    ATT_BAR();
#undef ATT_TROW
#undef ATT_DMA
#undef ATT_ACTIVE
#undef ATT_SOFT
#undef ATT_S
#undef ATT_PV
#undef ATT_TOP
#undef ATT_QK
}

__device__ __forceinline__ void attn_unit_a2(LAS unsigned char* shm, const bf16_t* __restrict__ QKV, bf16_t* BR, const UnitP& P) {
    int tid_ = threadIdx.x; asm volatile("" : "+v"(tid_));
    const int tid = tid_, lane = tid & 63, r32 = lane & 31, hi = lane >> 5; const int wid = __builtin_amdgcn_readfirstlane(tid >> 6);
    const int grp = wid >> 2;
    const unsigned lds0 = (unsigned)(uintptr_t)shm;
    const char* kbase = (const char*)QKV + (size_t)P.kcol * 2 + wid * 16 + (size_t)lane * (NQKV * 2);
    const char* vbase = (const char*)QKV + (size_t)P.vcol * 2 + ((wid >> 2) * 32 + (lane & 3) * 8) * 2 + (size_t)(16 * (wid & 3) + (lane >> 2)) * (NQKV * 2);
    const unsigned kdst = lds0 + LDS_K + wid * 1024, vdst = lds0 + LDS_V + wid * 1024;
    const int nloc = P.nloc, NT = nloc + 4;
#define A2_TROW(t) ((t) < nloc ? P.locrow0 + 64 * (t) : P.ctxrow0 + 64 * ((t) - nloc))
#define A2_DMA(t, ks, vs) do { const size_t ro_ = (size_t)A2_TROW(t) * (NQKV * 2); \
        glds16(kbase + ro_, (unsigned)__builtin_amdgcn_readfirstlane(kdst + (ks) * SLOTB)); glds16(vbase + ro_, (unsigned)__builtin_amdgcn_readfirstlane(vdst + (vs) * SLOTB)); } while (0)
    A2_DMA(0, 0, 0); A2_DMA(1, 1, 1);
    bf16x8 qr[2][4];
    LAS bf16x8* qlds = (LAS bf16x8*)(shm + LDS_Q + wid * 8192) + lane;
#pragma unroll
    for (int j = 0; j < 2; ++j) {
        const bf16_t* Qw = QKV + (size_t)(P.qrow0 + 32 * j + r32) * NQKV + P.qcol + hi * 8;
        u32x4 raw[4];
#pragma unroll
        for (int d0 = 0; d0 < 4; ++d0) raw[d0] = *reinterpret_cast<const u32x4*>(Qw + d0 * 16);
        float x[4][8];
#pragma unroll
        for (int d0 = 0; d0 < 4; ++d0) { x[d0][0] = bflo(raw[d0].x); x[d0][1] = bfhi(raw[d0].x); x[d0][2] = bflo(raw[d0].y); x[d0][3] = bfhi(raw[d0].y);
            x[d0][4] = bflo(raw[d0].z); x[d0][5] = bfhi(raw[d0].z); x[d0][6] = bflo(raw[d0].w); x[d0][7] = bfhi(raw[d0].w); }
        const f32x2* rt = P.rope ? P.rope + (size_t)(P.qpos0 + 32 * j + r32) * 48 : nullptr;
        float ss = 0.f;
#pragma unroll
        for (int d0 = 0; d0 < 4; ++d0)
#pragma unroll
            for (int e = 0; e < 8; ++e) ss += x[d0][e] * x[d0][e];
        ss += shx(ss, 32, lane);
        const float rs = __builtin_amdgcn_rsqf(ss * (1.0f / 64.0f) + EPSN);
#pragma unroll
        for (int d0 = 0; d0 < 4; ++d0)
#pragma unroll
            for (int e = 0; e < 8; ++e) x[d0][e] *= rs * P.qgain[16 * d0 + 8 * hi + e];
        if (rt) {
#pragma unroll
            for (int d0 = 0; d0 < 2; ++d0)
#pragma unroll
                for (int e = 0; e < 8; ++e) { const f32x2 cs = rt[16 * d0 + 8 * hi + e]; const float a = x[d0][e], b = x[d0 + 2][e];
                    x[d0][e] = a * cs.x - b * cs.y; x[d0 + 2][e] = a * cs.y + b * cs.x; } }
        const float qs = 0.125f * LOG2E;
#pragma unroll
        for (int d0 = 0; d0 < 4; ++d0) { u32x4 w; w.x = cvtpk(x[d0][0] * qs, x[d0][1] * qs); w.y = cvtpk(x[d0][2] * qs, x[d0][3] * qs); w.z = cvtpk(x[d0][4] * qs, x[d0][5] * qs); w.w = cvtpk(x[d0][6] * qs, x[d0][7] * qs);
            qr[j][d0] = __builtin_bit_cast(bf16x8, w); qlds[(j * 4 + d0) * 64] = qr[j][d0]; }
    }
    f32x16 o[2][2]; float l1[2] = {0.f, 0.f};
#pragma unroll
    for (int j = 0; j < 2; ++j) { o[j][0] = f32x16{}; o[j][1] = f32x16{}; }
    f32x16 pa[2][2];
#pragma unroll
    for (int j = 0; j < 2; ++j) { pa[j][0] = f32x16{}; pa[j][1] = f32x16{}; }
    u32x4 pw[2][4];
#pragma unroll
    for (int j = 0; j < 2; ++j)
#pragma unroll
        for (int i = 0; i < 4; ++i) pw[j][i] = (u32x4){0u, 0u, 0u, 0u};
    const lds_cptr kp0 = (lds_cptr)shm + LDS_K + hi * 1024 + r32 * 16;
    const lds_cptr vp0 = (lds_cptr)shm + LDS_V + ((lane >> 4) & 1) * 32 + (lane & 3) * 8 + (4 * hi + ((lane & 15) >> 2)) * 64;
#define A2_S() do { _Pragma("unroll") for (int j = 0; j < 2; ++j) { float s_ = 0.f; \
        _Pragma("unroll") for (int r = 0; r < 16; ++r) { pa[j][0][r] = __builtin_amdgcn_exp2f(pa[j][0][r]); pa[j][1][r] = __builtin_amdgcn_exp2f(pa[j][1][r]); s_ += pa[j][0][r] + pa[j][1][r]; } \
        l1[j] += s_; \
        pw[j][0] = (u32x4){cvtpk(pa[j][0][0], pa[j][0][1]), cvtpk(pa[j][0][2], pa[j][0][3]), cvtpk(pa[j][0][4], pa[j][0][5]), cvtpk(pa[j][0][6], pa[j][0][7])}; \
        pw[j][1] = (u32x4){cvtpk(pa[j][0][8], pa[j][0][9]), cvtpk(pa[j][0][10], pa[j][0][11]), cvtpk(pa[j][0][12], pa[j][0][13]), cvtpk(pa[j][0][14], pa[j][0][15])}; \
        pw[j][2] = (u32x4){cvtpk(pa[j][1][0], pa[j][1][1]), cvtpk(pa[j][1][2], pa[j][1][3]), cvtpk(pa[j][1][4], pa[j][1][5]), cvtpk(pa[j][1][6], pa[j][1][7])}; \
        pw[j][3] = (u32x4){cvtpk(pa[j][1][8], pa[j][1][9]), cvtpk(pa[j][1][10], pa[j][1][11]), cvtpk(pa[j][1][12], pa[j][1][13]), cvtpk(pa[j][1][14], pa[j][1][15])}; } } while (0)
#define A2_PV(vsp) do { const lds_cptr vp = vp0 + (vsp) * SLOTB; \
        _Pragma("unroll") for (int dh = 0; dh < 2; ++dh) _Pragma("unroll") for (int ks = 0; ks < 4; ++ks) { \
            const s16x4 vl = vtr(vp + dh * 4096 + ks * 1024), vh = vtr(vp + dh * 4096 + ks * 1024 + 512); \
            const bf16x8 vf = (bf16x8){vl[0], vl[1], vl[2], vl[3], vh[0], vh[1], vh[2], vh[3]}; \
            o[0][dh] = ATT_MFMA(vf, __builtin_bit_cast(bf16x8, pw[0][ks]), o[0][dh]); o[1][dh] = ATT_MFMA(vf, __builtin_bit_cast(bf16x8, pw[1][ks]), o[1][dh]); } } while (0)
#define A2_QK(ksc) do { const lds_cptr kp = kp0 + (ksc) * SLOTB; \
        _Pragma("unroll") for (int d0 = 0; d0 < 4; ++d0) { const bf16x8 k0 = *(const LAS bf16x8*)(kp + d0 * 2048), k1 = *(const LAS bf16x8*)(kp + d0 * 2048 + 512); \
            const bf16x8 q0_ = qlds[d0 * 64], q1_ = qlds[(4 + d0) * 64]; \
            pa[0][0] = ATT_MFMA(k0, q0_, d0 == 0 ? f32x16{} : pa[0][0]); pa[1][0] = ATT_MFMA(k0, q1_, d0 == 0 ? f32x16{} : pa[1][0]); \
            pa[0][1] = ATT_MFMA(k1, q0_, d0 == 0 ? f32x16{} : pa[0][1]); pa[1][1] = ATT_MFMA(k1, q1_, d0 == 0 ? f32x16{} : pa[1][1]); } } while (0)
#define A2_TOP(t) do { if ((t) + 1 < NT) { ATT_WAIT_BAR(2); } else { ATT_WAIT_BAR(0); } \
        if ((t) + 2 < NT) { A2_DMA((t) + 2, (k3 == 0) ? 2 : k3 - 1, ((t) + 2) & 3); } } while (0)
    int k3 = 0;
    if (grp == 0) {
        A2_TOP(0); A2_QK(0); ATT_BAR(); A2_S();
        k3 = 1;
        for (int t = 1; t < NT; ++t) {
            A2_TOP(t);
            __builtin_amdgcn_s_setprio(1); A2_PV((t + 3) & 3); A2_QK(k3); __builtin_amdgcn_s_setprio(0);
            ATT_BAR();
            A2_S();
            k3 = (k3 == 2) ? 0 : k3 + 1;
        }
        ATT_BAR();
        A2_PV((NT + 3) & 3);
        ATT_BAR();
    } else {
        A2_TOP(0); ATT_BAR(); A2_QK(0);
        k3 = 1;
        for (int t = 1; t < NT; ++t) {
            A2_TOP(t);
            A2_S();
            ATT_BAR();
            __builtin_amdgcn_s_setprio(1); A2_PV((t + 3) & 3); A2_QK(k3); __builtin_amdgcn_s_setprio(0);
            k3 = (k3 == 2) ? 0 : k3 + 1;
        }
        ATT_BAR();
        A2_S();
        ATT_BAR();
        A2_PV((NT + 3) & 3);
    }
#pragma unroll
    for (int j = 0; j < 2; ++j) {
        float lt = l1[j]; lt += shx(lt, 32, lane);
        const float i1 = 1.0f / lt;
        bf16_t* orow = BR + (size_t)(P.qrow0 + 32 * j + r32) * DM + P.ocol + 4 * hi;
#pragma unroll
        for (int dh = 0; dh < 2; ++dh)
#pragma unroll
            for (int g = 0; g < 4; ++g) { u32x2 w; w.x = cvtpk(o[j][dh][4 * g] * i1, o[j][dh][4 * g + 1] * i1); w.y = cvtpk(o[j][dh][4 * g + 2] * i1, o[j][dh][4 * g + 3] * i1);
                *(u32x2*)(orow + dh * 32 + 8 * g) = w; }
    }
    ATT_BAR();
#undef A2_TROW
#undef A2_DMA
#undef A2_S
#undef A2_PV
#undef A2_QK
#undef A2_TOP
}
}

struct Args { const float* in[33]; float* out; unsigned char* ws; int ph_lo, ph_hi; };
enum { I_X = 0, I_C, I_CTX, I_CCTX, I_N1G, I_N2G, I_WADA, I_BADA, I_WIN, I_BGATE, I_AQN, I_AKN, I_BQN, I_BKN, I_LQ1, I_LK1, I_LQ2, I_LK2, I_SUBLN, I_CQN, I_CKN, I_SINK, I_DQN, I_DKN, I_RPB,
       I_WBR, I_WOUT, I_RW, I_RB, I_WGU, I_BGU, I_WD, I_BD };
constexpr int N_PHASES = 22;

__device__ __forceinline__ void p0_transpose_item(const float* __restrict__ W, int K, int N, bf16_t* WT, int item, int lane, LAS float* scr, bool gu_perm) {
    const int nblk = N >> 5, kb = item / nblk, nb = item - kb * nblk, k0 = 64 * kb, n0 = 32 * nb;
#pragma unroll 8
    for (int i = 0; i < 32; ++i) { const int kk = 2 * i + (lane >> 5); scr[kk * 33 + (lane & 31)] = W[(size_t)(k0 + kk) * N + n0 + (lane & 31)]; }
    LDS_WAIT();
    const int c = lane & 7;
    const int rowbase = gu_perm ? (((n0 & 1023) >> 7) * 256 + (n0 >> 10) * 128 + (n0 & 127)) : n0;
#pragma unroll
    for (int j = 0; j < 4; ++j) { const int n = (lane >> 3) + 8 * j; const LAS float* s = scr + (8 * c) * 33 + n;
        u32x4 o; o.x = cvtpk(s[0 * 33], s[1 * 33]); o.y = cvtpk(s[2 * 33], s[3 * 33]); o.z = cvtpk(s[4 * 33], s[5 * 33]); o.w = cvtpk(s[6 * 33], s[7 * 33]);
        *(u32x4*)(WT + (size_t)(rowbase + n) * K + k0 + 8 * c) = o; }
    LDS_WAIT();
}

__device__ __forceinline__ void moe_tables(LAS int* tb, const unsigned* gcount) {
    if (threadIdx.x == 0) { int s = 0;
        for (int e = 0; e < 32; ++e) { const int c = (int)gcount[e]; tb[e] = s; tb[64 + e] = c; s += (c + 255) >> 8; }
        tb[32] = s; }
    __syncthreads();
}
__device__ __forceinline__ void moe_gather_row(f32x4 (&a)[4], int row, const unsigned* tokep, const float* tokw, const LAS int* tb, const bf16_t* Y, int lane) {
#pragma unroll
    for (int k = 0; k < 4; ++k) { const unsigned ep = tokep[row * 4 + k]; const float w = tokw[row * 4 + k];
        const int e = (int)(ep >> 24), pos = (int)(ep & 0xffffffu); const size_t slot = (size_t)tb[e] * 256 + pos;
        const u32x2* yp = (const u32x2*)(Y + slot * DM) + lane;
#pragma unroll
        for (int j = 0; j < 4; ++j) { const u32x2 u = yp[64 * j]; a[j][0] += w * bflo(u.x); a[j][1] += w * bfhi(u.x); a[j][2] += w * bflo(u.y); a[j][3] += w * bfhi(u.y); } }
}

__global__ void __launch_bounds__(NTHR, 2) hdb_fwd(Args args) {
    extern __shared__ __attribute__((aligned(16))) unsigned char lds_raw[];
    LAS unsigned char* lds = (LAS unsigned char*)lds_raw;
    const int tid0 = threadIdx.x, wid = __builtin_amdgcn_readfirstlane(tid0 >> 6);
    const int G = gridDim.x, bx = blockIdx.x;
typedef const __attribute__((address_space(4))) char* K4;
#define INP(i) (*(const float* const __attribute__((address_space(4)))*)(kargs_ + 8 * (i)))
#define PH_LOCALS_X PH_LOCALS const float* modl = MOD + l * 5 * 6144; (void)modl;
#define PH_LOCALS K4 kargs_ = (K4)__builtin_amdgcn_kernarg_segment_ptr(); asm volatile("" : "+s"(kargs_)); unsigned char* wsl = *(unsigned char* const __attribute__((address_space(4)))*)(kargs_ + 272); int tid = tid0; asm volatile("" : "+v"(tid)); const int lane = tid & 63; const int gw = bx * NWAVES + wid, NGW = G * NWAVES; (void)lane; (void)gw; (void)NGW;
    unsigned char* ws = args.ws;
    unsigned* ctl = (unsigned*)(ws + WS_CTL);
    LAS int* tb = (LAS int*)(lds + MISC_OFF);
    volatile LAS unsigned* barst = (volatile LAS unsigned*)(lds + MISC_OFF + 512);
    if (tid0 < 4) barst[tid0] = 0u;
    __syncthreads();
    XcdBarrier bar; bar.bar = ctl + CW_BAR; bar.x = 0; bar.st = nullptr;
    if (!MK_PER_PHASE) bar = xcd_barrier_post(ctl + CW_BAR, barst);
    const int lo = args.ph_lo, hi_ph = args.ph_hi;
#ifndef PHMASK
#define PHMASK 0xfff
#endif
#define PHON(b) (((PHMASK) >> (b)) & 1)
#ifndef REPMASK
#define REPMASK 0
#endif
#define NREP(b) ((((REPMASK) >> (b)) & 1) ? 2 : 1)
#define IN(k) (lo <= (k) && (k) < hi_ph)
#define SEAM(k) do { if (!MK_PER_PHASE && IN(k) && IN((k) + 1)) xcd_barrier(bar); } while (0)

#define MOD ((float*)(wsl + WS_MOD))
#define ROPE ((f32x2*)(wsl + WS_ROPE))
#define TOKEP ((unsigned*)(wsl + WS_TOKEP))
#define TOKW ((float*)(wsl + WS_TOKW))
#define TOKMAP ((int*)(wsl + WS_TOKMAP))
#define WIN ((bf16_t*)(wsl + WS_WIN))
#define WB ((bf16_t*)(wsl + WS_WB))
#define WO ((bf16_t*)(wsl + WS_WO))
#define WGU ((bf16_t*)(wsl + WS_WGU))
#define WD ((bf16_t*)(wsl + WS_WD))
#define H ((bf16_t*)(wsl + WS_H))
#define QKV ((bf16_t*)(wsl + WS_QKV))
#define GT ((bf16_t*)(wsl + WS_G))
#define BR ((bf16_t*)(wsl + WS_BR))
#define XRB ((bf16_t*)(wsl + WS_XR))
#define ACT ((bf16_t*)(wsl + WS_ACT))
#define Y ((bf16_t*)(wsl + WS_Y))

    if (PHON(10) && IN(0)) {
        PH_LOCALS
        for (int it = bx; it < 192; it += G) {
            const int l = it / 96, col0 = (it % 96) * 64;
            LAS float* sl = (LAS float*)lds; LAS float* part = (LAS float*)(lds + 20480);
            for (int i = tid; i < 5 * 1024; i += NTHR) { const int r = i >> 10, k = i & 1023; const float v = (r < 4) ? INP(I_C)[r * 1024 + k] : INP(I_CCTX)[k]; sl[i] = v / (1.0f + __expf(-v)); }
            __syncthreads();
            float acc[5] = {0.f, 0.f, 0.f, 0.f, 0.f};
            const float* wp = INP(I_WADA) + ((size_t)l * 1024 + wid * 128) * 6144 + col0 + lane;
#pragma unroll 16
            for (int kk = 0; kk < 128; ++kk) { const float w = wp[(size_t)kk * 6144];
#pragma unroll
                for (int r = 0; r < 5; ++r) acc[r] += sl[r * 1024 + wid * 128 + kk] * w; }
#pragma unroll
            for (int r = 0; r < 5; ++r) part[(wid * 5 + r) * 64 + lane] = acc[r];
            __syncthreads();
            if (tid < 320) { const int r = tid >> 6, ln = tid & 63; float s = 0.f;
#pragma unroll
                for (int w = 0; w < 8; ++w) s += part[(w * 5 + r) * 64 + ln];
                MOD[(l * 5 + r) * 6144 + col0 + ln] = s + INP(I_BADA)[l * 6144 + col0 + ln]; }
            __syncthreads();
        }
        for (int i = bx * NTHR + tid; i < SEQ * 48; i += G * NTHR) {
            const int t = i / 48, j = i - t * 48; const float row = (float)(t >> 6), col = (float)(t & 63);
            float ang;
            if (j < 32) { const int jj = j & 15; const float inv = powf(10000.0f, -(float)jj / 16.0f); ang = (j < 16 ? row : col) * inv; }
            else { const int j2 = j - 32, jj = j2 & 7; const float inv = powf(10000.0f, -(float)jj / 8.0f); ang = (j2 < 8 ? row : col) * inv; }
            float sn, cs; sincosf(ang, &sn, &cs);
            ROPE[i] = (f32x2){cs, sn};
        }
        if (bx == 0) for (int i = tid; i < DM / 2; i += NTHR) ((unsigned*)(H + (size_t)TT * DM))[i] = 0u;
        {
            LAS float* scr = (LAS float*)(lds + wid * 16384);
            constexpr int I_IN = 2 * 16 * 208, I_BRN = 8 * 4 * 32, I_OUT = 2 * 16 * 32, I_GU = 64 * 16 * 64, I_DN = 64 * 16 * 32;
            constexpr int NITEMS = I_IN + I_BRN + I_OUT + I_GU + I_DN;
            unsigned* qhead = ctl + 3100; LAS int* qslot = (LAS int*)(lds + MISC_OFF + 768);
            for (;;) {
                __syncthreads();
                if (tid == 0) qslot[0] = (int)__hip_atomic_fetch_add(qhead, 64u, __ATOMIC_RELAXED, __HIP_MEMORY_SCOPE_AGENT);
                __syncthreads();
                const int c0 = qslot[0];
                if (c0 >= NITEMS) break;
                const int c1 = min(c0 + 64, NITEMS);
            for (int it = c0 + wid; it < c1; it += NWAVES) {
                int r = it;
                if (r < I_IN) { const int l = r / 3328, q = r % 3328; p0_transpose_item(INP(I_WIN) + (size_t)l * 1024 * NIN, 1024, NIN, WIN + (size_t)l * NIN * 1024, q, lane, scr, false); continue; } r -= I_IN;
                if (r < I_BRN) { const int mtx = r / 128, q = r % 128; p0_transpose_item(INP(I_WBR) + (size_t)mtx * 256 * 1024, 256, 1024, WB + (size_t)mtx * 1024 * 256, q, lane, scr, false); continue; } r -= I_BRN;
                if (r < I_OUT) { const int l = r / 512, q = r % 512; p0_transpose_item(INP(I_WOUT) + (size_t)l * 1024 * 1024, 1024, 1024, WO + (size_t)l * 1024 * 1024, q, lane, scr, false); continue; } r -= I_OUT;
                if (r < I_GU) { const int mtx = r / 1024, q = r % 1024; p0_transpose_item(INP(I_WGU) + (size_t)mtx * 1024 * 2048, 1024, 2048, WGU + (size_t)mtx * 2048 * 1024, q, lane, scr, true); continue; } r -= I_GU;
                { const int mtx = r / 512, q = r % 512; p0_transpose_item(INP(I_WD) + (size_t)mtx * 1024 * 1024, 1024, 1024, WD + (size_t)mtx * 1024 * 1024, q, lane, scr, false); }
            }
            }
        }
    }
    SEAM(0);
#ifdef PROBE_BARS
    for (int i_ = 0; i_ < PROBE_BARS; ++i_) xcd_barrier(bar);
#endif

    for (int l = 0; l < 2; ++l) {
        const int pb = 1 + 10 * l;
        const int nrows_m = l == 0 ? TT : TL;
        unsigned* gcount = ctl + CW_GCOUNT + 64 * l;

        if (PHON(0) && IN(pb + 0)) {
            PH_LOCALS_X
            if (l == 1) moe_tables(tb, ctl + CW_GCOUNT);
            const float* g2prev = MOD + 0 * 5 * 6144;
            const f32x4* gn = (const f32x4*)(INP(I_N1G) + l * DM) + lane;
            for (int rowA = gw; rowA < TT; rowA += 2 * NGW) {
                const bool hasB = rowA + NGW < TT; const int rowB = hasB ? rowA + NGW : rowA;
                f32x4 v[2][4], a[2][4];
#pragma unroll
                for (int r = 0; r < 2; ++r) { const int row = r ? rowB : rowA;
                    if (l == 0) { const f32x4* xr = (const f32x4*)(row < TL ? INP(I_X) + (size_t)row * DM : INP(I_CTX) + (size_t)(row - TL) * DM) + lane;
#pragma unroll
                        for (int j = 0; j < 4; ++j) v[r][j] = xr[64 * j]; }
                    else { const u32x2* xr = (const u32x2*)(XRB + (size_t)row * DM) + lane;
#pragma unroll
                        for (int j = 0; j < 4; ++j) { const u32x2 t2 = xr[64 * j]; v[r][j] = (f32x4){bflo(t2.x), bfhi(t2.x), bflo(t2.y), bfhi(t2.y)}; } }
#pragma unroll
                    for (int j = 0; j < 4; ++j) a[r][j] = (f32x4){0.f, 0.f, 0.f, 0.f}; }
                if (l == 1) {
                    moe_gather_row(a[0], rowA, TOKEP, TOKW, tb, Y, lane);
                    moe_gather_row(a[1], rowB, TOKEP, TOKW, tb, Y, lane);
                }
#pragma unroll
                for (int r = 0; r < 2; ++r) { const int row = r ? rowB : rowA; const int ridx = row < TL ? (row >> 13) : 4;
                    if (r == 1 && !hasB) break;
                    if (l == 1) { u32x2* xw = (u32x2*)(XRB + (size_t)row * DM) + lane; const f32x4* g2 = (const f32x4*)(g2prev + ridx * 6144 + 5 * 1024) + lane;
#pragma unroll
                        for (int j = 0; j < 4; ++j) { v[r][j] += g2[64 * j] * a[r][j]; u32x2 w2; w2.x = cvtpk(v[r][j][0], v[r][j][1]); w2.y = cvtpk(v[r][j][2], v[r][j][3]); xw[64 * j] = w2; } }
                    float ss = 0.f;
#pragma unroll
                    for (int j = 0; j < 4; ++j) ss += (v[r][j][0] * v[r][j][0] + v[r][j][1] * v[r][j][1]) + (v[r][j][2] * v[r][j][2] + v[r][j][3] * v[r][j][3]);
                    const float rstd = __builtin_amdgcn_rsqf(wave_sum(ss, lane) * (1.0f / DM) + EPSN);
                    const f32x4* sh = (const f32x4*)(modl + ridx * 6144) + lane; const f32x4* sc = (const f32x4*)(modl + ridx * 6144 + 1024) + lane;
                    u32x2* o8 = (u32x2*)(H + (size_t)row * DM) + lane;
#pragma unroll
                    for (int j = 0; j < 4; ++j) { const f32x4 y = (v[r][j] * rstd * gn[64 * j]) * (sc[64 * j] + 1.0f) + sh[64 * j];
                        u32x2 w; w.x = cvtpk(y[0], y[1]); w.y = cvtpk(y[2], y[3]); o8[64 * j] = w; } }
            }
        }
        SEAM(pb + 0);

        if (PHON(1) && IN(pb + 1)) {
            PH_LOCALS_X
            pg8::DenseSched S; S.nM = TT / 256; S.nN = NIN / 256; S.nwg = S.nM * S.nN; S.G = G; S.c = bx; S.Bt = (const char*)(WIN + (size_t)l * NIN * 1024); S.ldb2 = 2048; S.kmul = 0;
            pg8::EpiIn E{QKV, GT, INP(I_BGATE) + l * NGATE};
            pg8::gemm_phase<pg8::EpiIn, pg8::DenseSched>(lds, (const char*)H, 2048u, 2048u, 1024, S, E);
        }
        SEAM(pb + 1);

        if (PHON(2) && IN(pb + 2)) {
            PH_LOCALS_X
            const int total = TT * 96, S4 = G * NTHR;
            for (int i0 = bx * NTHR + tid; i0 < total; i0 += 4 * S4) {
                u32x4 uu[4]; f32x4 gg[4][2], rr[4][4]; int rows[4], prs[4]; bool ok[4];
#pragma unroll
                for (int q = 0; q < 4; ++q) { const int i = i0 + q * S4; ok[q] = i < total; const int ii = ok[q] ? i : i0;
                    rows[q] = ii / 96; prs[q] = ii - rows[q] * 96;
                    const int kc = prs[q] >> 3, p = prs[q] & 7; const int mixer = kc < 2 ? 0 : (kc < 6 ? 1 : (kc < 8 ? 2 : 3)); const bool is32 = mixer == 1;
                    uu[q] = *(const u32x4*)(QKV + (size_t)rows[q] * NQKV + 1024 + kc * 64 + p * 8);
                    const int gi = mixer == 0 ? I_AKN : mixer == 1 ? I_BKN : mixer == 2 ? I_CKN : I_DKN;
                    const float* gain = INP(gi) + l * (is32 ? 32 : 64) + (is32 ? (p & 3) : p) * 8;
                    gg[q][0] = *(const f32x4*)gain; gg[q][1] = *(const f32x4*)(gain + 4);
                    const f32x4* rt = (const f32x4*)(ROPE + (size_t)(rows[q] & (SEQ - 1)) * 48 + (is32 ? 32 + (p & 1) * 8 : (p & 3) * 8));
#pragma unroll
                    for (int e = 0; e < 4; ++e) rr[q][e] = rt[e]; }
#pragma unroll
                for (int q = 0; q < 4; ++q) {
                    const int row = rows[q], kc = prs[q] >> 3, p = prs[q] & 7;
                    const int mixer = kc < 2 ? 0 : (kc < 6 ? 1 : (kc < 8 ? 2 : 3));
                    const u32x4 u = uu[q];
                    float x[8] = {bflo(u.x), bfhi(u.x), bflo(u.y), bfhi(u.y), bflo(u.z), bfhi(u.z), bflo(u.w), bfhi(u.w)};
                    float ss = 0.f;
#pragma unroll
                    for (int e = 0; e < 8; ++e) ss += x[e] * x[e];
                    ss += shx(ss, 1, lane); ss += shx(ss, 2, lane);
                    const float s4 = shx(ss, 4, lane);
                    const bool is32 = mixer == 1;
                    if (!is32) ss += s4;
                    const float rs = __builtin_amdgcn_rsqf(ss * (is32 ? 1.0f / 32.0f : 1.0f / 64.0f) + EPSN);
#pragma unroll
                    for (int e = 0; e < 4; ++e) { x[e] *= rs * gg[q][0][e]; x[4 + e] *= rs * gg[q][1][e]; }
                    const bool rope = (row < TL) && (mixer != 3);
                    const float sgn = (is32 ? (p & 2) : (p & 4)) ? 1.0f : -1.0f;
#pragma unroll
                    for (int e = 0; e < 8; ++e) { const float p2 = shx(x[e], 2, lane), p4 = shx(x[e], 4, lane); const float pt = is32 ? p2 : p4;
                        const float cs = rr[q][e >> 1][(e & 1) * 2], sn = rr[q][e >> 1][(e & 1) * 2 + 1];
                        if (rope) x[e] = x[e] * cs + sgn * pt * sn; }
                    u32x4 w; w.x = cvtpk(x[0], x[1]); w.y = cvtpk(x[2], x[3]); w.z = cvtpk(x[4], x[5]); w.w = cvtpk(x[6], x[7]);
                    if (ok[q]) *(u32x4*)(QKV + (size_t)row * NQKV + 1024 + kc * 64 + p * 8) = w;
                }
            }
        }
        SEAM(pb + 2);

        if (PHON(3) && IN(pb + 3)) {
            PH_LOCALS_X
            const float lam_init = 0.8f - 0.6f * __expf(-0.3f * (float)l);
            float lam;
            { const float a = (lane < 32) ? INP(I_LQ1)[l * 32 + lane] * INP(I_LK1)[l * 32 + lane] : 0.f, b = (lane < 32) ? INP(I_LQ2)[l * 32 + lane] * INP(I_LK2)[l * 32 + lane] : 0.f;
              lam = __expf(wave_sum(a, lane)) - __expf(wave_sum(b, lane)) + lam_init; lam = __builtin_bit_cast(float, __builtin_amdgcn_readfirstlane(__builtin_bit_cast(int, lam))); }
            const float* subln = INP(I_SUBLN) + l * 64;
            const int ctxb = TL;
#if !defined(ATT_ONLY) || ATT_ONLY == 0
            for (int u = bx; u < 512; u += G) {
                att::UnitP P; P.linit = 0.f; P.lam = lam; P.outscale = 1.0f - lam_init; P.subln = subln;
                const int bh = (u & 7) * 2 + ((u >> 8) & 1), blk = (u >> 3) & 31, b = bh >> 2, h = bh & 3;
                P.qrow0 = b * SEQ + blk * 256 + wid * 32; P.qpos0 = blk * 256 + wid * 32;
                P.qcol = QB_ + h * 64; P.kcol = KB_ + h * 64; P.vcol = VB_ + h * 64; P.ocol = 256 + h * 64; P.qgain = INP(I_BQN) + l * 32; P.rope = ROPE;
                P.locrow0 = b * SEQ; P.nloc = 128; P.kpos0 = 0; P.ctxrow0 = ctxb + b * CTXL;
                att::attn_unit<1>(lds, QKV, BR, P);
            }
#endif
#if !defined(ATT_ONLY) || ATT_ONLY == 1
            for (int u = bx; u < 256; u += G) {
                att::UnitP P; P.linit = 0.f; P.lam = lam; P.outscale = 1.0f; P.subln = subln;
                const int bk = u & 7, blk = u >> 3, b = bk >> 1, kvh = bk & 1, h = kvh * 2 + (wid >> 2);
                P.qrow0 = b * SEQ + blk * 256 + (wid & 3) * 64; P.qpos0 = blk * 256 + (wid & 3) * 64;
                P.qcol = QA + h * 64; P.kcol = KA + kvh * 64; P.vcol = VA + kvh * 64; P.ocol = 0 + h * 64; P.qgain = INP(I_AQN) + l * 64; P.rope = ROPE;
                P.locrow0 = b * SEQ; P.nloc = 128; P.kpos0 = 0; P.ctxrow0 = ctxb + b * CTXL;
                att::attn_unit_a2(lds, QKV, BR, P);
            }
#endif
#if !defined(ATT_ONLY) || ATT_ONLY == 2
            for (;;) { LAS int* qs_ = (LAS int*)(lds + MISC_OFF + 772);
                __syncthreads(); if (tid == 0) qs_[0] = (int)__hip_atomic_fetch_add(ctl + 3200 + 8 * l, 1u, __ATOMIC_RELAXED, __HIP_MEMORY_SCOPE_AGENT); __syncthreads();
                const int u = qs_[0]; if (u >= 512) break;
                att::UnitP P; P.lam = lam; P.outscale = 1.0f; P.subln = subln;
                const int bk = u & 7, blk = u >> 3, b = bk >> 1, kvh = bk & 1, h = kvh * 2 + (wid >> 2);
                P.qrow0 = b * SEQ + blk * 128 + (wid & 3) * 32; P.qpos0 = blk * 128 + (wid & 3) * 32;
                P.qcol = QC + h * 64; P.kcol = KC + kvh * 64; P.vcol = VC + kvh * 64; P.ocol = 512 + h * 64; P.qgain = INP(I_CQN) + l * 64; P.rope = ROPE;
                const int k0 = max(blk * 128 - 128, 0), k1 = min(blk * 128 + 256, SEQ);
                P.locrow0 = b * SEQ + k0; P.nloc = (k1 - k0) >> 6; P.kpos0 = k0; P.ctxrow0 = ctxb + b * CTXL;
                P.linit = __builtin_amdgcn_exp2f(INP(I_SINK)[l * 4 + h] * LOG2E);
                att::attn_unit<2>(lds, QKV, BR, P);
            }
#endif
#if !defined(ATT_ONLY) || ATT_ONLY == 3
            for (;;) { LAS int* qs_ = (LAS int*)(lds + MISC_OFF + 772);
                __syncthreads(); if (tid == 0) qs_[0] = (int)__hip_atomic_fetch_add(ctl + 3201 + 8 * l, 1u, __ATOMIC_RELAXED, __HIP_MEMORY_SCOPE_AGENT); __syncthreads();
                const int u = qs_[0]; if (u >= 512) break;
                att::UnitP P; P.linit = 0.f; P.lam = lam; P.outscale = 1.0f; P.subln = subln;
                const int bh = (u & 7) * 2 + ((u >> 8) & 1), blk = (u >> 3) & 31, b = bh >> 2, h = bh & 3;
                { LAS float* bt = (LAS float*)(lds + att::LDS_BIAS); const float* rp = INP(I_RPB) + ((size_t)l * 4 + h) * 465;
                  for (int i = tid; i < 465; i += NTHR) bt[i] = rp[i] * LOG2E; }
                P.qrow0 = b * SEQ + blk * 256 + wid * 32; P.qpos0 = blk * 256 + wid * 32;
                P.qcol = QD + h * 64; P.kcol = KD + h * 64; P.vcol = VD + h * 64; P.ocol = 768 + h * 64; P.qgain = INP(I_DQN) + l * 64; P.rope = nullptr;
                const int ra = min(max(4 * blk - 4, 0), 120), rb = min(max(4 * blk + 3 - 4, 0), 120) + 8;
                P.locrow0 = b * SEQ + ra * 64; P.nloc = rb - ra; P.kpos0 = ra * 64; P.ctxrow0 = ctxb + b * CTXL;
                att::attn_unit<3>(lds, QKV, BR, P);
            }
#endif
#ifndef ATT_ONLY
            if (l == 0) {
                for (int u = bx; u < 64; u += G) if ((u >> 4) == 0) {
                    const int v = u & 15, b = v >> 2, kvh = (v >> 1) & 1, blk = v & 1, h = kvh * 2 + (wid >> 2);
                    att::UnitP P; P.linit = 0.f; P.lam = lam; P.outscale = 1.0f; P.subln = subln; P.nloc = 0; P.locrow0 = 0; P.kpos0 = 0; P.qpos0 = 0;
                    P.qrow0 = ctxb + b * CTXL + blk * 128 + (wid & 3) * 32; P.ctxrow0 = ctxb + b * CTXL;
                    P.qcol = QA + h * 64; P.kcol = KA + kvh * 64; P.vcol = VA + kvh * 64; P.ocol = h * 64; P.qgain = INP(I_AQN) + l * 64; P.rope = nullptr;
                    att::attn_unit<0>(lds, QKV, BR, P);
                }
                for (int u = bx; u < 64; u += G) if ((u >> 4) == 1) {
                    const int v = u & 15, b = v >> 2, h = v & 3;
                    att::UnitP P; P.linit = 0.f; P.lam = lam; P.outscale = 1.0f - lam_init; P.subln = subln; P.nloc = 0; P.locrow0 = 0; P.kpos0 = 0; P.qpos0 = 0;
                    P.qrow0 = ctxb + b * CTXL + wid * 32; P.ctxrow0 = ctxb + b * CTXL;
                    P.qcol = QB_ + h * 64; P.kcol = KB_ + h * 64; P.vcol = VB_ + h * 64; P.ocol = 256 + h * 64; P.qgain = INP(I_BQN) + l * 32; P.rope = nullptr;
                    att::attn_unit<1>(lds, QKV, BR, P);
                }
                for (int u = bx; u < 64; u += G) if ((u >> 4) == 2) {
                    const int v = u & 15, b = v >> 2, kvh = (v >> 1) & 1, blk = v & 1, h = kvh * 2 + (wid >> 2);
                    att::UnitP P; P.lam = lam; P.outscale = 1.0f; P.subln = subln; P.nloc = 0; P.locrow0 = 0; P.kpos0 = 0; P.qpos0 = 0;
                    P.qrow0 = ctxb + b * CTXL + blk * 128 + (wid & 3) * 32; P.ctxrow0 = ctxb + b * CTXL;
                    P.qcol = QC + h * 64; P.kcol = KC + kvh * 64; P.vcol = VC + kvh * 64; P.ocol = 512 + h * 64; P.qgain = INP(I_CQN) + l * 64; P.rope = nullptr;
                    P.linit = __builtin_amdgcn_exp2f(INP(I_SINK)[l * 4 + h] * LOG2E);
                    att::attn_unit<0>(lds, QKV, BR, P);
                }
                for (int u = bx; u < 64; u += G) if ((u >> 4) == 3) {
                    const int v = u & 15, b = v >> 2, h = v & 3;
                    att::UnitP P; P.linit = 0.f; P.lam = lam; P.outscale = 1.0f; P.subln = subln; P.nloc = 0; P.locrow0 = 0; P.kpos0 = 0; P.qpos0 = 0;
                    P.qrow0 = ctxb + b * CTXL + wid * 32; P.ctxrow0 = ctxb + b * CTXL;
                    P.qcol = QD + h * 64; P.kcol = KD + h * 64; P.vcol = VD + h * 64; P.ocol = 768 + h * 64; P.qgain = INP(I_DQN) + l * 64; P.rope = nullptr;
                    att::attn_unit<0>(lds, QKV, BR, P);
                }
            }
#endif
        }
        SEAM(pb + 3);

        if (PHON(4) && IN(pb + 4)) {
            PH_LOCALS_X
            pg8::BranchSchedH S; S.nM = nrows_m / 256; S.nwg = S.nM * 8; S.G = G; S.c = bx; S.Bt = (const char*)(WB + (size_t)l * 4096 * 256);
            pg8::EpiBranchH E{}; E.Gt = GT; E.SUMB = H;
            pg8::gemm_phase<pg8::EpiBranchH, pg8::BranchSchedH>(lds, (const char*)BR, 2048u, 512u, 256, S, E);
        }
        SEAM(pb + 4);

        if (PHON(5) && IN(pb + 5)) {
            PH_LOCALS_X
        }

        if (PHON(6) && IN(pb + 6)) {
            PH_LOCALS_X
            pg8::DenseSched S; S.nM = nrows_m / 256; S.nN = 4; S.nwg = S.nM * S.nN; S.G = G; S.c = bx; S.Bt = (const char*)(WO + (size_t)l * 1024 * 1024); S.ldb2 = 2048; S.kmul = 0;
            pg8::EpiOut E{INP(I_X), INP(I_CTX), XRB, modl, l};
            pg8::gemm_phase<pg8::EpiOut, pg8::DenseSched>(lds, (const char*)H, 2048u, 2048u, 1024, S, E);
        }
        SEAM(pb + 6);

        if (PHON(7) && IN(pb + 7)) {
            PH_LOCALS_X
            constexpr int XRS = 2064;
            LAS char* xh = (LAS char*)lds;
            constexpr int XLO = 32 * XRS;
            LAS float* part = (LAS float*)lds;
            LAS float* lgl = (LAS float*)(lds + 133120);
            LAS unsigned* ent = (LAS unsigned*)lgl;
            LAS int* lcount = (LAS int*)(lds + 133120 + 160 * 128);
            const float* rw = INP(I_RW) + (size_t)l * 1024 * 32;
            if (tid < 64) lcount[tid] = 0;
            const int nloc_rows = (nrows_m - bx + G - 1) / G;
            const f32x4* gn = (const f32x4*)(INP(I_N2G) + l * DM) + lane;
            const int fn = lane & 31, fkg = lane >> 5;
            bf16x8 wh[8], wl[8];
#pragma unroll
            for (int s = 0; s < 8; ++s) { const float* wp = rw + (size_t)(128 * wid + 16 * s + 8 * fkg) * 32 + fn; u32x4 h4, l4;
#pragma unroll
                for (int i = 0; i < 4; ++i) { const float w0 = wp[(2 * i) * 32], w1 = wp[(2 * i + 1) * 32]; const unsigned hp = cvtpk(w0, w1); h4[i] = hp; l4[i] = cvtpk(w0 - bflo(hp), w1 - bfhi(hp)); }
                wh[s] = __builtin_bit_cast(bf16x8, h4); wl[s] = __builtin_bit_cast(bf16x8, l4); }
            f32x4 gnv[4];
#pragma unroll
            for (int j = 0; j < 4; ++j) gnv[j] = gn[64 * j];
            const float rb0 = INP(I_RB)[l * 32 + (tid & 15) * 2], rb1 = INP(I_RB)[l * 32 + (tid & 15) * 2 + 1];
            u32x2 nx[4][4];
#pragma unroll
            for (int i = 0; i < 4; ++i) { const int li = wid * 4 + i; const u32x2* xr = (const u32x2*)(XRB + (size_t)(bx + (li < nloc_rows ? li : 0) * G) * DM) + lane;
#pragma unroll
                for (int j = 0; j < 4; ++j) nx[i][j] = xr[64 * j]; }
            const int nch = (nloc_rows + 31) >> 5;
            for (int c = 0; c < nch; ++c) {
                const int rowc = bx + c * 32 * G; const int ridx = rowc < TL ? (rowc >> 13) : 4;
                f32x4 shv[4], scv[4];
                { const f32x4* sh = (const f32x4*)(modl + ridx * 6144 + 3 * 1024) + lane; const f32x4* sc = (const f32x4*)(modl + ridx * 6144 + 4 * 1024) + lane;
#pragma unroll
                    for (int j = 0; j < 4; ++j) { shv[j] = sh[64 * j]; scv[j] = sc[64 * j]; } }
                __builtin_amdgcn_sched_barrier(0);
#pragma unroll
                for (int pr = 0; pr < 2; ++pr) {
                    f32x4 v[2][4]; float ss[2] = {0.f, 0.f};
#pragma unroll
                    for (int r = 0; r < 2; ++r)
#pragma unroll
                        for (int j = 0; j < 4; ++j) { const u32x2 t2 = nx[2 * pr + r][j]; v[r][j] = (f32x4){bflo(t2.x), bfhi(t2.x), bflo(t2.y), bfhi(t2.y)}; }
                    __builtin_amdgcn_sched_barrier(0);
#pragma unroll
                    for (int r = 0; r < 2; ++r) { const int li = (c + 1) * 32 + wid * 4 + 2 * pr + r; const u32x2* xr = (const u32x2*)(XRB + (size_t)(bx + (li < nloc_rows ? li : 0) * G) * DM) + lane;
#pragma unroll
                        for (int j = 0; j < 4; ++j) nx[2 * pr + r][j] = xr[64 * j]; }
                    __builtin_amdgcn_sched_barrier(0);
#pragma unroll
                    for (int r = 0; r < 2; ++r) {
#pragma unroll
                        for (int j = 0; j < 4; ++j) ss[r] += (v[r][j][0] * v[r][j][0] + v[r][j][1] * v[r][j][1]) + (v[r][j][2] * v[r][j][2] + v[r][j][3] * v[r][j][3]); }
#pragma unroll
                    for (int r = 0; r < 2; ++r) { const int rc = wid * 4 + 2 * pr + r, li = c * 32 + rc; const bool valid = li < nloc_rows; const int row = bx + (valid ? li : 0) * G;
                        const float rstd = __builtin_amdgcn_rsqf(wave_sum(ss[r], lane) * (1.0f / DM) + EPSN);
                        u32x2* o8 = (u32x2*)(H + (size_t)row * DM) + lane;
#pragma unroll
                        for (int j = 0; j < 4; ++j) { const f32x4 y = (v[r][j] * rstd * gnv[j]) * (scv[j] + 1.0f) + shv[j];
                            u32x2 w, wlo; w.x = cvtpk(y[0], y[1]); w.y = cvtpk(y[2], y[3]); wlo.x = cvtpk(y[0] - bflo(w.x), y[1] - bfhi(w.x)); wlo.y = cvtpk(y[2] - bflo(w.y), y[3] - bfhi(w.y));
                            if (valid) o8[64 * j] = w;
                            *(LAS u32x2*)(xh + rc * XRS + (4 * lane + 256 * j) * 2) = w; *(LAS u32x2*)(xh + XLO + rc * XRS + (4 * lane + 256 * j) * 2) = wlo; } }
                }
                __syncthreads();
                f32x16 acc;
#pragma unroll
                for (int i = 0; i < 16; ++i) acc[i] = 0.f;
                { LAS const char* bh = xh + fn * XRS + (128 * wid + 8 * fkg) * 2;
#pragma unroll
                    for (int s = 0; s < 8; ++s) { const bf16x8 fh = *(LAS const bf16x8*)(bh + 32 * s), fl = *(LAS const bf16x8*)(bh + XLO + 32 * s);
                        acc = ATT_MFMA(wh[s], fh, acc); acc = ATT_MFMA(wh[s], fl, acc); acc = ATT_MFMA(wl[s], fh, acc); } }
                __syncthreads();
#pragma unroll
                for (int q = 0; q < 4; ++q) *(LAS f32x4*)(part + (wid * 32 + fn) * 36 + 8 * q + 4 * fkg) = (f32x4){acc[4 * q], acc[4 * q + 1], acc[4 * q + 2], acc[4 * q + 3]};
                __syncthreads();
                { const int r = tid >> 4, e0 = (tid & 15) * 2; f32x2 sacc = (f32x2){rb0, rb1};
#pragma unroll
                    for (int w = 0; w < 8; ++w) sacc += *(LAS const f32x2*)(part + (w * 32 + r) * 36 + e0);
                    *(LAS f32x2*)(lgl + (c * 32 + r) * 32 + e0) = sacc; }
                __syncthreads();
            }
            __syncthreads();
            for (int li = tid; li < nloc_rows; li += NTHR) {
                float q[32];
#pragma unroll
                for (int i = 0; i < 8; ++i) { const f32x4 t4 = *(const LAS f32x4*)(lgl + li * 32 + 4 * i); q[4 * i] = t4[0]; q[4 * i + 1] = t4[1]; q[4 * i + 2] = t4[2]; q[4 * i + 3] = t4[3]; }
                int te[4]; float tv[4];
#pragma unroll
                for (int k = 0; k < 4; ++k) { float best = q[0]; int bi = 0;
#pragma unroll
                    for (int e = 1; e < 32; ++e) { const bool gt = q[e] > best; best = gt ? q[e] : best; bi = gt ? e : bi; }
                    te[k] = bi; tv[k] = best;
#pragma unroll
                    for (int e = 0; e < 32; ++e) q[e] = (e == bi) ? -INFINITY : q[e]; }
                float ew[4], es = 0.f;
#pragma unroll
                for (int k = 0; k < 4; ++k) { ew[k] = __expf(tv[k] - tv[0]); es += ew[k]; }
                const float ies = 1.0f / es;
#pragma unroll
                for (int k = 0; k < 4; ++k) { const int lp = __hip_atomic_fetch_add(&lcount[te[k]], 1, __ATOMIC_RELAXED, __HIP_MEMORY_SCOPE_WORKGROUP);
                    ent[li * 32 + 2 * k] = (unsigned)te[k] | ((unsigned)lp << 8); ent[li * 32 + 2 * k + 1] = __float_as_uint(ew[k] * ies); }
            }
            __syncthreads();
            if (tid < 32) lcount[32 + tid] = (int)atomicAdd(&gcount[tid], (unsigned)lcount[tid]);
            __syncthreads();
            for (int i = tid; i < nloc_rows * 4; i += NTHR) { const int li = i >> 2, k = i & 3, row = bx + li * G;
                const unsigned ev = ent[li * 32 + 2 * k]; const int e = (int)(ev & 255u), pos = lcount[32 + e] + (int)(ev >> 8);
                TOKMAP[(size_t)e * ECAP + pos] = row; TOKEP[row * 4 + k] = ((unsigned)e << 24) | (unsigned)pos; TOKW[row * 4 + k] = __uint_as_float(ent[li * 32 + 2 * k + 1]); }
            __syncthreads();
        }
        SEAM(pb + 7);

        if (PHON(8) && IN(pb + 8)) {
            PH_LOCALS_X
            moe_tables(tb, gcount);
            pg8::MoeSched S; S.G = G; S.c = bx; S.npn = 8; S.gather = 1; S.tb = tb; S.tokmap = TOKMAP; S.Bt = (const char*)(WGU + (size_t)l * 32 * 2048 * 1024); S.bexp = (size_t)2048 * 1024 * 2; S.ldb2 = 2048; S.zrow = TT;
            pg8::EpiSwiglu E{ACT, INP(I_BGU) + (size_t)l * 32 * 2048};
            pg8::gemm_phase<pg8::EpiSwiglu, pg8::MoeSched>(lds, (const char*)H, 2048u, 2048u, 1024, S, E);
        }
        SEAM(pb + 8);

        if (PHON(9) && IN(pb + 9)) {
            PH_LOCALS_X
            moe_tables(tb, gcount);
            pg8::MoeSched S; S.G = G; S.c = bx; S.npn = 4; S.gather = 0; S.tb = tb; S.tokmap = TOKMAP; S.Bt = (const char*)(WD + (size_t)l * 32 * 1024 * 1024); S.bexp = (size_t)1024 * 1024 * 2; S.ldb2 = 2048; S.zrow = TT;
            pg8::EpiDown E{Y, INP(I_BD) + (size_t)l * 32 * 1024};
            pg8::gemm_phase<pg8::EpiDown, pg8::MoeSched>(lds, (const char*)ACT, 2048u, 2048u, 1024, S, E);
        }
        SEAM(pb + 9);
    }

    if (PHON(11) && IN(21)) {
        PH_LOCALS
        moe_tables(tb, ctl + CW_GCOUNT + 64);
        const float* mod1 = MOD + 1 * 5 * 6144;
        for (int rowA = gw; rowA < TL; rowA += 2 * NGW) {
            const bool hasB = rowA + NGW < TL; const int rowB = hasB ? rowA + NGW : rowA;
            f32x4 v[2][4], a[2][4];
#pragma unroll
            for (int r = 0; r < 2; ++r) { const u32x2* xr = (const u32x2*)(XRB + (size_t)(r ? rowB : rowA) * DM) + lane;
#pragma unroll
                for (int j = 0; j < 4; ++j) { const u32x2 t2 = xr[64 * j]; v[r][j] = (f32x4){bflo(t2.x), bfhi(t2.x), bflo(t2.y), bfhi(t2.y)}; a[r][j] = (f32x4){0.f, 0.f, 0.f, 0.f}; } }
            moe_gather_row(a[0], rowA, TOKEP, TOKW, tb, Y, lane);
            moe_gather_row(a[1], rowB, TOKEP, TOKW, tb, Y, lane);
#pragma unroll
            for (int r = 0; r < 2; ++r) { const int row = r ? rowB : rowA;
                if (r == 1 && !hasB) break;
                const f32x4* g2 = (const f32x4*)(mod1 + (row >> 13) * 6144 + 5 * 1024) + lane;
                f32x4* op = (f32x4*)(args.out + (size_t)row * DM) + lane;
#pragma unroll
                for (int j = 0; j < 4; ++j) op[64 * j] = v[r][j] + g2[64 * j] * a[r][j]; }
        }
    }
#undef IN
#undef SEAM
}

extern "C" void kernel_launch(void* const* d_in, const int* in_sizes, int n_in, void* d_out, int out_size, void* d_ws, size_t ws_size, hipStream_t stream) {
    static int grid = 0;
    if (grid == 0) {
        if (n_in != 33 || out_size != TL * DM || ws_size < WS_END) { fprintf(stderr, "kernel_launch: unexpected shapes (n_in %d out %d ws %zu)\n", n_in, out_size, ws_size); grid = -1; return; }
        int dev = 0, cus = 0, per_cu = 0;
        if (hipGetDevice(&dev) != hipSuccess || hipDeviceGetAttribute(&cus, hipDeviceAttributeMultiprocessorCount, dev) != hipSuccess) { grid = -1; return; }
        if (hipFuncSetAttribute((const void*)hdb_fwd, hipFuncAttributeMaxDynamicSharedMemorySize, LDS_BYTES) != hipSuccess) { fprintf(stderr, "kernel_launch: hipFuncSetAttribute failed\n"); grid = -1; return; }
        if (hipOccupancyMaxActiveBlocksPerMultiprocessor(&per_cu, (const void*)hdb_fwd, NTHR, LDS_BYTES) != hipSuccess || per_cu < 1) { fprintf(stderr, "kernel_launch: occupancy query reports %d\n", per_cu); }
        (void)hipGetLastError();
        grid = cus;
        if (grid > 256) grid = 256;
        if (grid != 256) { fprintf(stderr, "kernel_launch: the router phase assumes 256 workgroups (one batch per 32 local rows), device has %d CUs\n", cus); grid = -1; return; }
    }
    if (grid < 0) return;
    (void)hipMemsetAsync((char*)d_ws + WS_CTL, 0, CTL_ZERO_BYTES, stream);
    Args a{};
    for (int i = 0; i < 33; ++i) a.in[i] = (const float*)d_in[i];
    a.out = (float*)d_out; a.ws = (unsigned char*)d_ws;
#if MK_PER_PHASE
    for (int p = 0; p < N_PHASES; ++p) { a.ph_lo = p; a.ph_hi = p + 1; hipLaunchKernelGGL(hdb_fwd, dim3(grid), dim3(NTHR), LDS_BYTES, stream, a); }
#else
    a.ph_lo = 0; a.ph_hi = N_PHASES;
    hipLaunchKernelGGL(hdb_fwd, dim3(grid), dim3(NTHR), LDS_BYTES, stream, a);
#endif
}
```

```cpp
#include <hip/hip_runtime.h>
#include <cstdio>
#include <cstdint>

#ifndef PROBE_SEC
#define PROBE_SEC 0
#endif
#ifndef MK_PER_PHASE
#define MK_PER_PHASE 0
#endif

#define LAS __attribute__((address_space(3)))
typedef unsigned short bf16_t;
typedef short bf16x8 __attribute__((ext_vector_type(8)));
typedef short s16x4 __attribute__((ext_vector_type(4)));
typedef float f32x4 __attribute__((ext_vector_type(4)));
typedef float f32x16 __attribute__((ext_vector_type(16)));
typedef float f32x2 __attribute__((ext_vector_type(2)));
typedef unsigned u32x4 __attribute__((ext_vector_type(4)));
typedef unsigned u32x2 __attribute__((ext_vector_type(2)));
typedef __bf16 bf16x2_t __attribute__((ext_vector_type(2)));

constexpr int DM = 1024, NB = 4, SEQ = 8192, CTXL = 256;
constexpr int TL = NB * SEQ;
constexpr int TC = NB * CTXL;
constexpr int TT = TL + TC;
constexpr int NQKV = 2560, NGATE = 4096, NIN = 6656;
constexpr int NEXP = 32, ECAP = TT;
constexpr int MAXTILES = 560;
constexpr float LOG2E = 1.4426950408889634f;
constexpr float EPSN = 1e-6f;
constexpr int QA = 0, QB_ = 256, QC = 512, QD = 768, KA = 1024, KB_ = 1152, KC = 1408, KD = 1536, VA = 1792, VB_ = 1920, VC = 2176, VD = 2304;

constexpr size_t MiB = 1u << 20;
constexpr size_t WS_CTL = 0, CTL_ZERO_BYTES = 1 * MiB;
constexpr size_t WS_MOD = 1 * MiB;
constexpr size_t WS_ROPE = 2 * MiB;
constexpr size_t WS_TOKEP = 6 * MiB;
constexpr size_t WS_TOKW = 7 * MiB;
constexpr size_t WS_TOKMAP = 8 * MiB;
constexpr size_t WS_WIN = 16 * MiB;
constexpr size_t WS_WB = 42 * MiB;
constexpr size_t WS_WO = 46 * MiB;
constexpr size_t WS_WGU = 50 * MiB;
constexpr size_t WS_WD = 306 * MiB;
constexpr size_t WS_H = 434 * MiB;
constexpr size_t WS_QKV = 501 * MiB;
constexpr size_t WS_G = 666 * MiB;
constexpr size_t WS_BR = 930 * MiB;
constexpr size_t WS_XR = 996 * MiB;
constexpr size_t WS_ACT = 1128 * MiB;
constexpr size_t WS_Y = 1408 * MiB;
constexpr size_t WS_END = 1688 * MiB;
constexpr int CW_GCOUNT = 64;
constexpr int CW_BAR = 4096;

constexpr int LDS_BYTES = 163840;
constexpr int MISC_OFF = LDS_BYTES - 1024;
constexpr int NWAVES = 8, NTHR = 512;

__device__ __forceinline__ unsigned cvtpk(float lo, float hi) { f32x2 v = {lo, hi}; bf16x2_t b = __builtin_convertvector(v, bf16x2_t); return __builtin_bit_cast(unsigned, b); }
__device__ __forceinline__ float bflo(unsigned u) { return __builtin_bit_cast(float, u << 16); }
__device__ __forceinline__ float bfhi(unsigned u) { return __builtin_bit_cast(float, u & 0xffff0000u); }
__device__ __forceinline__ float shx(float v, int m, int lane) { return __builtin_bit_cast(float, __builtin_amdgcn_ds_bpermute((lane ^ m) << 2, __builtin_bit_cast(int, v))); }
__device__ __forceinline__ float wave_sum(float v, int lane) {
#pragma unroll
    for (int o = 1; o < 64; o <<= 1) v += shx(v, o, lane);
    return v;
}
__device__ __forceinline__ float wave_max(float v, int lane) {
#pragma unroll
    for (int o = 1; o < 64; o <<= 1) v = fmaxf(v, shx(v, o, lane));
    return v;
}
#define LDS_WAIT() asm volatile("s_waitcnt lgkmcnt(0)" ::: "memory")
namespace att { __device__ __forceinline__ void glds16(const void* gsrc, unsigned lds_dst); }
#define VM_WAIT() asm volatile("s_waitcnt vmcnt(0)" ::: "memory")

#define XB_TMO      128
#define XB_XCNT(j)  (256  + 64 * (j))
#define XB_XSUB(j)  (1280 + 64 * (j))
#define XB_XGEN(j)  (2304 + 64 * (j))
#define XB_TOP      3328
#define XB_TOPGEN   3392
#define XCD_BAR_WORDS 3456
#define XB_SPIN_CAP (1u << 24)

__device__ __forceinline__ unsigned xb_ld(unsigned* p)              { return __hip_atomic_load(p, __ATOMIC_RELAXED, __HIP_MEMORY_SCOPE_AGENT); }
__device__ __forceinline__ unsigned xb_add(unsigned* p, unsigned v) { return __hip_atomic_fetch_add(p, v, __ATOMIC_RELAXED, __HIP_MEMORY_SCOPE_AGENT); }
__device__ __forceinline__ unsigned xb_xcc_id() { return (unsigned)__builtin_amdgcn_s_getreg((3 << 11) | 20) & 0xFu; }
#define XB_SPIN(cond, bar) do { unsigned _sp = 0; while (cond) { __builtin_amdgcn_s_sleep(1); \
    if ((++_sp & 255u) == 0u) { if (xb_ld(&(bar)[XB_TMO])) break; if (_sp > XB_SPIN_CAP) { atomicAdd(&(bar)[XB_TMO], 1u); break; } } } } while (0)

struct XcdBarrier { unsigned* bar; unsigned x; volatile LAS unsigned* st; };

__device__ __forceinline__ XcdBarrier xcd_barrier_post(unsigned* bar, volatile LAS unsigned* st) {
    XcdBarrier b; b.bar = bar; b.x = xb_xcc_id(); b.st = st;
    if (threadIdx.x == 0) (void)xb_add(&bar[XB_XCNT(b.x)], 1u);
    return b;
}
__device__ __forceinline__ void xcd_barrier_complete(unsigned* bar, unsigned x, unsigned& nloc, unsigned& nx) {
    const unsigned G = gridDim.x * gridDim.y * gridDim.z;
    unsigned sum, cnt, mine, sp = 0u;
    for (;;) {
        sum = 0u; cnt = 0u; mine = 0u;
#pragma unroll
        for (unsigned j = 0; j < 16; ++j) { const unsigned c = xb_ld(&bar[XB_XCNT(j)]); sum += c; cnt += (c > 0u) ? 1u : 0u; mine = (j == x) ? c : mine; }
        if (sum == G) break;
        __builtin_amdgcn_s_sleep(1);
        if ((++sp & 255u) == 0u) { if (xb_ld(&bar[XB_TMO])) break; if (sp > XB_SPIN_CAP) { atomicAdd(&bar[XB_TMO], 1u); break; } }
    }
    nloc = mine > 0u ? mine : 1u; nx = cnt > 0u ? cnt : 1u;
}
__device__ __forceinline__ void xcd_barrier(const XcdBarrier& b) {
    asm volatile("s_waitcnt vmcnt(0)" ::: "memory");
    __syncthreads();
    if (threadIdx.x == 0) {
        unsigned* bar = b.bar;
        __builtin_amdgcn_s_waitcnt(0);
        unsigned nloc = b.st[0], nx = b.st[1];
        if (nloc == 0u) { xcd_barrier_complete(bar, b.x, nloc, nx); b.st[0] = nloc; b.st[1] = nx; }
        const unsigned old = xb_add(&bar[XB_XSUB(b.x)], 1u);
        const unsigned gen = old / nloc;
        if (old + 1u == (gen + 1u) * nloc) {
            __builtin_amdgcn_fence(__ATOMIC_RELEASE, "agent");
            asm volatile("s_waitcnt vmcnt(0)" ::: "memory");
            const unsigned og = xb_add(&bar[XB_TOP], 1u);
            const unsigned tg = og / nx;
            if (og + 1u == (tg + 1u) * nx) xb_add(&bar[XB_TOPGEN], 1u);
            else XB_SPIN(xb_ld(&bar[XB_TOPGEN]) == tg, bar);
            __builtin_amdgcn_fence(__ATOMIC_ACQUIRE, "agent");
            xb_add(&bar[XB_XGEN(b.x)], 1u);
            asm volatile("s_waitcnt vmcnt(0)" ::: "memory");
        } else {
            XB_SPIN(xb_ld(&bar[XB_XGEN(b.x)]) == gen, bar);
            __builtin_amdgcn_fence(__ATOMIC_ACQUIRE, "agent");
            asm volatile("s_waitcnt vmcnt(0)" ::: "memory");
        }
    }
    __syncthreads();
}

namespace pg8 {
constexpr int BM = 256, BK = 64, HALF = 128, HTB = HALF * BK * 2, STAGE_BYTES = 8 * HTB;
__host__ __device__ __forceinline__ int lds_byte(int r, int c) { const int st = (r >> 4) * 2 + (c >> 5), rr = r & 15, cc = c & 31, ob = rr * 64 + cc * 2; return st * 1024 + (ob ^ (((ob >> 9) & 1) << 5)); }
__host__ __device__ __forceinline__ void stage_rc(int b, int& R, int& C) { const int st = b / 1024, sb = b % 1024, swz = sb ^ (((sb >> 9) & 1) << 5); R = (st >> 1) * 16 + swz / 64; C = (st & 1) * 32 + (swz % 64) / 2; }
__host__ __device__ __forceinline__ int perm32(int rho) { const int n = rho >> 4, i = rho & 15; return 8 * (i >> 2) + 4 * n + (i & 3); }
struct Unit { int pm, pn, ex; };

template <class Epi, class Sched>
__device__ __forceinline__ void gemm_phase(LAS unsigned char* lds, const char* Abase, const unsigned lda2, const unsigned ldb2, const int K, const Sched& S, const Epi& E) {
    int tid_ = threadIdx.x; asm volatile("" : "+v"(tid_));
    const int tid = tid_, wid = __builtin_amdgcn_readfirstlane(tid >> 6), lane = tid & 63, wr = wid >> 2, wc = wid & 3, fr = lane & 15, fq = lane >> 4;
    const int nt = K / BK;
    int Rr[2]; unsigned Cc[2], voffB[2];
#pragma unroll
    for (int i = 0; i < 2; ++i) { int R, C; stage_rc(tid * 16 + i * 8192, R, C); const int Rb = Epi::PERM ? ((R & ~31) + perm32(R & 31)) : R;
        Rr[i] = R; Cc[i] = (unsigned)C * 2u; voffB[i] = (unsigned)Rb * ldb2 + (unsigned)C * 2u; }
    const size_t kstep = (size_t)(BK * 2);
    const size_t hstepB = (size_t)HALF * ldb2;
    const unsigned ldsw = (unsigned)wid * 1024u;
    const int aoff = lds_byte(wr * 64 + fr, fq * 8), boff = lds_byte(wc * 32 + fr, fq * 8);
#define PG8_SA(b, h) (((b) * 2 + (h)) * HTB)
#define PG8_SB(b, h) ((4 + (b) * 2 + (h)) * HTB)
#define PG8_STAGE_A(bufoff, kptr, V) do { _Pragma("unroll") for (int _i = 0; _i < 2; ++_i) \
        __builtin_amdgcn_global_load_lds((const unsigned*)((const char*)(kptr) + (V)[_i]), (LAS unsigned*)(lds + (bufoff) + ldsw + _i * 8192), 16, 0, 0); } while (0)
#define PG8_STAGE_B(bufoff, gbase) do { _Pragma("unroll") for (int _i = 0; _i < 2; ++_i) \
        __builtin_amdgcn_global_load_lds((const unsigned*)((const char*)(gbase) + voffB[_i]), (LAS unsigned*)(lds + (bufoff) + ldsw + _i * 8192), 16, 0, 0); } while (0)
#define PG8_LDA(dst, b, h) do { _Pragma("unroll") for (int m = 0; m < 4; ++m) _Pragma("unroll") for (int k = 0; k < 2; ++k) dst[m][k] = *(const LAS bf16x8*)(lds + PG8_SA(b, h) + aoff + m * 2048 + k * 1024); } while (0)
#define PG8_LDB(dst, b, h) do { _Pragma("unroll") for (int n = 0; n < 2; ++n) _Pragma("unroll") for (int k = 0; k < 2; ++k) dst[n][k] = *(const LAS bf16x8*)(lds + PG8_SB(b, h) + boff + n * 2048 + k * 1024); } while (0)
#define PG8_MMA(ai, bj, At, Bt) do { __builtin_amdgcn_s_setprio(1); _Pragma("unroll") for (int m = 0; m < 4; ++m) _Pragma("unroll") for (int n = 0; n < 2; ++n) _Pragma("unroll") for (int k = 0; k < 2; ++k) \
        acc[ai][bj][m][n] = __builtin_amdgcn_mfma_f32_16x16x32_bf16(Bt[n][k], At[m][k], acc[ai][bj][m][n], 0, 0, 0); __builtin_amdgcn_s_setprio(0); } while (0)
#define PG8_WAIT_V(n) asm volatile("s_waitcnt vmcnt(" #n ")" ::: "memory")
#define PG8_WAIT_L(n) asm volatile("s_waitcnt lgkmcnt(" #n ")" ::: "memory")
#define PG8_BAR __builtin_amdgcn_s_barrier()
#define PG8_SCHED __builtin_amdgcn_sched_barrier(0)
#define PG8_FILLA(dst, u) do { const unsigned ko_ = S.akoff(u); _Pragma("unroll") for (int h_ = 0; h_ < 2; ++h_) _Pragma("unroll") for (int i_ = 0; i_ < 2; ++i_) \
        dst[h_][i_] = (unsigned)S.arow(u, h_ * 128 + Rr[i_]) * lda2 + Cc[i_] + ko_; } while (0)
    Unit cur, nxt; int ui = 0;
    if (!S.next(0, cur)) return;
    f32x4 acc[2][2][4][2];
#pragma unroll
    for (int a = 0; a < 2; ++a)
#pragma unroll
        for (int b = 0; b < 2; ++b)
#pragma unroll
            for (int m = 0; m < 4; ++m)
#pragma unroll
                for (int n = 0; n < 2; ++n) acc[a][b][m][n] = (f32x4){0.f, 0.f, 0.f, 0.f};
    bf16x8 At[4][2], B0[2][2], B1[2][2];
    unsigned vA[2][2], nvA[2][2];
    PG8_FILLA(vA, cur);
    const char* cB = S.bptr(cur);
    constexpr bool HN = Epi::HALFN;
    if constexpr (HN) {
        PG8_STAGE_B(PG8_SB(0, 0), cB); PG8_STAGE_A(PG8_SA(0, 0), Abase, vA[0]); PG8_STAGE_A(PG8_SA(0, 1), Abase, vA[1]);
        if (wr == 1) PG8_BAR;
        PG8_WAIT_V(2); PG8_BAR;
        PG8_STAGE_B(PG8_SB(1, 0), cB + kstep); PG8_STAGE_A(PG8_SA(1, 0), Abase + kstep, vA[0]);
        PG8_WAIT_V(4); PG8_BAR;
    } else {
    PG8_STAGE_B(PG8_SB(0, 0), cB); PG8_STAGE_B(PG8_SB(0, 1), cB + hstepB); PG8_STAGE_A(PG8_SA(0, 0), Abase, vA[0]); PG8_STAGE_A(PG8_SA(0, 1), Abase, vA[1]);
    if (wr == 1) PG8_BAR;
    PG8_WAIT_V(2); PG8_BAR;
    PG8_STAGE_B(PG8_SB(1, 0), cB + kstep); PG8_STAGE_A(PG8_SA(1, 0), Abase + kstep, vA[0]); PG8_STAGE_B(PG8_SB(1, 1), cB + hstepB + kstep);
    PG8_WAIT_V(6); PG8_BAR;
    }
    for (;;) {
        if constexpr (Epi::LDSBIAS) {
            if (wid == 0) att::glds16(E.bias_src(cur, lane), (unsigned)__builtin_amdgcn_readfirstlane((unsigned)(uintptr_t)lds + 131072u + (unsigned)(ui & 1) * 1024u));
            E.bias_buf = (ui & 1) * 1024; }
        const bool has_next = S.next(ui + 1, nxt);
        const char* nB = cB;
        if (has_next) { PG8_FILLA(nvA, nxt); nB = S.bptr(nxt); }
        else {
#pragma unroll
            for (int h = 0; h < 2; ++h)
#pragma unroll
                for (int i = 0; i < 2; ++i) nvA[h][i] = vA[h][i];
        }
        for (int t = 0; t < nt; t += 2) {
            const bool last = (t == nt - 2);
            const char* a1k = Abase + (size_t)(t + 1) * kstep;
            const char* a2k = last ? Abase : Abase + (size_t)(t + 2) * kstep; const char* b2 = last ? nB : cB + (size_t)(t + 2) * kstep;
            const char* a3k = a2k + kstep; const char* b3 = b2 + kstep;
            unsigned s0[2], s1[2];
#pragma unroll
            for (int i = 0; i < 2; ++i) { s0[i] = last ? nvA[0][i] : vA[0][i]; s1[i] = last ? nvA[1][i] : vA[1][i]; }
            if constexpr (HN) {
            PG8_LDB(B0, 0, 0); PG8_SCHED; PG8_LDA(At, 0, 0); PG8_STAGE_A(PG8_SA(1, 1), a1k, vA[1]);
            PG8_WAIT_V(6); PG8_WAIT_L(0); PG8_BAR; PG8_MMA(0, 0, At, B0); PG8_BAR; PG8_SCHED;
            PG8_LDA(At, 0, 1); PG8_STAGE_B(PG8_SB(0, 0), b2); PG8_STAGE_A(PG8_SA(0, 0), a2k, s0);
            PG8_WAIT_V(6); PG8_WAIT_L(0); PG8_BAR; PG8_MMA(1, 0, At, B0); PG8_BAR; PG8_SCHED;
            PG8_LDB(B0, 1, 0); PG8_SCHED; PG8_LDA(At, 1, 0); PG8_STAGE_A(PG8_SA(0, 1), a2k, s1);
            PG8_WAIT_V(6); PG8_WAIT_L(0); PG8_BAR; PG8_MMA(0, 0, At, B0); PG8_BAR; PG8_SCHED;
            PG8_LDA(At, 1, 1); PG8_STAGE_B(PG8_SB(1, 0), b3); PG8_STAGE_A(PG8_SA(1, 0), a3k, s0);
            PG8_WAIT_V(6); PG8_WAIT_L(0); PG8_BAR; PG8_MMA(1, 0, At, B0); PG8_BAR; PG8_SCHED;
            } else {
            PG8_LDB(B0, 0, 0); PG8_LDB(B1, 0, 1); PG8_SCHED; PG8_LDA(At, 0, 0); PG8_STAGE_A(PG8_SA(1, 1), a1k, vA[1]);
            PG8_WAIT_V(8); PG8_WAIT_L(0); PG8_BAR; PG8_MMA(0, 0, At, B0); PG8_MMA(0, 1, At, B1); PG8_BAR; PG8_SCHED;
            PG8_LDA(At, 0, 1); PG8_STAGE_B(PG8_SB(0, 0), b2); PG8_STAGE_B(PG8_SB(0, 1), b2 + hstepB); PG8_STAGE_A(PG8_SA(0, 0), a2k, s0);
            PG8_WAIT_V(8); PG8_WAIT_L(0); PG8_BAR; PG8_MMA(1, 0, At, B0); PG8_MMA(1, 1, At, B1); PG8_BAR; PG8_SCHED;
            PG8_LDB(B0, 1, 0); PG8_LDB(B1, 1, 1); PG8_SCHED; PG8_LDA(At, 1, 0); PG8_STAGE_A(PG8_SA(0, 1), a2k, s1);
            PG8_WAIT_V(8); PG8_WAIT_L(0); PG8_BAR; PG8_MMA(0, 0, At, B0); PG8_MMA(0, 1, At, B1); PG8_BAR; PG8_SCHED;
            PG8_LDA(At, 1, 1); PG8_STAGE_B(PG8_SB(1, 0), b3); PG8_STAGE_B(PG8_SB(1, 1), b3 + hstepB); PG8_STAGE_A(PG8_SA(1, 0), a3k, s0);
            PG8_WAIT_V(8); PG8_WAIT_L(0); PG8_BAR; PG8_MMA(1, 0, At, B0); PG8_MMA(1, 1, At, B1); PG8_BAR; PG8_SCHED;
            }
        }
        if (wr == 0) PG8_BAR;
        E(acc, cur, wr, wc, fr, fq);
        if (!has_next) break;
#pragma unroll
        for (int a = 0; a < 2; ++a)
#pragma unroll
            for (int b = 0; b < 2; ++b)
#pragma unroll
                for (int m = 0; m < 4; ++m)
#pragma unroll
                    for (int n = 0; n < 2; ++n) acc[a][b][m][n] = (f32x4){0.f, 0.f, 0.f, 0.f};
        cur = nxt; cB = nB; ++ui;
#pragma unroll
        for (int h = 0; h < 2; ++h)
#pragma unroll
            for (int i = 0; i < 2; ++i) vA[h][i] = nvA[h][i];
        if (wr == 1) PG8_BAR;
    }
    PG8_WAIT_V(0);
    PG8_BAR;
#undef PG8_SA
#undef PG8_SB
#undef PG8_STAGE_A
#undef PG8_STAGE_B
#undef PG8_LDA
#undef PG8_LDB
#undef PG8_MMA
#undef PG8_WAIT_V
#undef PG8_WAIT_L
#undef PG8_BAR
#undef PG8_SCHED
#undef PG8_FILLA
}

struct DenseSched {
    int nM, nN, nwg, G, c; const char* Bt; unsigned ldb2; int kmul;
    __device__ __forceinline__ bool next(int i, Unit& u) const {
        const long L = (long)i * G + c; if (L >= nwg) return false;
        int wgid = (int)L; { const int q = nwg / 8, r = nwg % 8, xcd = wgid % 8, off = wgid / 8; wgid = (xcd < r ? xcd * (q + 1) : r * (q + 1) + (xcd - r) * q) + off; }
        const int nig = 8 * nN, gid = wgid / nig, fm = gid * 8, gsz = (nM - fm) < 8 ? (nM - fm) : 8;
        u.pm = fm + ((wgid % nig) % gsz); u.pn = (wgid % nig) / gsz; u.ex = 0; return true;
    }
    __device__ __forceinline__ int arow(const Unit& u, int r) const { return u.pm * 256 + r; }
    __device__ __forceinline__ unsigned akoff(const Unit& u) const { return (unsigned)((u.pn >> 2) * kmul); }
    __device__ __forceinline__ const char* bptr(const Unit& u) const { return Bt + (size_t)u.pn * 256 * ldb2; }
};
struct BranchSched {
    int nM, nwg, G, c; const char* Bt;
    __device__ __forceinline__ bool next(int i, Unit& u) const {
        const long L = (long)(i >> 2) * G + c; if (L >= nwg) return false;
        int wgid = (int)L; { const int q = nwg / 8, r = nwg % 8, xcd = wgid % 8, off = wgid / 8; wgid = (xcd < r ? xcd * (q + 1) : r * (q + 1) + (xcd - r) * q) + off; }
        const int nig = 8 * 4, gid = wgid / nig, fm = gid * 8, gsz = (nM - fm) < 8 ? (nM - fm) : 8;
        u.pm = fm + ((wgid % nig) % gsz); u.pn = (i & 3) * 4 + (wgid % nig) / gsz; u.ex = 0; return true;
    }
    __device__ __forceinline__ int arow(const Unit& u, int r) const { return u.pm * 256 + r; }
    __device__ __forceinline__ unsigned akoff(const Unit& u) const { return (unsigned)((u.pn >> 2) * 512); }
    __device__ __forceinline__ const char* bptr(const Unit& u) const { return Bt + (size_t)u.pn * 256 * 512; }
};
struct BranchSchedH {
    int nM, nwg, G, c; const char* Bt;
    __device__ __forceinline__ bool next(int i, Unit& u) const {
        const long L = (long)(i >> 2) * G + c; if (L >= nwg) return false;
        int wgid = (int)L; { const int q = nwg / 8, r = nwg % 8, xcd = wgid % 8, off = wgid / 8; wgid = (xcd < r ? xcd * (q + 1) : r * (q + 1) + (xcd - r) * q) + off; }
        const int nig = 8 * 8, gid = wgid / nig, fm = gid * 8, gsz = (nM - fm) < 8 ? (nM - fm) : 8;
        u.pm = fm + ((wgid % nig) % gsz); u.pn = (wgid % nig) / gsz; u.ex = i & 3; return true;
    }
    __device__ __forceinline__ int arow(const Unit& u, int r) const { return u.pm * 256 + r; }
    __device__ __forceinline__ unsigned akoff(const Unit& u) const { return (unsigned)(u.ex * 512); }
    __device__ __forceinline__ const char* bptr(const Unit& u) const { return Bt + (size_t)(u.ex * 1024 + u.pn * 128) * 512; }
};
struct EpiBranchH { static constexpr bool LDSBIAS = false;
    static constexpr bool PERM = true, HALFN = true;
    const bf16_t* Gt; bf16_t* SUMB; mutable f32x4 S[2][4][2];
    __device__ __forceinline__ void operator()(const f32x4 (&acc)[2][2][4][2], const Unit& u, int wr, int wc, int fr, int fq) const {
        const int row0 = u.pm * BM + wr * 64 + fr, scol0 = u.pn * 128 + wc * 32 + 8 * fq, gcol0 = u.ex * 1024 + scol0;
        const bool first = u.ex == 0, lastb = u.ex == 3; const int tid_ = (wr * 4 + wc) * 64 + fq * 16 + fr; (void)gcol0;
        u32x4 gv[2][4];
#pragma unroll
        for (int ai = 0; ai < 2; ++ai)
#pragma unroll
            for (int m = 0; m < 4; ++m) gv[ai][m] = __builtin_nontemporal_load((const u32x4*)(Gt + ((((size_t)u.pm * 32 + (u.ex * 8 + u.pn)) * 8 + (ai * 4 + m)) * 512 + tid_) * 8));
        __builtin_amdgcn_sched_barrier(0);
#pragma unroll
        for (int ai = 0; ai < 2; ++ai)
#pragma unroll
            for (int m = 0; m < 4; ++m) { const size_t row = (size_t)(row0 + ai * HALF + m * 16);
                const u32x4 g = gv[ai][m];
                const f32x4 v0 = acc[ai][0][m][0], v1 = acc[ai][0][m][1];
                f32x4 s0 = (f32x4){v0[0] * bflo(g.x), v0[1] * bfhi(g.x), v0[2] * bflo(g.y), v0[3] * bfhi(g.y)};
                f32x4 s1 = (f32x4){v1[0] * bflo(g.z), v1[1] * bfhi(g.z), v1[2] * bflo(g.w), v1[3] * bfhi(g.w)};
                if (!first) { s0 += S[ai][m][0]; s1 += S[ai][m][1]; }
                S[ai][m][0] = s0; S[ai][m][1] = s1;
                if (lastb) { u32x4 w; w.x = cvtpk(s0[0], s0[1]); w.y = cvtpk(s0[2], s0[3]); w.z = cvtpk(s1[0], s1[1]); w.w = cvtpk(s1[2], s1[3]);
                    *(u32x4*)(SUMB + row * DM + scol0) = w; } }
    }
};
struct MoeSched {
    int G, c, npn, gather; const LAS int* tb; const int* tokmap; const char* Bt; size_t bexp; unsigned ldb2; int zrow;
    __device__ __forceinline__ bool next(int i, Unit& u) const {
        const int ntl = tb[32];
        int tile, pn;
        if ((G & 7) == 0 && (G >> 3) % npn == 0) {
            const int x = c & 7, j = c >> 3, tpr = (G >> 3) / npn;
            tile = (i * tpr + j / npn) * 8 + x; pn = j % npn;
            if (tile >= ntl) return false;
        } else { const int idx = i * G + c; if (idx >= ntl * npn) return false; tile = idx / npn; pn = idx - tile * npn; }
        u.pm = tile; u.pn = pn;
        int e = 0;
#pragma unroll
        for (int s = 16; s >= 1; s >>= 1) e = (tb[e + s] <= tile) ? e + s : e;
        u.ex = e; return true;
    }
    __device__ __forceinline__ int arow(const Unit& u, int r) const {
        if (!gather) return u.pm * 256 + r;
        const int p = (u.pm - tb[u.ex]) * 256 + r;
        return (p < tb[64 + u.ex]) ? tokmap[(size_t)u.ex * ECAP + p] : zrow;
    }
    __device__ __forceinline__ unsigned akoff(const Unit&) const { return 0u; }
    __device__ __forceinline__ const char* bptr(const Unit& u) const { return Bt + (size_t)u.ex * bexp + (size_t)u.pn * 256 * ldb2; }
};

__device__ __forceinline__ float sigmoidf_(float v) { return __builtin_amdgcn_rcpf(1.0f + __builtin_amdgcn_exp2f(-v * LOG2E)); }

struct EpiIn { static constexpr bool LDSBIAS = false;
    static constexpr bool PERM = true, HALFN = false;
    bf16_t* QKV; bf16_t* Gt; const float* bgate; int dry;
    const float* kg; const f32x2* rope;
    __device__ __forceinline__ void operator()(const f32x4 (&acc)[2][2][4][2], const Unit& u, int wr, int wc, int fr, int fq) const {
        const int row0 = u.pm * BM + wr * 64 + fr;
        if (u.pn >= 4 && u.pn <= 6) {
            const bool is32 = (u.pn == 4 && wc >= 2) || (u.pn == 5 && wc < 2);
            const bool rot = (u.pm < TL / BM) && (u.pn != 6);
            const float* gp = kg + (u.pn == 6 ? 192 : (is32 ? 64 : (u.pn == 4 ? 0 : 128)));
            const int lane_ = fq * 16 + fr;
            f32x4 g[2][2];
#pragma unroll
            for (int bj = 0; bj < 2; ++bj)
#pragma unroll
                for (int n = 0; n < 2; ++n) g[bj][n] = *(const f32x4*)(gp + (is32 ? 16 * n + 4 * fq : 32 * bj + 8 * fq + 4 * n));
            bf16_t* cbase = QKV + u.pn * 256 + 64 * wc;
            f32x4 rc[2][4]; const int rcb = is32 ? 32 + 4 * fq : 8 * fq;
#define EPI_ROPE_LOAD(idx_, s_) do { if (rot) { const f32x2* rt_ = rope + (size_t)((row0 + ((idx_) >> 2) * HALF + ((idx_) & 3) * 16) & (SEQ - 1)) * 48 + rcb; \
                _Pragma("unroll") for (int k_ = 0; k_ < 4; ++k_) rc[s_][k_] = *(const f32x4*)(rt_ + 2 * k_); } } while (0)
            EPI_ROPE_LOAD(0, 0);
#pragma unroll
            for (int idx = 0; idx < 8; ++idx) { const int ai = idx >> 2, m = idx & 3, sb = idx & 1; const int row = row0 + ai * HALF + m * 16;
                    if (idx + 1 < 8) EPI_ROPE_LOAD(idx + 1, (idx + 1) & 1);
                    f32x4 x[2][2]; float s[2];
#pragma unroll
                    for (int bj = 0; bj < 2; ++bj) { x[bj][0] = acc[ai][bj][m][0]; x[bj][1] = acc[ai][bj][m][1]; float t = 0.f;
#pragma unroll
                        for (int e = 0; e < 4; ++e) t += x[bj][0][e] * x[bj][0][e] + x[bj][1][e] * x[bj][1][e];
                        t += shx(t, 16, lane_); t += shx(t, 32, lane_); s[bj] = t; }
                    float rs[2];
                    if (is32) { rs[0] = __builtin_amdgcn_rsqf(s[0] * (1.0f / 32.0f) + EPSN); rs[1] = __builtin_amdgcn_rsqf(s[1] * (1.0f / 32.0f) + EPSN); }
                    else { rs[0] = rs[1] = __builtin_amdgcn_rsqf((s[0] + s[1]) * (1.0f / 64.0f) + EPSN); }
#pragma unroll
                    for (int bj = 0; bj < 2; ++bj)
#pragma unroll
                        for (int n = 0; n < 2; ++n) x[bj][n] = x[bj][n] * rs[bj] * g[bj][n];
                    if (rot) {
                        if (is32) { const f32x4 c01 = rc[sb][0], c23 = rc[sb][1];
                            const float cs[4] = {c01[0], c01[2], c23[0], c23[2]}, sn[4] = {c01[1], c01[3], c23[1], c23[3]};
#pragma unroll
                            for (int bj = 0; bj < 2; ++bj)
#pragma unroll
                                for (int e = 0; e < 4; ++e) { const float a = x[bj][0][e], b = x[bj][1][e]; x[bj][0][e] = a * cs[e] - b * sn[e]; x[bj][1][e] = a * sn[e] + b * cs[e]; } }
                        else {
#pragma unroll
                            for (int n = 0; n < 2; ++n) { const f32x4 c01 = rc[sb][2 * n], c23 = rc[sb][2 * n + 1];
                                const float cs[4] = {c01[0], c01[2], c23[0], c23[2]}, sn[4] = {c01[1], c01[3], c23[1], c23[3]};
#pragma unroll
                                for (int e = 0; e < 4; ++e) { const float a = x[0][n][e], b = x[1][n][e]; x[0][n][e] = a * cs[e] - b * sn[e]; x[1][n][e] = a * sn[e] + b * cs[e]; } } } }
                    bf16_t* rp = cbase + (size_t)row * NQKV;
#pragma unroll
                    for (int bj = 0; bj < 2; ++bj) {
                        if (is32) {
#pragma unroll
                            for (int n = 0; n < 2; ++n) { u32x2 w; w.x = cvtpk(x[bj][n][0], x[bj][n][1]); w.y = cvtpk(x[bj][n][2], x[bj][n][3]); *(u32x2*)(rp + 32 * bj + 16 * n + 4 * fq) = w; } }
                        else { u32x4 w; w.x = cvtpk(x[bj][0][0], x[bj][0][1]); w.y = cvtpk(x[bj][0][2], x[bj][0][3]); w.z = cvtpk(x[bj][1][0], x[bj][1][1]); w.w = cvtpk(x[bj][1][2], x[bj][1][3]);
                            *(u32x4*)(rp + 32 * bj + 8 * fq) = w; } } }
#undef EPI_ROPE_LOAD
            return;
        }
        const bool isg = u.pn >= 10;
        const int colt = isg ? (u.pn - 10) * 256 : u.pn * 256, ldc = isg ? NGATE : NQKV;
        bf16_t* base = isg ? Gt : QKV;
        const int col0 = colt + wc * 32 + 8 * fq;
        f32x4 bv[2][2];
#pragma unroll
        for (int bj = 0; bj < 2; ++bj)
#pragma unroll
            for (int n = 0; n < 2; ++n) bv[bj][n] = isg ? *(const f32x4*)(bgate + col0 + bj * HALF + 4 * n) : (f32x4){0.f, 0.f, 0.f, 0.f};
#pragma unroll
        for (int ai = 0; ai < 2; ++ai)
#pragma unroll
            for (int m = 0; m < 4; ++m) { bf16_t* rowp = base + (size_t)(row0 + ai * HALF + m * 16) * ldc + col0;
#pragma unroll
                for (int bj = 0; bj < 2; ++bj) { f32x4 v0 = acc[ai][bj][m][0] + bv[bj][0], v1 = acc[ai][bj][m][1] + bv[bj][1];
                    if (isg && !(PROBE_SEC >= 110 && (dry & 2))) {
#pragma unroll
                        for (int q = 0; q < 4; ++q) { v0[q] = __builtin_amdgcn_exp2f(-v0[q] * LOG2E); v1[q] = __builtin_amdgcn_exp2f(-v1[q] * LOG2E); }
                        __builtin_amdgcn_sched_barrier(0);
#pragma unroll
                        for (int q = 0; q < 4; ++q) { v0[q] = __builtin_amdgcn_rcpf(1.0f + v0[q]); v1[q] = __builtin_amdgcn_rcpf(1.0f + v1[q]); }
                        __builtin_amdgcn_sched_barrier(0); }
                    u32x4 w; w.x = cvtpk(v0[0], v0[1]); w.y = cvtpk(v0[2], v0[3]); w.z = cvtpk(v1[0], v1[1]); w.w = cvtpk(v1[2], v1[3]);
                    if (PROBE_SEC >= 110 && (dry & 1)) { asm volatile("" :: "v"(w)); } else
                    if (isg) { const int tid_ = (wr * 4 + wc) * 64 + fq * 16 + fr, ch = (u.pn - 10) * 2 + bj;
                        __builtin_nontemporal_store(w, (u32x4*)(Gt + ((((size_t)u.pm * 32 + ch) * 8 + (ai * 4 + m)) * 512 + tid_) * 8)); }
                    else *(u32x4*)(rowp + bj * HALF) = w; } }
    }
};
struct EpiBranch { static constexpr bool LDSBIAS = false;
    static constexpr bool PERM = true, HALFN = false;
    const bf16_t* Gt; bf16_t* SUMB;
    __device__ __forceinline__ void operator()(const f32x4 (&acc)[2][2][4][2], const Unit& u, int wr, int wc, int fr, int fq) const {
        const int row0 = u.pm * BM + wr * 64 + fr, col0 = u.pn * 256 + wc * 32 + 8 * fq, scol0 = (u.pn & 3) * 256 + wc * 32 + 8 * fq;
        const bool first = (u.pn >> 2) == 0;
#pragma unroll
        for (int ai = 0; ai < 2; ++ai)
#pragma unroll
            for (int m = 0; m < 4; ++m) { const bf16_t* rowp = Gt + (size_t)(row0 + ai * HALF + m * 16) * NGATE + col0; bf16_t* outp = SUMB + (size_t)(row0 + ai * HALF + m * 16) * DM + scol0;
#pragma unroll
                for (int bj = 0; bj < 2; ++bj) { const u32x4 g = *(const u32x4*)(rowp + bj * HALF);
                    u32x4 so = (u32x4){0u, 0u, 0u, 0u}; if (!first) so = *(const u32x4*)(outp + bj * HALF);
                    const f32x4 v0 = acc[ai][bj][m][0], v1 = acc[ai][bj][m][1];
                    u32x4 w; w.x = cvtpk(v0[0] * bflo(g.x) + bflo(so.x), v0[1] * bfhi(g.x) + bfhi(so.x)); w.y = cvtpk(v0[2] * bflo(g.y) + bflo(so.y), v0[3] * bfhi(g.y) + bfhi(so.y));
                    w.z = cvtpk(v1[0] * bflo(g.z) + bflo(so.z), v1[1] * bfhi(g.z) + bfhi(so.z)); w.w = cvtpk(v1[2] * bflo(g.w) + bflo(so.w), v1[3] * bfhi(g.w) + bfhi(so.w));
                    *(u32x4*)(outp + bj * HALF) = w; } }
    }
};
struct EpiOut { static constexpr bool LDSBIAS = false;
    static constexpr bool PERM = true, HALFN = false;
    const float* x0; const float* c0; bf16_t* XRB; const float* mod; int layer;
    __device__ __forceinline__ void operator()(const f32x4 (&acc)[2][2][4][2], const Unit& u, int wr, int wc, int fr, int fq) const {
        const int rt = u.pm * BM;
        const int ridx = rt < TL ? (rt >> 13) : 4;
        const float* srcf = rt < TL ? x0 + (size_t)rt * DM : c0 + (size_t)(rt - TL) * DM;
        bf16_t* dst = XRB + (size_t)rt * DM;
        const float* g1 = mod + ridx * 6144 + 2 * 1024;
        const int col0 = u.pn * BM + wc * 32 + 8 * fq;
        unsigned eo_ = (unsigned)((wr * 64 + fr) * DM + col0); asm volatile("" : "+v"(eo_));
        f32x4 ga[2], gb[2], xa[2][2], xb[2][2]; u32x4 xx[2][2];
#define EPO_LOAD(ab, s) do { const int ai_ = (ab) >> 2, m0_ = (((ab) >> 1) & 1) * 2, cc_ = ((ab) & 1) * HALF; \
            ga[s] = *(const f32x4*)(g1 + col0 + cc_); gb[s] = *(const f32x4*)(g1 + col0 + cc_ + 4); \
            _Pragma("unroll") for (int mm = 0; mm < 2; ++mm) { const unsigned o_ = eo_ + (unsigned)((ai_ * HALF + (m0_ + mm) * 16) * DM + cc_); \
                if (layer) xx[s][mm] = *(const u32x4*)(dst + o_); else { xa[s][mm] = *(const f32x4*)(srcf + o_); xb[s][mm] = *(const f32x4*)(srcf + o_ + 4); } } } while (0)
        EPO_LOAD(0, 0);
#pragma unroll
        for (int ab = 0; ab < 8; ++ab) { const int ai = ab >> 2, m0 = ((ab >> 1) & 1) * 2, bj = ab & 1, cc = bj * HALF, s = ab & 1;
            if (ab + 1 < 8) EPO_LOAD(ab + 1, (ab + 1) & 1);
            __builtin_amdgcn_sched_barrier(0);
#pragma unroll
            for (int mm = 0; mm < 2; ++mm) { const int m = m0 + mm; const unsigned off = eo_ + (unsigned)((ai * HALF + m * 16) * DM);
                f32x4 va, vb;
                if (layer) { const u32x4 t = xx[s][mm]; va = (f32x4){bflo(t.x), bfhi(t.x), bflo(t.y), bfhi(t.y)}; vb = (f32x4){bflo(t.z), bfhi(t.z), bflo(t.w), bfhi(t.w)}; }
                else { va = xa[s][mm]; vb = xb[s][mm]; }
                const f32x4 ra = va + ga[s] * acc[ai][bj][m][0], rb = vb + gb[s] * acc[ai][bj][m][1];
                u32x4 w; w.x = cvtpk(ra[0], ra[1]); w.y = cvtpk(ra[2], ra[3]); w.z = cvtpk(rb[0], rb[1]); w.w = cvtpk(rb[2], rb[3]);
                *(u32x4*)(dst + off + cc) = w; }
            __builtin_amdgcn_sched_barrier(0); }
#undef EPO_LOAD
    }
};
struct EpiSwiglu {
    static constexpr bool PERM = true, HALFN = false, LDSBIAS = true;
    bf16_t* ACT; const float* bgu; LAS unsigned char* ldsb; mutable int bias_buf;
    __device__ __forceinline__ const float* bias_src(const Unit& u, int lane) const { return bgu + (size_t)u.ex * 2048 + (lane >> 5) * 1024 + u.pn * 128 + (lane & 31) * 4; }
    __device__ __forceinline__ void operator()(const f32x4 (&acc)[2][2][4][2], const Unit& u, int wr, int wc, int fr, int fq) const {
        const int row0 = u.pm * BM + wr * 64 + fr, j0 = u.pn * 128 + wc * 32 + 8 * fq;
        const LAS float* bl = (const LAS float*)(ldsb + 131072 + bias_buf) + wc * 32 + 8 * fq;
        f32x4 bgv[2], buv[2];
#pragma unroll
        for (int n = 0; n < 2; ++n) { bgv[n] = *(const LAS f32x4*)(bl + 4 * n); buv[n] = *(const LAS f32x4*)(bl + 128 + 4 * n); }
#pragma unroll
        for (int ai = 0; ai < 2; ++ai)
#pragma unroll
            for (int m = 0; m < 4; ++m) { bf16_t* rowp = ACT + (size_t)(row0 + ai * HALF + m * 16) * DM + j0;
                float o[8], gq[8], ex[8];
#pragma unroll
                for (int n = 0; n < 2; ++n)
#pragma unroll
                    for (int q = 0; q < 4; ++q) { float g = acc[ai][0][m][n][q] + bgv[n][q]; g = fminf(g, 7.0f); gq[n * 4 + q] = g; ex[n * 4 + q] = __builtin_amdgcn_exp2f(g * (-1.702f * LOG2E)); }
                __builtin_amdgcn_sched_barrier(0);
#pragma unroll
                for (int i = 0; i < 8; ++i) ex[i] = __builtin_amdgcn_rcpf(1.0f + ex[i]);
                __builtin_amdgcn_sched_barrier(0);
#pragma unroll
                for (int n = 0; n < 2; ++n)
#pragma unroll
                    for (int q = 0; q < 4; ++q) { float up = acc[ai][1][m][n][q] + buv[n][q]; up = fminf(fmaxf(up, -7.0f), 7.0f);
                        o[n * 4 + q] = gq[n * 4 + q] * ex[n * 4 + q] * (up + 1.0f); }
                u32x4 w; w.x = cvtpk(o[0], o[1]); w.y = cvtpk(o[2], o[3]); w.z = cvtpk(o[4], o[5]); w.w = cvtpk(o[6], o[7]);
                *(u32x4*)rowp = w; }
    }
};
struct EpiDown {
    static constexpr bool PERM = true, HALFN = false, LDSBIAS = true;
    bf16_t* Y; const float* bd; LAS unsigned char* ldsb; mutable int bias_buf;
    __device__ __forceinline__ const float* bias_src(const Unit& u, int lane) const { return bd + (size_t)u.ex * 1024 + u.pn * 256 + lane * 4; }
    __device__ __forceinline__ void operator()(const f32x4 (&acc)[2][2][4][2], const Unit& u, int wr, int wc, int fr, int fq) const {
        const int row0 = u.pm * BM + wr * 64 + fr, col0 = u.pn * 256 + wc * 32 + 8 * fq;
        const LAS float* bl = (const LAS float*)(ldsb + 131072 + bias_buf) + wc * 32 + 8 * fq;
        f32x4 bv[2][2];
#pragma unroll
        for (int bj = 0; bj < 2; ++bj)
#pragma unroll
            for (int n = 0; n < 2; ++n) bv[bj][n] = *(const LAS f32x4*)(bl + bj * HALF + 4 * n);
#pragma unroll
        for (int ai = 0; ai < 2; ++ai)
#pragma unroll
            for (int m = 0; m < 4; ++m) { bf16_t* rowp = Y + (size_t)(row0 + ai * HALF + m * 16) * DM + col0;
#pragma unroll
                for (int bj = 0; bj < 2; ++bj) { const f32x4 v0 = acc[ai][bj][m][0] + bv[bj][0], v1 = acc[ai][bj][m][1] + bv[bj][1];
                    u32x4 w; w.x = cvtpk(v0[0], v0[1]); w.y = cvtpk(v0[2], v0[3]); w.z = cvtpk(v1[0], v1[1]); w.w = cvtpk(v1[2], v1[3]);
                    *(u32x4*)(rowp + bj * HALF) = w; } }
    }
};
}

namespace att {
constexpr int SLOTB = 8192, LDS_K = 0, LDS_V = 3 * SLOTB, LDS_BIAS = 7 * SLOTB, LDS_Q = 7 * SLOTB + 2048;
__device__ __forceinline__ int crow(int r, int hi) { return (r & 3) + 8 * (r >> 2) + 4 * hi; }
__device__ __forceinline__ void glds16(const void* gsrc, unsigned lds_dst) { unsigned keep;
    asm volatile("s_mov_b32 %0, m0\n\ts_mov_b32 m0, %2\n\ts_nop 0\n\tglobal_load_lds_dwordx4 %1, off\n\ts_mov_b32 m0, %0" : "=&s"(keep) : "v"(gsrc), "s"(lds_dst) : "memory"); }
typedef LAS const char* lds_cptr;
typedef short v4i16_t __attribute__((ext_vector_type(4)));
__device__ __forceinline__ s16x4 vtr(lds_cptr p) { return __builtin_bit_cast(s16x4, __builtin_amdgcn_ds_read_tr16_b64_v4i16((LAS v4i16_t*)p)); }
#define ATT_WAIT_BAR(N) do { __builtin_amdgcn_sched_barrier(0); asm volatile("s_waitcnt vmcnt(" #N ") lgkmcnt(0)\n\ts_barrier" ::: "memory"); __builtin_amdgcn_sched_barrier(0); } while (0)
#define ATT_BAR() do { __builtin_amdgcn_sched_barrier(0); asm volatile("s_waitcnt lgkmcnt(0)\n\ts_barrier" ::: "memory"); __builtin_amdgcn_sched_barrier(0); } while (0)
#define ATT_MFMA(a, b, c) __builtin_amdgcn_mfma_f32_32x32x16_bf16(a, b, c, 0, 0, 0)
#ifndef ATT_PRIO_MMA
#define ATT_PRIO_MMA 0
#endif
#ifndef ATT_PRIO_S
#define ATT_PRIO_S 0
#endif
#define ATT_SP_M() do { if (ATT_PRIO_MMA) __builtin_amdgcn_s_setprio(ATT_PRIO_MMA); } while (0)
#define ATT_SP_M0() do { if (ATT_PRIO_MMA) __builtin_amdgcn_s_setprio(0); } while (0)
#define ATT_SP_S() do { if (ATT_PRIO_S) __builtin_amdgcn_s_setprio(ATT_PRIO_S); } while (0)
#define ATT_SP_S0() do { if (ATT_PRIO_S) __builtin_amdgcn_s_setprio(0); } while (0)
#define SGB_DS(n) __builtin_amdgcn_sched_group_barrier(0x100, n, 0)
#define SGB_MF(n) __builtin_amdgcn_sched_group_barrier(0x008, n, 0)

struct UnitP {
    int qrow0;
    int qcol, kcol, vcol, ocol;
    int locrow0, nloc;
    int ctxrow0;
    int qpos0;
    int kpos0;
    float linit;
    float lam, outscale;
    const float* subln;
    const float* qgain;
    const f32x2* rope;
};

template <int MODE>
__device__ __forceinline__ void attn_unit(LAS unsigned char* shm, const bf16_t* __restrict__ QKV, bf16_t* BR, const UnitP& P) {
    int tid_ = threadIdx.x; asm volatile("" : "+v"(tid_));
    const int tid = tid_, lane = tid & 63, r32 = lane & 31, hi = lane >> 5; const int wid = __builtin_amdgcn_readfirstlane(tid >> 6);
    const int grp = wid >> 2;
    const unsigned lds0 = (unsigned)(uintptr_t)shm;
    const char* kbase = (const char*)QKV + (size_t)P.kcol * 2 + wid * 16 + (size_t)lane * (NQKV * 2);
    const char* vbase = (const char*)QKV + (size_t)P.vcol * 2 + ((wid >> 2) * 32 + (lane & 3) * 8) * 2 + (size_t)(16 * (wid & 3) + (lane >> 2)) * (NQKV * 2);
    const unsigned kdst = lds0 + LDS_K + wid * 1024, vdst = lds0 + LDS_V + wid * 1024;
    const int nloc = P.nloc, NT = nloc + 4;
#define ATT_TROW(t) ((t) < nloc ? P.locrow0 + 64 * (t) : P.ctxrow0 + 64 * ((t) - nloc))
#define ATT_DMA(t, ks, vs) do { const size_t ro_ = (size_t)ATT_TROW(t) * (NQKV * 2); \
        glds16(kbase + ro_, (unsigned)__builtin_amdgcn_readfirstlane(kdst + (ks) * SLOTB)); glds16(vbase + ro_, (unsigned)__builtin_amdgcn_readfirstlane(vdst + (vs) * SLOTB)); } while (0)
    ATT_DMA(0, 0, 0); ATT_DMA(1, 1, 1);
    bf16x8 qr[4];
    LAS bf16x8* qlds = (LAS bf16x8*)(shm + LDS_Q + wid * 4096) + lane;
    {
      const bf16_t* Qw = QKV + (size_t)(P.qrow0 + r32) * NQKV + P.qcol + hi * 8;
      u32x4 raw[4];
#pragma unroll
      for (int d0 = 0; d0 < 4; ++d0) raw[d0] = *reinterpret_cast<const u32x4*>(Qw + d0 * 16);
      float x[4][8];
#pragma unroll
      for (int d0 = 0; d0 < 4; ++d0) { x[d0][0] = bflo(raw[d0].x); x[d0][1] = bfhi(raw[d0].x); x[d0][2] = bflo(raw[d0].y); x[d0][3] = bfhi(raw[d0].y);
          x[d0][4] = bflo(raw[d0].z); x[d0][5] = bfhi(raw[d0].z); x[d0][6] = bflo(raw[d0].w); x[d0][7] = bfhi(raw[d0].w); }
      const f32x2* rt = P.rope ? P.rope + (size_t)(P.qpos0 + r32) * 48 : nullptr;
      if (MODE == 1) {
#pragma unroll
          for (int c = 0; c < 2; ++c) { float ss = 0.f;
#pragma unroll
              for (int dd = 0; dd < 2; ++dd)
#pragma unroll
                  for (int e = 0; e < 8; ++e) ss += x[2 * c + dd][e] * x[2 * c + dd][e];
              ss += shx(ss, 32, lane);
              const float rs = __builtin_amdgcn_rsqf(ss * (1.0f / 32.0f) + EPSN);
#pragma unroll
              for (int dd = 0; dd < 2; ++dd)
#pragma unroll
                  for (int e = 0; e < 8; ++e) x[2 * c + dd][e] *= rs * P.qgain[16 * dd + 8 * hi + e];
              if (rt) {
#pragma unroll
                  for (int e = 0; e < 8; ++e) { const f32x2 cs = rt[32 + 8 * hi + e]; const float a = x[2 * c][e], b = x[2 * c + 1][e];
                      x[2 * c][e] = a * cs.x - b * cs.y; x[2 * c + 1][e] = a * cs.y + b * cs.x; } } }
      } else {
          float ss = 0.f;
#pragma unroll
          for (int d0 = 0; d0 < 4; ++d0)
#pragma unroll
              for (int e = 0; e < 8; ++e) ss += x[d0][e] * x[d0][e];
          ss += shx(ss, 32, lane);
          const float rs = __builtin_amdgcn_rsqf(ss * (1.0f / 64.0f) + EPSN);
#pragma unroll
          for (int d0 = 0; d0 < 4; ++d0)
#pragma unroll
              for (int e = 0; e < 8; ++e) x[d0][e] *= rs * P.qgain[16 * d0 + 8 * hi + e];
          if (rt) {
#pragma unroll
              for (int d0 = 0; d0 < 2; ++d0)
#pragma unroll
                  for (int e = 0; e < 8; ++e) { const f32x2 cs = rt[16 * d0 + 8 * hi + e]; const float a = x[d0][e], b = x[d0 + 2][e];
                      x[d0][e] = a * cs.x - b * cs.y; x[d0 + 2][e] = a * cs.y + b * cs.x; } }
      }
      const float qs = (MODE == 1 ? 0.17677669529663687f : 0.125f) * LOG2E;
#pragma unroll
      for (int d0 = 0; d0 < 4; ++d0) { u32x4 w; w.x = cvtpk(x[d0][0] * qs, x[d0][1] * qs); w.y = cvtpk(x[d0][2] * qs, x[d0][3] * qs); w.z = cvtpk(x[d0][4] * qs, x[d0][5] * qs); w.w = cvtpk(x[d0][6] * qs, x[d0][7] * qs);
          qr[d0] = __builtin_bit_cast(bf16x8, w); if (MODE == 1) qlds[d0 * 64] = qr[d0]; } }
    f32x16 o[2], o2[2]; o[0] = f32x16{}; o[1] = f32x16{}; o2[0] = f32x16{}; o2[1] = f32x16{};
    float l1 = (hi == 0) ? P.linit : 0.f, l2 = 0.f;
    f32x16 pa0 = f32x16{}, pa1 = f32x16{}, pb0 = f32x16{}, pb1 = f32x16{};
    u32x4 pw[4], pv2[4];
#pragma unroll
    for (int i = 0; i < 4; ++i) { pw[i] = (u32x4){0u, 0u, 0u, 0u}; pv2[i] = (u32x4){0u, 0u, 0u, 0u}; }
    const int qpos = P.qpos0 + r32;
    const int qrow_w = P.qpos0 >> 6, r0w = min(max(qrow_w - 4, 0), 120);
    const int qc = qpos & 63, c0q = min(max(qc - 8, 0), 48);
    unsigned okb0 = 0u, okb1 = 0u;
    if (MODE == 3) {
#pragma unroll
        for (int r = 0; r < 16; ++r) { const int kc = crow(r, hi); okb0 |= ((unsigned)(kc - c0q) < 16u ? 1u : 0u) << r; okb1 |= ((unsigned)(kc + 32 - c0q) < 16u ? 1u : 0u) << r; }
        asm volatile("" : "+v"(okb0), "+v"(okb1)); }
    const LAS float* biasT = (const LAS float*)(shm + LDS_BIAS);
    const lds_cptr kp0 = (lds_cptr)shm + LDS_K + hi * 1024 + r32 * 16;
    const lds_cptr vp0 = (lds_cptr)shm + LDS_V + ((lane >> 4) & 1) * 32 + (lane & 3) * 8 + (4 * hi + ((lane & 15) >> 2)) * 64;
#define ATT_ACTIVE(t) ( (MODE == 2 && (t) < nloc) ? ((P.kpos0 + 64 * (t) <= P.qpos0 + 31 + 128) && (P.kpos0 + 64 * (t) + 63 >= P.qpos0 - 128)) : \
                        (MODE == 3 && (t) < nloc) ? ((((P.kpos0 >> 6) + (t)) >= r0w) && (((P.kpos0 >> 6) + (t)) < r0w + 8)) : true )
#define ATT_SOFT(P0, P1, LS, PW, t) do { \
        if (MODE == 2 && (t) < nloc) { const int kb_ = P.kpos0 + 64 * (t) - qpos; \
            _Pragma("unroll") for (int r = 0; r < 16; ++r) { const int d = kb_ + crow(r, hi); \
                if (d > 128 || d < -128) P0[r] = -INFINITY; \
                if (d + 32 > 128 || d + 32 < -128) P1[r] = -INFINITY; } } \
        if (MODE == 3 && (t) < nloc) { const int kr_ = (P.kpos0 >> 6) + (t); const LAS float* bp_ = biasT + ((kr_ - qrow_w + 7) * 31 + 15 - qc + 4 * hi); \
              \
            float b0_[16], b1_[16]; \
            _Pragma("unroll") for (int r = 0; r < 16; ++r) { b0_[r] = bp_[(r & 3) + 8 * (r >> 2)]; b1_[r] = bp_[(r & 3) + 8 * (r >> 2) + 32]; } \
            _Pragma("unroll") for (int r = 0; r < 16; ++r) { \
                const unsigned m0 = (unsigned)(((int)(okb0 << (31 - r))) >> 31), m1 = (unsigned)(((int)(okb1 << (31 - r))) >> 31); \
                P0[r] = __builtin_bit_cast(float, (m0 & __builtin_bit_cast(unsigned, P0[r] + b0_[r])) | (~m0 & 0xff800000u)); \
                P1[r] = __builtin_bit_cast(float, (m1 & __builtin_bit_cast(unsigned, P1[r] + b1_[r])) | (~m1 & 0xff800000u)); } } \
        float s_ = 0.f; \
        _Pragma("unroll") for (int r = 0; r < 16; ++r) { P0[r] = __builtin_amdgcn_exp2f(P0[r]); P1[r] = __builtin_amdgcn_exp2f(P1[r]); s_ += P0[r] + P1[r]; } \
        LS += s_; \
        PW[0] = (u32x4){cvtpk(P0[0], P0[1]), cvtpk(P0[2], P0[3]), cvtpk(P0[4], P0[5]), cvtpk(P0[6], P0[7])}; \
        PW[1] = (u32x4){cvtpk(P0[8], P0[9]), cvtpk(P0[10], P0[11]), cvtpk(P0[12], P0[13]), cvtpk(P0[14], P0[15])}; \
        PW[2] = (u32x4){cvtpk(P1[0], P1[1]), cvtpk(P1[2], P1[3]), cvtpk(P1[4], P1[5]), cvtpk(P1[6], P1[7])}; \
        PW[3] = (u32x4){cvtpk(P1[8], P1[9]), cvtpk(P1[10], P1[11]), cvtpk(P1[12], P1[13]), cvtpk(P1[14], P1[15])}; } while (0)
#define ATT_S(t) do { if (ATT_ACTIVE(t)) { ATT_SOFT(pa0, pa1, l1, pw, t); if (MODE == 1) ATT_SOFT(pb0, pb1, l2, pv2, t); } } while (0)
#define ATT_PV(tp, vsp) do { if (MODE < 2 || ATT_ACTIVE(tp)) { const lds_cptr vp = vp0 + (vsp) * SLOTB; \
            _Pragma("unroll") for (int dh = 0; dh < 2; ++dh) { _Pragma("unroll") for (int ks = 0; ks < 4; ++ks) { \
                const s16x4 vl = vtr(vp + dh * 4096 + ks * 1024), vh = vtr(vp + dh * 4096 + ks * 1024 + 512); \
                const bf16x8 vf = (bf16x8){vl[0], vl[1], vl[2], vl[3], vh[0], vh[1], vh[2], vh[3]}; \
                o[dh] = ATT_MFMA(vf, __builtin_bit_cast(bf16x8, pw[ks]), o[dh]); \
                if (MODE == 1) o2[dh] = ATT_MFMA(vf, __builtin_bit_cast(bf16x8, pv2[ks]), o2[dh]); } \
                } } \
        } while (0)
#define ATT_QK(t, ksc) do { if (MODE < 2 || ATT_ACTIVE(t)) { const lds_cptr kp = kp0 + (ksc) * SLOTB; \
            if (MODE == 1) { \
                _Pragma("unroll") for (int d0 = 0; d0 < 2; ++d0) { const bf16x8 k0 = *(const LAS bf16x8*)(kp + d0 * 2048), k1 = *(const LAS bf16x8*)(kp + d0 * 2048 + 512); const bf16x8 qf = qlds[d0 * 64]; \
                    pa0 = ATT_MFMA(k0, qf, d0 == 0 ? f32x16{} : pa0); pa1 = ATT_MFMA(k1, qf, d0 == 0 ? f32x16{} : pa1); } \
                _Pragma("unroll") for (int d0 = 2; d0 < 4; ++d0) { const bf16x8 k0 = *(const LAS bf16x8*)(kp + d0 * 2048), k1 = *(const LAS bf16x8*)(kp + d0 * 2048 + 512); const bf16x8 qf = qlds[d0 * 64]; \
                    pb0 = ATT_MFMA(k0, qf, d0 == 2 ? f32x16{} : pb0); pb1 = ATT_MFMA(k1, qf, d0 == 2 ? f32x16{} : pb1); } \
            } else { \
                _Pragma("unroll") for (int d0 = 0; d0 < 4; ++d0) { const bf16x8 k0 = *(const LAS bf16x8*)(kp + d0 * 2048), k1 = *(const LAS bf16x8*)(kp + d0 * 2048 + 512); \
                    pa0 = ATT_MFMA(k0, qr[d0], d0 == 0 ? f32x16{} : pa0); pa1 = ATT_MFMA(k1, qr[d0], d0 == 0 ? f32x16{} : pa1); } } } } while (0)
#define ATT_MMA1(vsp, ksc) do { const lds_cptr vp = vp0 + (vsp) * SLOTB; const lds_cptr kp = kp0 + (ksc) * SLOTB; \
        bf16x8 vf_[8], kf_[4][2], qf_[4]; \
        _Pragma("unroll") for (int i = 0; i < 8; ++i) { const s16x4 vl = vtr(vp + (i >> 2) * 4096 + (i & 3) * 1024), vh = vtr(vp + (i >> 2) * 4096 + (i & 3) * 1024 + 512); \
            vf_[i] = (bf16x8){vl[0], vl[1], vl[2], vl[3], vh[0], vh[1], vh[2], vh[3]}; } \
        _Pragma("unroll") for (int d0 = 0; d0 < 4; ++d0) { kf_[d0][0] = *(const LAS bf16x8*)(kp + d0 * 2048); kf_[d0][1] = *(const LAS bf16x8*)(kp + d0 * 2048 + 512); qf_[d0] = qlds[d0 * 64]; } \
        _Pragma("unroll") for (int i = 0; i < 8; ++i) { o[i >> 2] = ATT_MFMA(vf_[i], __builtin_bit_cast(bf16x8, pw[i & 3]), o[i >> 2]); o2[i >> 2] = ATT_MFMA(vf_[i], __builtin_bit_cast(bf16x8, pv2[i & 3]), o2[i >> 2]); } \
        pa0 = ATT_MFMA(kf_[0][0], qf_[0], f32x16{}); pa1 = ATT_MFMA(kf_[0][1], qf_[0], f32x16{}); pa0 = ATT_MFMA(kf_[1][0], qf_[1], pa0); pa1 = ATT_MFMA(kf_[1][1], qf_[1], pa1); \
        pb0 = ATT_MFMA(kf_[2][0], qf_[2], f32x16{}); pb1 = ATT_MFMA(kf_[2][1], qf_[2], f32x16{}); pb0 = ATT_MFMA(kf_[3][0], qf_[3], pb0); pb1 = ATT_MFMA(kf_[3][1], qf_[3], pb1); \
        SGB_DS(6); \
        SGB_MF(2); SGB_DS(2); SGB_MF(2); SGB_DS(2); SGB_MF(2); SGB_DS(2); SGB_MF(2); SGB_DS(2); SGB_MF(2); SGB_DS(2); \
        SGB_MF(2); SGB_DS(3); SGB_MF(2); SGB_DS(3); SGB_MF(2); SGB_DS(3); \
        SGB_MF(2); SGB_DS(3); SGB_MF(2); SGB_MF(2); SGB_MF(2); } while (0)
#define ATT_TOP(t) do { if ((t) + 1 < NT) { ATT_WAIT_BAR(2); } else { ATT_WAIT_BAR(0); } \
        if ((t) + 2 < NT) { ATT_DMA((t) + 2, (k3 == 0) ? 2 : k3 - 1, ((t) + 2) & 3); } } while (0)
    int k3 = 0;
    if (grp == 0) {
        ATT_TOP(0); ATT_QK(0, 0); ATT_BAR(); ATT_S(0);
        k3 = 1;
        for (int t = 1; t < NT; ++t) {
            ATT_TOP(t);
            ATT_SP_M(); if (MODE == 1) { ATT_MMA1((t + 3) & 3, k3); } else { ATT_PV(t - 1, (t + 3) & 3); ATT_QK(t, k3); } ATT_SP_M0();
            ATT_BAR();
            ATT_SP_S(); ATT_S(t); ATT_SP_S0();
            k3 = (k3 == 2) ? 0 : k3 + 1;
        }
        ATT_BAR();
        ATT_PV(NT - 1, (NT + 3) & 3);
        ATT_BAR();
    } else {
        ATT_TOP(0); ATT_BAR(); ATT_QK(0, 0);
        k3 = 1;
        for (int t = 1; t < NT; ++t) {
            ATT_TOP(t);
            ATT_SP_S(); ATT_S(t - 1); ATT_SP_S0();
            ATT_BAR();
            ATT_SP_M(); if (MODE == 1) { ATT_MMA1((t + 3) & 3, k3); } else { ATT_PV(t - 1, (t + 3) & 3); ATT_QK(t, k3); } ATT_SP_M0();
            k3 = (k3 == 2) ? 0 : k3 + 1;
        }
        ATT_BAR();
        ATT_S(NT - 1);
        ATT_BAR();
        ATT_PV(NT - 1, (NT + 3) & 3);
    }
    l1 += shx(l1, 32, lane);
    const float i1 = 1.0f / l1;
    bf16_t* orow = BR + (size_t)(P.qrow0 + r32) * DM + P.ocol + 4 * hi;
    if (MODE == 1) {
        l2 += shx(l2, 32, lane);
        const float i2 = P.lam / l2;
        float ss = 0.f;
#pragma unroll
        for (int dh = 0; dh < 2; ++dh)
#pragma unroll
            for (int r = 0; r < 16; ++r) { const float v = o[dh][r] * i1 - o2[dh][r] * i2; o[dh][r] = v; ss += v * v; }
        ss += shx(ss, 32, lane);
        const float rs = __builtin_amdgcn_rsqf(ss * (1.0f / 64.0f) + EPSN) * P.outscale;
#pragma unroll
        for (int dh = 0; dh < 2; ++dh)
#pragma unroll
            for (int g = 0; g < 4; ++g) { const f32x4 sg = *(const f32x4*)(P.subln + dh * 32 + 8 * g + 4 * hi);
                u32x2 w; w.x = cvtpk(o[dh][4 * g] * rs * sg[0], o[dh][4 * g + 1] * rs * sg[1]); w.y = cvtpk(o[dh][4 * g + 2] * rs * sg[2], o[dh][4 * g + 3] * rs * sg[3]);
                *(u32x2*)(orow + dh * 32 + 8 * g) = w; }
    } else {
#pragma unroll
        for (int dh = 0; dh < 2; ++dh)
#pragma unroll
            for (int g = 0; g < 4; ++g) { u32x2 w; w.x = cvtpk(o[dh][4 * g] * i1, o[dh][4 * g + 1] * i1); w.y = cvtpk(o[dh][4 * g + 2] * i1, o[dh][4 * g + 3] * i1);
                *(u32x2*)(orow + dh * 32 + 8 * g) = w; }
    }
    ATT_BAR();
#undef ATT_TROW
#undef ATT_DMA
#undef ATT_ACTIVE
#undef ATT_SOFT
#undef ATT_S
#undef ATT_PV
#undef ATT_MMA1
#undef ATT_TOP
#undef ATT_QK
}

template <int EXP> __device__ __forceinline__ float a2_exp(float x) {
    if (EXP & 8) { asm volatile("v_exp_f32 %0, %0" : "+v"(x)); return x; }
    if (EXP & 16) { asm volatile("v_add_f32 %0, 1.0, %0\n\tv_add_f32 %0, 1.0, %0" : "+v"(x)); return x; }
    return __builtin_amdgcn_exp2f(x);
}
template <int EXP = 0>
__device__ __forceinline__ void attn_unit_a2(LAS unsigned char* shm, const bf16_t* __restrict__ QKV, bf16_t* BR, const UnitP& P) {
    int tid_ = threadIdx.x; asm volatile("" : "+v"(tid_));
    const int tid = tid_, lane = tid & 63, r32 = lane & 31, hi = lane >> 5; const int wid = __builtin_amdgcn_readfirstlane(tid >> 6);
    const int grp = wid >> 2;
    const unsigned lds0 = (unsigned)(uintptr_t)shm;
    const char* kbase = (const char*)QKV + (size_t)P.kcol * 2 + wid * 16 + (size_t)lane * (NQKV * 2);
    const char* vbase = (const char*)QKV + (size_t)P.vcol * 2 + ((wid >> 2) * 32 + (lane & 3) * 8) * 2 + (size_t)(16 * (wid & 3) + (lane >> 2)) * (NQKV * 2);
    const unsigned kdst = lds0 + LDS_K + wid * 1024, vdst = lds0 + LDS_V + wid * 1024;
    const int nloc = P.nloc, NT = nloc + 4;
#define A2_TROW(t) ((t) < nloc ? P.locrow0 + 64 * (t) : P.ctxrow0 + 64 * ((t) - nloc))
#define A2_DMA(t, ks, vs) do { const size_t ro_ = (size_t)A2_TROW(t) * (NQKV * 2); \
        glds16(kbase + ro_, (unsigned)__builtin_amdgcn_readfirstlane(kdst + (ks) * SLOTB)); glds16(vbase + ro_, (unsigned)__builtin_amdgcn_readfirstlane(vdst + (vs) * SLOTB)); } while (0)
    A2_DMA(0, 0, 0); A2_DMA(1, 1, 1);
    bf16x8 qr[2][4];
    LAS bf16x8* qlds = (LAS bf16x8*)(shm + LDS_Q + wid * 8192) + lane;
#pragma unroll
    for (int j = 0; j < 2; ++j) {
        const bf16_t* Qw = QKV + (size_t)(P.qrow0 + 32 * j + r32) * NQKV + P.qcol + hi * 8;
        u32x4 raw[4];
#pragma unroll
        for (int d0 = 0; d0 < 4; ++d0) raw[d0] = *reinterpret_cast<const u32x4*>(Qw + d0 * 16);
        float x[4][8];
#pragma unroll
        for (int d0 = 0; d0 < 4; ++d0) { x[d0][0] = bflo(raw[d0].x); x[d0][1] = bfhi(raw[d0].x); x[d0][2] = bflo(raw[d0].y); x[d0][3] = bfhi(raw[d0].y);
            x[d0][4] = bflo(raw[d0].z); x[d0][5] = bfhi(raw[d0].z); x[d0][6] = bflo(raw[d0].w); x[d0][7] = bfhi(raw[d0].w); }
        const f32x2* rt = P.rope ? P.rope + (size_t)(P.qpos0 + 32 * j + r32) * 48 : nullptr;
        float ss = 0.f;
#pragma unroll
        for (int d0 = 0; d0 < 4; ++d0)
#pragma unroll
            for (int e = 0; e < 8; ++e) ss += x[d0][e] * x[d0][e];
        ss += shx(ss, 32, lane);
        const float rs = __builtin_amdgcn_rsqf(ss * (1.0f / 64.0f) + EPSN);
#pragma unroll
        for (int d0 = 0; d0 < 4; ++d0)
#pragma unroll
            for (int e = 0; e < 8; ++e) x[d0][e] *= rs * P.qgain[16 * d0 + 8 * hi + e];
        if (rt) {
#pragma unroll
            for (int d0 = 0; d0 < 2; ++d0)
#pragma unroll
                for (int e = 0; e < 8; ++e) { const f32x2 cs = rt[16 * d0 + 8 * hi + e]; const float a = x[d0][e], b = x[d0 + 2][e];
                    x[d0][e] = a * cs.x - b * cs.y; x[d0 + 2][e] = a * cs.y + b * cs.x; } }
        const float qs = 0.125f * LOG2E;
#pragma unroll
        for (int d0 = 0; d0 < 4; ++d0) { u32x4 w; w.x = cvtpk(x[d0][0] * qs, x[d0][1] * qs); w.y = cvtpk(x[d0][2] * qs, x[d0][3] * qs); w.z = cvtpk(x[d0][4] * qs, x[d0][5] * qs); w.w = cvtpk(x[d0][6] * qs, x[d0][7] * qs);
            qr[j][d0] = __builtin_bit_cast(bf16x8, w); qlds[(j * 4 + d0) * 64] = qr[j][d0]; }
    }
    f32x16 o[2][2]; float l1[2] = {0.f, 0.f};
#pragma unroll
    for (int j = 0; j < 2; ++j) { o[j][0] = f32x16{}; o[j][1] = f32x16{}; }
    f32x16 pa[2][2];
#pragma unroll
    for (int j = 0; j < 2; ++j) { pa[j][0] = f32x16{}; pa[j][1] = f32x16{}; }
    u32x4 pw[2][4];
#pragma unroll
    for (int j = 0; j < 2; ++j)
#pragma unroll
        for (int i = 0; i < 4; ++i) pw[j][i] = (u32x4){0u, 0u, 0u, 0u};
    const lds_cptr kp0 = (lds_cptr)shm + LDS_K + hi * 1024 + r32 * 16;
    const lds_cptr vp0 = (lds_cptr)shm + LDS_V + ((lane >> 4) & 1) * 32 + (lane & 3) * 8 + (4 * hi + ((lane & 15) >> 2)) * 64;
#define SGB_TR(n) __builtin_amdgcn_sched_group_barrier(0x400, n, 0)
#define SGB_VA(n) __builtin_amdgcn_sched_group_barrier(0x002, n, 0)
#define A2_SJ(j) do { float s_ = 0.f; \
        _Pragma("unroll") for (int r = 0; r < 16; ++r) { pa[j][0][r] = __builtin_amdgcn_exp2f(pa[j][0][r]); pa[j][1][r] = __builtin_amdgcn_exp2f(pa[j][1][r]); s_ += pa[j][0][r] + pa[j][1][r]; } \
        l1[j] += s_; \
        pw[j][0] = (u32x4){cvtpk(pa[j][0][0], pa[j][0][1]), cvtpk(pa[j][0][2], pa[j][0][3]), cvtpk(pa[j][0][4], pa[j][0][5]), cvtpk(pa[j][0][6], pa[j][0][7])}; \
        pw[j][1] = (u32x4){cvtpk(pa[j][0][8], pa[j][0][9]), cvtpk(pa[j][0][10], pa[j][0][11]), cvtpk(pa[j][0][12], pa[j][0][13]), cvtpk(pa[j][0][14], pa[j][0][15])}; \
        pw[j][2] = (u32x4){cvtpk(pa[j][1][0], pa[j][1][1]), cvtpk(pa[j][1][2], pa[j][1][3]), cvtpk(pa[j][1][4], pa[j][1][5]), cvtpk(pa[j][1][6], pa[j][1][7])}; \
        pw[j][3] = (u32x4){cvtpk(pa[j][1][8], pa[j][1][9]), cvtpk(pa[j][1][10], pa[j][1][11]), cvtpk(pa[j][1][12], pa[j][1][13]), cvtpk(pa[j][1][14], pa[j][1][15])}; } while (0)
#define A2_VLOAD(i) do { const s16x4 vl = vtr(vp + ((i) >> 2) * 4096 + ((i) & 3) * 1024), vh = vtr(vp + ((i) >> 2) * 4096 + ((i) & 3) * 1024 + 512); \
        vf_[i] = (bf16x8){vl[0], vl[1], vl[2], vl[3], vh[0], vh[1], vh[2], vh[3]}; } while (0)
#define A2_SLOT(jm, js, vsp, ksc) do { const lds_cptr vp = vp0 + (vsp) * SLOTB; const lds_cptr kp = kp0 + (ksc) * SLOTB; \
        bf16x8 vf_[8], kf_[4][2], qf_[4]; float sA_ = 0.f; \
        A2_VLOAD(0); A2_VLOAD(1); A2_VLOAD(2); \
        float ec0_ = __builtin_amdgcn_exp2f(pa[js][0][0]), ec1_ = __builtin_amdgcn_exp2f(pa[js][1][0]); asm volatile("" : "+v"(ec0_), "+v"(ec1_)); \
        __builtin_amdgcn_sched_barrier(0); \
        _Pragma("unroll") for (int i = 0; i < 16; ++i) { \
            if (i < 8) o[jm][i >> 2] = ATT_MFMA(vf_[i], __builtin_bit_cast(bf16x8, pw[jm][i & 3]), o[jm][i >> 2]); \
            else { const int d0 = (i - 8) >> 1, h = (i - 8) & 1; pa[jm][h] = ATT_MFMA(kf_[d0][h], qf_[d0], d0 == 0 ? f32x16{} : pa[jm][h]); } \
            if (i + 3 < 8) A2_VLOAD(i + 3); \
            if (i >= 5 && i <= 8) { const int d0 = i - 5; kf_[d0][0] = *(const LAS bf16x8*)(kp + d0 * 2048); kf_[d0][1] = *(const LAS bf16x8*)(kp + d0 * 2048 + 512); qf_[d0] = qlds[((jm) * 4 + d0) * 64]; } \
            { float n0 = 0.f, n1 = 0.f; if (i < 15) { n0 = __builtin_amdgcn_exp2f(pa[js][0][i + 1]); n1 = __builtin_amdgcn_exp2f(pa[js][1][i + 1]); }        \
              sA_ += ec0_ + ec1_; \
              if (i & 1) { unsigned c0 = cvtpk(pa[js][0][i - 1], ec0_), c1 = cvtpk(pa[js][1][i - 1], ec1_); asm volatile("" : "+v"(c0), "+v"(c1)); pw[js][i >> 3][(i & 7) >> 1] = c0; pw[js][2 + (i >> 3)][(i & 7) >> 1] = c1; } \
              pa[js][0][i] = ec0_; pa[js][1][i] = ec1_; \
              asm volatile("" : "+v"(n0), "+v"(n1), "+v"(sA_)); ec0_ = n0; ec1_ = n1; } \
            __builtin_amdgcn_sched_barrier(0); } \
        l1[js] += sA_; } while (0)
#define A2_SLOT0(jm, js, ksc, HAS_S) do { const lds_cptr kp = kp0 + (ksc) * SLOTB; \
        _Pragma("unroll") for (int d0 = 0; d0 < 4; ++d0) { const bf16x8 k0 = *(const LAS bf16x8*)(kp + d0 * 2048), k1 = *(const LAS bf16x8*)(kp + d0 * 2048 + 512); const bf16x8 qf = qlds[((jm) * 4 + d0) * 64]; \
            pa[jm][0] = ATT_MFMA(k0, qf, d0 == 0 ? f32x16{} : pa[jm][0]); pa[jm][1] = ATT_MFMA(k1, qf, d0 == 0 ? f32x16{} : pa[jm][1]); } \
        if (HAS_S) A2_SJ(js); \
        __builtin_amdgcn_sched_barrier(0); } while (0)
#define A2_TOP(t) do { if ((t) + 1 < NT) { ATT_WAIT_BAR(2); } else { ATT_WAIT_BAR(0); } \
        if ((t) + 2 < NT) { A2_DMA((t) + 2, (k3 == 0) ? 2 : k3 - 1, ((t) + 2) & 3); } } while (0)
    int k3 = 0; (void)grp;
    A2_TOP(0);
    A2_SLOT0(0, 1, 0, 0);
    A2_SLOT0(1, 0, 0, 1);
    k3 = 1;
    for (int t = 1; t < NT; ++t) {
        A2_TOP(t);
        A2_SLOT(0, 1, (t + 3) & 3, k3);
        A2_SLOT(1, 0, (t + 3) & 3, k3);
        k3 = (k3 == 2) ? 0 : k3 + 1;
    }
    A2_SJ(1);
    { const lds_cptr vp = vp0 + ((NT + 3) & 3) * SLOTB;
#pragma unroll
        for (int i = 0; i < 8; ++i) { const s16x4 vl = vtr(vp + (i >> 2) * 4096 + (i & 3) * 1024), vh = vtr(vp + (i >> 2) * 4096 + (i & 3) * 1024 + 512);
            const bf16x8 vf = (bf16x8){vl[0], vl[1], vl[2], vl[3], vh[0], vh[1], vh[2], vh[3]};
            o[0][i >> 2] = ATT_MFMA(vf, __builtin_bit_cast(bf16x8, pw[0][i & 3]), o[0][i >> 2]); o[1][i >> 2] = ATT_MFMA(vf, __builtin_bit_cast(bf16x8, pw[1][i & 3]), o[1][i >> 2]); } }
#pragma unroll
    for (int j = 0; j < 2; ++j) {
        float lt = l1[j]; lt += shx(lt, 32, lane);
        const float i1 = 1.0f / lt;
        bf16_t* orow = BR + (size_t)(P.qrow0 + 32 * j + r32) * DM + P.ocol + 4 * hi;
#pragma unroll
        for (int dh = 0; dh < 2; ++dh)
#pragma unroll
            for (int g = 0; g < 4; ++g) { u32x2 w; w.x = cvtpk(o[j][dh][4 * g] * i1, o[j][dh][4 * g + 1] * i1); w.y = cvtpk(o[j][dh][4 * g + 2] * i1, o[j][dh][4 * g + 3] * i1);
                *(u32x2*)(orow + dh * 32 + 8 * g) = w; }
    }
    ATT_BAR();
#undef A2_TROW
#undef A2_DMA
#undef A2_SJ
#undef A2_SLOT
#undef A2_SLOT0
#undef A2_VLOAD
#undef A2_TOP
}
}

struct Args { const float* in[33]; float* out; unsigned char* ws; int ph_lo, ph_hi; };
enum { I_X = 0, I_C, I_CTX, I_CCTX, I_N1G, I_N2G, I_WADA, I_BADA, I_WIN, I_BGATE, I_AQN, I_AKN, I_BQN, I_BKN, I_LQ1, I_LK1, I_LQ2, I_LK2, I_SUBLN, I_CQN, I_CKN, I_SINK, I_DQN, I_DKN, I_RPB,
       I_WBR, I_WOUT, I_RW, I_RB, I_WGU, I_BGU, I_WD, I_BD };
constexpr int N_PHASES = 22;

template <bool NT = false>
__device__ __forceinline__ void p0_transpose_item(const float* __restrict__ W, int K, int N, bf16_t* WT, int item, int lane, LAS float* scr, bool gu_perm, int kmode = 0) {
    const int nblk = N >> 6, kb = item / nblk, nb = item - kb * nblk, k0 = 64 * kb, n0 = 64 * nb;
    const float* src = W + (size_t)k0 * N + n0 + lane;
    float v[64];
#pragma unroll
    for (int i = 0; i < 64; ++i) v[i] = NT ? __builtin_nontemporal_load(src + (size_t)i * N) : src[(size_t)i * N];
#pragma unroll
    for (int i = 0; i < 64; ++i) scr[i * 65 + lane] = v[i];
    LDS_WAIT();
    const int c = lane & 7;
    const int rowbase = gu_perm ? (((n0 & 1023) >> 7) * 256 + (n0 >> 10) * 128 + (n0 & 127)) : n0;
#pragma unroll
    for (int j = 0; j < 8; ++j) { const int n = (lane >> 3) + 8 * j; const LAS float* s = scr + (8 * c) * 65 + n;
        u32x4 o; o.x = cvtpk(s[0 * 65], s[1 * 65]); o.y = cvtpk(s[2 * 65], s[3 * 65]); o.z = cvtpk(s[4 * 65], s[5 * 65]); o.w = cvtpk(s[6 * 65], s[7 * 65]);
        int row = rowbase + n;
        if (kmode) { const int jj = n & 31, x = kmode == 1 ? jj : (8 * ((jj >> 2) & 3) + 4 * (jj >> 4) + (jj & 3)); row = (n0 & ~255) + 128 * (n >> 5) + 32 * ((n0 >> 6) & 3) + x; }
        if (NT) __builtin_nontemporal_store(o, (u32x4*)(WT + (size_t)row * K + k0 + 8 * c)); else *(u32x4*)(WT + (size_t)row * K + k0 + 8 * c) = o; }
    LDS_WAIT();
}

__device__ __forceinline__ void moe_tables(LAS int* tb, const unsigned* gcount) {
    if (threadIdx.x == 0) { int s = 0;
        for (int e = 0; e < 32; ++e) { const int c = (int)gcount[e]; tb[e] = s; tb[64 + e] = c; s += (c + 255) >> 8; }
        tb[32] = s; }
    __syncthreads();
}
__device__ __forceinline__ void moe_gather_row(f32x4 (&a)[4], int row, const unsigned* tokep, const float* tokw, const LAS int* tb, const bf16_t* Y, int lane) {
#pragma unroll
    for (int k = 0; k < 4; ++k) { const unsigned ep = tokep[row * 4 + k]; const float w = tokw[row * 4 + k];
        const int e = (int)(ep >> 24), pos = (int)(ep & 0xffffffu); const size_t slot = (size_t)tb[e] * 256 + pos;
        const u32x2* yp = (const u32x2*)(Y + slot * DM) + lane;
#pragma unroll
        for (int j = 0; j < 4; ++j) { const u32x2 u = yp[64 * j]; a[j][0] += w * bflo(u.x); a[j][1] += w * bfhi(u.x); a[j][2] += w * bflo(u.y); a[j][3] += w * bfhi(u.y); } }
}

__global__ void __launch_bounds__(NTHR, 2) hdb_fwd(Args args) {
    extern __shared__ __attribute__((aligned(16))) unsigned char lds_raw[];
    LAS unsigned char* lds = (LAS unsigned char*)lds_raw;
    const int tid0 = threadIdx.x, wid = __builtin_amdgcn_readfirstlane(tid0 >> 6);
    const int G = gridDim.x, bx = blockIdx.x;
typedef const __attribute__((address_space(4))) char* K4;
#define INP(i) (*(const float* const __attribute__((address_space(4)))*)(kargs_ + 8 * (i)))
#define PH_LOCALS_X PH_LOCALS const float* modl = MOD + l * 5 * 6144; (void)modl;
#define PH_LOCALS K4 kargs_ = (K4)__builtin_amdgcn_kernarg_segment_ptr(); asm volatile("" : "+s"(kargs_)); unsigned char* wsl = *(unsigned char* const __attribute__((address_space(4)))*)(kargs_ + 272); int tid = tid0; asm volatile("" : "+v"(tid)); const int lane = tid & 63; const int gw = bx * NWAVES + wid, NGW = G * NWAVES; (void)lane; (void)gw; (void)NGW;
    unsigned char* ws = args.ws;
    unsigned* ctl = (unsigned*)(ws + WS_CTL);
    LAS int* tb = (LAS int*)(lds + MISC_OFF);
    volatile LAS unsigned* barst = (volatile LAS unsigned*)(lds + MISC_OFF + 512);
    if (tid0 < 4) barst[tid0] = 0u;
    __syncthreads();
    XcdBarrier bar; bar.bar = ctl + CW_BAR; bar.x = 0; bar.st = nullptr;
    if (!MK_PER_PHASE) bar = xcd_barrier_post(ctl + CW_BAR, barst);
    const int lo = args.ph_lo, hi_ph = args.ph_hi;
#ifndef PHMASK
#define PHMASK 0xfff
#endif
#define PHON(b) (((PHMASK) >> (b)) & 1)
#ifndef REPMASK
#define REPMASK 0
#endif
#define NREP(b) ((((REPMASK) >> (b)) & 1) ? 2 : 1)
#define IN(k) (lo <= (k) && (k) < hi_ph)
#define PSTART(k, cond) do { if (PROBE_SEC == (k) && (cond) && bx == 0 && tid0 == 0) ctl[3002] = (unsigned)__builtin_amdgcn_s_memrealtime(); } while (0)
#define CSTART(k, cond) do { if (PROBE_SEC == (k) && (cond) && bx == 0 && tid0 == 0) { const unsigned long long t_ = __builtin_amdgcn_s_memtime(); ctl[3002] = (unsigned)t_; ctl[3003] = (unsigned)(t_ >> 32); } } while (0)
#define CEND(k, cond) do { if (PROBE_SEC == (k) && (cond) && bx == 0 && tid0 == 0) { const unsigned long long t_ = __builtin_amdgcn_s_memtime() - (((unsigned long long)ctl[3003] << 32) | ctl[3002]); ctl[3000] = (unsigned)(t_ / 100ull); } } while (0)
#define PEND(k, cond) do { if (PROBE_SEC == (k) && (cond) && bx == 0 && tid0 == 0) ctl[3000] = (unsigned)__builtin_amdgcn_s_memrealtime() - ctl[3002]; } while (0)
#define SEAM(k) do { if (!MK_PER_PHASE && IN(k) && IN((k) + 1)) xcd_barrier(bar); } while (0)

#define MOD ((float*)(wsl + WS_MOD))
#define ROPE ((f32x2*)(wsl + WS_ROPE))
#define KG ((float*)(wsl + WS_MOD + 512 * 1024))
#define TOKEP ((unsigned*)(wsl + WS_TOKEP))
#define TOKW ((float*)(wsl + WS_TOKW))
#define TOKMAP ((int*)(wsl + WS_TOKMAP))
#define WIN ((bf16_t*)(wsl + WS_WIN))
#define WB ((bf16_t*)(wsl + WS_WB))
#define WO ((bf16_t*)(wsl + WS_WO))
#define WGU ((bf16_t*)(wsl + WS_WGU))
#define WD ((bf16_t*)(wsl + WS_WD))
#define H ((bf16_t*)(wsl + WS_H))
#define QKV ((bf16_t*)(wsl + WS_QKV))
#define GT ((bf16_t*)(wsl + WS_G))
#define BR ((bf16_t*)(wsl + WS_BR))
#define XRB ((bf16_t*)(wsl + WS_XR))
#define ACT ((bf16_t*)(wsl + WS_ACT))
#define Y ((bf16_t*)(wsl + WS_Y))

    PSTART(8, true);
    if (PHON(10) && IN(0)) {
        PH_LOCALS
        for (int it = bx; it < 192; it += G) {
            const int l = it / 96, col0 = (it % 96) * 64;
            LAS float* sl = (LAS float*)lds; LAS float* part = (LAS float*)(lds + 20480);
            for (int i = tid; i < 5 * 1024; i += NTHR) { const int r = i >> 10, k = i & 1023; const float v = (r < 4) ? INP(I_C)[r * 1024 + k] : INP(I_CCTX)[k]; sl[i] = v / (1.0f + __expf(-v)); }
            __syncthreads();
            float acc[5] = {0.f, 0.f, 0.f, 0.f, 0.f};
            const float* wp = INP(I_WADA) + ((size_t)l * 1024 + wid * 128) * 6144 + col0 + lane;
#pragma unroll 16
            for (int kk = 0; kk < 128; ++kk) { const float w = wp[(size_t)kk * 6144];
#pragma unroll
                for (int r = 0; r < 5; ++r) acc[r] += sl[r * 1024 + wid * 128 + kk] * w; }
#pragma unroll
            for (int r = 0; r < 5; ++r) part[(wid * 5 + r) * 64 + lane] = acc[r];
            __syncthreads();
            if (tid < 320) { const int r = tid >> 6, ln = tid & 63; float s = 0.f;
#pragma unroll
                for (int w = 0; w < 8; ++w) s += part[(w * 5 + r) * 64 + ln];
                MOD[(l * 5 + r) * 6144 + col0 + ln] = s + INP(I_BADA)[l * 6144 + col0 + ln]; }
            __syncthreads();
        }
        for (int i = bx * NTHR + tid; i < SEQ * 48; i += G * NTHR) {
            const int t = i / 48, j = i - t * 48; const float row = (float)(t >> 6), col = (float)(t & 63);
            float ang;
            if (j < 32) { const int jj = j & 15; const float inv = powf(10000.0f, -(float)jj / 16.0f); ang = (j < 16 ? row : col) * inv; }
            else { const int j2 = j - 32, jj = j2 & 7; const float inv = powf(10000.0f, -(float)jj / 8.0f); ang = (j2 < 8 ? row : col) * inv; }
            float sn, cs; sincosf(ang, &sn, &cs);
            ROPE[i] = (f32x2){cs, sn};
        }
        if (bx == 1) for (int i = tid; i < 512; i += NTHR) { const int l = i >> 8, mx = (i >> 6) & 3, j = i & 63;
            KG[i] = mx == 0 ? INP(I_AKN)[l * 64 + j] : mx == 1 ? INP(I_BKN)[l * 32 + (j & 31)] : mx == 2 ? INP(I_CKN)[l * 64 + j] : INP(I_DKN)[l * 64 + j]; }
        if (bx == 0) for (int i = tid; i < DM / 2; i += NTHR) ((unsigned*)(H + (size_t)TT * DM))[i] = 0u;
        {
            LAS float* scr = (LAS float*)(lds + wid * 16640);
            constexpr int I_IN = 2 * 16 * 104, I_BRN = 8 * 4 * 16, I_OUT = 2 * 16 * 16, I_GU = 64 * 16 * 32, I_DN = 64 * 16 * 16;
            constexpr int NITEMS = I_IN + I_BRN + I_OUT; (void)I_GU; (void)I_DN;
            unsigned* qhead = ctl + 3100; LAS int* qslot = (LAS int*)(lds + MISC_OFF + 768);
            for (;;) {
                __syncthreads();
                if (tid == 0) qslot[0] = (int)__hip_atomic_fetch_add(qhead, 16u, __ATOMIC_RELAXED, __HIP_MEMORY_SCOPE_AGENT);
                __syncthreads();
                const int c0 = qslot[0];
                if (c0 >= NITEMS) break;
                const int c1 = min(c0 + 16, NITEMS);
            for (int it = c0 + wid; it < c1; it += NWAVES) {
                int r = it;
                if (r < I_IN) { const int l = r / 1664, q = r % 1664; const int ncol = (q % 104) * 64;
                    const int km = (ncol >= KA && ncol < VA) ? ((ncol >= KB_ && ncol < KC) ? 2 : 1) : 0;
                    p0_transpose_item(INP(I_WIN) + (size_t)l * 1024 * NIN, 1024, NIN, WIN + (size_t)l * NIN * 1024, q, lane, scr, false, km); continue; } r -= I_IN;
                if (r < I_BRN) { const int mtx = r / 64, q = r % 64; p0_transpose_item(INP(I_WBR) + (size_t)mtx * 256 * 1024, 256, 1024, WB + (size_t)mtx * 1024 * 256, q, lane, scr, false); continue; } r -= I_BRN;
                { const int l = r / 256, q = r % 256; p0_transpose_item(INP(I_WOUT) + (size_t)l * 1024 * 1024, 1024, 1024, WO + (size_t)l * 1024 * 1024, q, lane, scr, false); }
            }
            }
        }
    }
    SEAM(0);
    PEND(8, true);
#if PROBE_SEC == 40
    PSTART(40, true);
    for (int i_ = 0; i_ < 50; ++i_) xcd_barrier(bar);
    PEND(40, true);
#endif
#ifdef PROBE_BARS
    for (int i_ = 0; i_ < PROBE_BARS; ++i_) xcd_barrier(bar);
#endif

    for (int l = 0; l < 2; ++l) {
        const int pb = 1 + 10 * l;
        const int nrows_m = l == 0 ? TT : TL;
        unsigned* gcount = ctl + CW_GCOUNT + 64 * l;

        PSTART(13, l == 1);
        if (PHON(0) && IN(pb + 0)) {
            PH_LOCALS_X
            if (l == 1) moe_tables(tb, ctl + CW_GCOUNT);
            LAS float* msh = (LAS float*)lds; LAS float* msc = msh + 5 * 1024; LAS float* mg2 = msc + 5 * 1024; LAS float* mgn = mg2 + 5 * 1024;
            { const float* g2prev = MOD + 0 * 5 * 6144;
                for (int i = tid; i < 5 * 1024; i += NTHR) { const int ri = i >> 10, k = i & 1023; msh[i] = modl[ri * 6144 + k]; msc[i] = modl[ri * 6144 + 1024 + k] + 1.0f; if (l == 1) mg2[i] = g2prev[ri * 6144 + 5 * 1024 + k]; }
                for (int i = tid; i < 1024; i += NTHR) mgn[i] = INP(I_N1G)[l * DM + i]; }
            __syncthreads();
            const int step = 2 * NGW;
            if (l == 0) {
                f32x4 xf[2][4];
#pragma unroll
                for (int r = 0; r < 2; ++r) { const int row = (gw + r * NGW < TT) ? gw + r * NGW : gw; const f32x4* xr = (const f32x4*)(row < TL ? INP(I_X) + (size_t)row * DM : INP(I_CTX) + (size_t)(row - TL) * DM) + lane;
#pragma unroll
                    for (int j = 0; j < 4; ++j) xf[r][j] = xr[64 * j]; }
                for (int rowA = gw; rowA < TT; rowA += step) {
                    const bool hasB = rowA + NGW < TT; const int rowB = hasB ? rowA + NGW : rowA;
                    f32x4 v[2][4];
#pragma unroll
                    for (int r = 0; r < 2; ++r)
#pragma unroll
                        for (int j = 0; j < 4; ++j) v[r][j] = xf[r][j];
                    __builtin_amdgcn_sched_barrier(0);
#pragma unroll
                    for (int r = 0; r < 2; ++r) { int row = rowA + step + r * NGW; row = row < TT ? row : rowA; const f32x4* xr = (const f32x4*)(row < TL ? INP(I_X) + (size_t)row * DM : INP(I_CTX) + (size_t)(row - TL) * DM) + lane;
#pragma unroll
                        for (int j = 0; j < 4; ++j) xf[r][j] = xr[64 * j]; }
                    __builtin_amdgcn_sched_barrier(0);
#pragma unroll
                    for (int r = 0; r < 2; ++r) { const int row = r ? rowB : rowA; const int ridx = row < TL ? (row >> 13) : 4;
                        if (r == 1 && !hasB) break;
                        float ss = 0.f;
#pragma unroll
                        for (int j = 0; j < 4; ++j) ss += (v[r][j][0] * v[r][j][0] + v[r][j][1] * v[r][j][1]) + (v[r][j][2] * v[r][j][2] + v[r][j][3] * v[r][j][3]);
                        const float rstd = __builtin_amdgcn_rsqf(wave_sum(ss, lane) * (1.0f / DM) + EPSN);
                        u32x2* o8 = (u32x2*)(H + (size_t)row * DM) + lane;
#pragma unroll
                        for (int j = 0; j < 4; ++j) { const f32x4 y = (v[r][j] * rstd * *(const LAS f32x4*)(mgn + 4 * lane + 256 * j)) * *(const LAS f32x4*)(msc + ridx * 1024 + 4 * lane + 256 * j) + *(const LAS f32x4*)(msh + ridx * 1024 + 4 * lane + 256 * j);
                            u32x2 w; w.x = cvtpk(y[0], y[1]); w.y = cvtpk(y[2], y[3]); o8[64 * j] = w; } }
                }
            } else {
                u32x2 xc[2][4], yc[2][4][4]; f32x4 wc[2], wn[2]; u32x4 en[2];
                { u32x4 e0[2];
#pragma unroll
                    for (int r = 0; r < 2; ++r) { const int row = (gw + r * NGW < TT) ? gw + r * NGW : gw; e0[r] = *(const u32x4*)(TOKEP + row * 4); wc[r] = *(const f32x4*)(TOKW + row * 4);
                        const u32x2* xr = (const u32x2*)(XRB + (size_t)row * DM) + lane;
#pragma unroll
                        for (int j = 0; j < 4; ++j) xc[r][j] = xr[64 * j]; }
#pragma unroll
                    for (int r = 0; r < 2; ++r) { int row = gw + step + r * NGW; row = row < TT ? row : gw; en[r] = *(const u32x4*)(TOKEP + row * 4); wn[r] = *(const f32x4*)(TOKW + row * 4); }
#pragma unroll
                    for (int r = 0; r < 2; ++r)
#pragma unroll
                        for (int k = 0; k < 4; ++k) { const unsigned ep = e0[r][k]; const size_t slot = (size_t)tb[ep >> 24] * 256 + (ep & 0xffffffu); const u32x2* yp = (const u32x2*)(Y + slot * DM) + lane;
#pragma unroll
                            for (int j = 0; j < 4; ++j) yc[r][k][j] = yp[64 * j]; } }
                for (int rowA = gw; rowA < TT; rowA += step) {
                    const bool hasB = rowA + NGW < TT; const int rowB = hasB ? rowA + NGW : rowA;
                    f32x4 v[2][4], a[2][4];
#pragma unroll
                    for (int r = 0; r < 2; ++r)
#pragma unroll
                        for (int j = 0; j < 4; ++j) { const u32x2 t2 = xc[r][j]; v[r][j] = (f32x4){bflo(t2.x), bfhi(t2.x), bflo(t2.y), bfhi(t2.y)}; a[r][j] = (f32x4){0.f, 0.f, 0.f, 0.f};
#pragma unroll
                            for (int k = 0; k < 4; ++k) { const u32x2 u = yc[r][k][j]; const float w = wc[r][k]; a[r][j][0] += w * bflo(u.x); a[r][j][1] += w * bfhi(u.x); a[r][j][2] += w * bflo(u.y); a[r][j][3] += w * bfhi(u.y); } }
                    __builtin_amdgcn_sched_barrier(0);
#pragma unroll
                    for (int r = 0; r < 2; ++r) { int row = rowA + step + r * NGW; row = row < TT ? row : rowA;
#pragma unroll
                        for (int k = 0; k < 4; ++k) { const unsigned ep = en[r][k]; const size_t slot = (size_t)tb[ep >> 24] * 256 + (ep & 0xffffffu); const u32x2* yp = (const u32x2*)(Y + slot * DM) + lane;
#pragma unroll
                            for (int j = 0; j < 4; ++j) yc[r][k][j] = yp[64 * j]; }
                        const u32x2* xr = (const u32x2*)(XRB + (size_t)row * DM) + lane;
#pragma unroll
                        for (int j = 0; j < 4; ++j) xc[r][j] = xr[64 * j];
                        wc[r] = wn[r];
                        int row2 = rowA + 2 * step + r * NGW; row2 = row2 < TT ? row2 : rowA; en[r] = *(const u32x4*)(TOKEP + row2 * 4); wn[r] = *(const f32x4*)(TOKW + row2 * 4); }
                    __builtin_amdgcn_sched_barrier(0);
#pragma unroll
                    for (int r = 0; r < 2; ++r) { const int row = r ? rowB : rowA; const int ridx = row < TL ? (row >> 13) : 4;
                        if (r == 1 && !hasB) break;
                        u32x2* xw = (u32x2*)(XRB + (size_t)row * DM) + lane;
#pragma unroll
                        for (int j = 0; j < 4; ++j) { v[r][j] += *(const LAS f32x4*)(mg2 + ridx * 1024 + 4 * lane + 256 * j) * a[r][j]; u32x2 w2; w2.x = cvtpk(v[r][j][0], v[r][j][1]); w2.y = cvtpk(v[r][j][2], v[r][j][3]); xw[64 * j] = w2; }
                        float ss = 0.f;
#pragma unroll
                        for (int j = 0; j < 4; ++j) ss += (v[r][j][0] * v[r][j][0] + v[r][j][1] * v[r][j][1]) + (v[r][j][2] * v[r][j][2] + v[r][j][3] * v[r][j][3]);
                        const float rstd = __builtin_amdgcn_rsqf(wave_sum(ss, lane) * (1.0f / DM) + EPSN);
                        u32x2* o8 = (u32x2*)(H + (size_t)row * DM) + lane;
#pragma unroll
                        for (int j = 0; j < 4; ++j) { const f32x4 y = (v[r][j] * rstd * *(const LAS f32x4*)(mgn + 4 * lane + 256 * j)) * *(const LAS f32x4*)(msc + ridx * 1024 + 4 * lane + 256 * j) + *(const LAS f32x4*)(msh + ridx * 1024 + 4 * lane + 256 * j);
                            u32x2 w; w.x = cvtpk(y[0], y[1]); w.y = cvtpk(y[2], y[3]); o8[64 * j] = w; } }
                }
            }
        }
        SEAM(pb + 0);
        PEND(13, l == 1);

        PSTART(5, l == 1);
        if (PHON(1) && IN(pb + 1)) {
            PH_LOCALS_X
            pg8::DenseSched S; S.nM = TT / 256; S.nN = NIN / 256; S.nwg = S.nM * S.nN; S.G = G; S.c = bx; S.Bt = (const char*)(WIN + (size_t)l * NIN * 1024); S.ldb2 = 2048; S.kmul = 0;
#if PROBE_SEC >= 110 && PROBE_SEC < 114
            for (int rp = 0; rp < (l == 1 ? 2 : 1); ++rp) {
            if (rp == 1) { xcd_barrier(bar); PSTART(PROBE_SEC, true); }
            pg8::EpiIn E{rp ? ACT : QKV, rp ? Y : GT, INP(I_BGATE) + l * NGATE, rp ? (PROBE_SEC - 110) : 0, KG + l * 256, ROPE};
            pg8::gemm_phase<pg8::EpiIn, pg8::DenseSched>(lds, (const char*)H, 2048u, 2048u, 1024, S, E);
            if (rp == 1) { PEND(PROBE_SEC, true); }
            }
#else
            pg8::EpiIn E{QKV, GT, INP(I_BGATE) + l * NGATE, 0, KG + l * 256, ROPE};
            pg8::gemm_phase<pg8::EpiIn, pg8::DenseSched>(lds, (const char*)H, 2048u, 2048u, 1024, S, E);
#endif
        }
        SEAM(pb + 1);
        PEND(5, l == 1);


        PSTART(15, l == 1);
        if (PHON(3) && IN(pb + 3)) {
            PH_LOCALS_X
            const float lam_init = 0.8f - 0.6f * __expf(-0.3f * (float)l);
            float lam;
            { const float a = (lane < 32) ? INP(I_LQ1)[l * 32 + lane] * INP(I_LK1)[l * 32 + lane] : 0.f, b = (lane < 32) ? INP(I_LQ2)[l * 32 + lane] * INP(I_LK2)[l * 32 + lane] : 0.f;
              lam = __expf(wave_sum(a, lane)) - __expf(wave_sum(b, lane)) + lam_init; lam = __builtin_bit_cast(float, __builtin_amdgcn_readfirstlane(__builtin_bit_cast(int, lam))); }
            const float* subln = INP(I_SUBLN) + l * 64;
            const int ctxb = TL;
            const int cslot = (bx >> 3) & 3;
#define P3_CONVERT() do { __syncthreads(); int ln_ = threadIdx.x & 63; asm volatile("" : "+v"(ln_)); const int lane = ln_; LAS float* scr_ = (LAS float*)(lds + wid * 16640); \
                for (int it_ = wid; it_ < 96; it_ += NWAVES) { const int idx_ = bx * 96 + it_; \
                    if (idx_ < 16384) p0_transpose_item<true>(INP(I_WGU) + (size_t)(l * 32 + (idx_ >> 9)) * 1024 * 2048, 1024, 2048, WGU + (size_t)(l * 32 + (idx_ >> 9)) * 2048 * 1024, idx_ & 511, lane, scr_, true); \
                    else { const int r_ = idx_ - 16384; p0_transpose_item<true>(INP(I_WD) + (size_t)(l * 32 + (r_ >> 8)) * 1024 * 1024, 1024, 1024, WD + (size_t)(l * 32 + (r_ >> 8)) * 1024 * 1024, r_ & 255, lane, scr_, false); } } \
                __syncthreads(); } while (0)
            PSTART(31, l == 1);
            if (cslot == 0) P3_CONVERT();
            PEND(31, l == 1);
#if !defined(ATT_ONLY) || ATT_ONLY == 0
            PSTART(1, l == 1); CSTART(21, l == 1);
            for (int u = bx; u < 512; u += G) {
                att::UnitP P; P.linit = 0.f; P.lam = lam; P.outscale = 1.0f - lam_init; P.subln = subln;
                const int bh = (u & 7) * 2 + ((u >> 8) & 1), blk = (u >> 3) & 31, b = bh >> 2, h = bh & 3;
                P.qrow0 = b * SEQ + blk * 256 + wid * 32; P.qpos0 = blk * 256 + wid * 32;
                P.qcol = QB_ + h * 64; P.kcol = KB_ + h * 64; P.vcol = VB_ + h * 64; P.ocol = 256 + h * 64; P.qgain = INP(I_BQN) + l * 32; P.rope = ROPE;
                P.locrow0 = b * SEQ; P.nloc = 128; P.kpos0 = 0; P.ctxrow0 = ctxb + b * CTXL;
                att::attn_unit<1>(lds, QKV, BR, P);
                if (cslot == 1 + (u >> 8)) P3_CONVERT();
            }
            PEND(1, l == 1); CEND(21, l == 1);
#endif
#if !defined(ATT_ONLY) || ATT_ONLY == 1
            PSTART(2, l == 1); CSTART(22, l == 1);
            for (int u = bx; u < 256; u += G) {
                att::UnitP P; P.linit = 0.f; P.lam = lam; P.outscale = 1.0f; P.subln = subln;
                const int bk = u & 7, blk = u >> 3, b = bk >> 1, kvh = bk & 1, h = kvh * 2 + (wid >> 2);
                P.qrow0 = b * SEQ + blk * 256 + (wid & 3) * 64; P.qpos0 = blk * 256 + (wid & 3) * 64;
                P.qcol = QA + h * 64; P.kcol = KA + kvh * 64; P.vcol = VA + kvh * 64; P.ocol = 0 + h * 64; P.qgain = INP(I_AQN) + l * 64; P.rope = ROPE;
                P.locrow0 = b * SEQ; P.nloc = 128; P.kpos0 = 0; P.ctxrow0 = ctxb + b * CTXL;
                att::attn_unit_a2(lds, QKV, BR, P);
            }
            if (cslot == 3) P3_CONVERT();
            PEND(2, l == 1); CEND(22, l == 1);
#endif
#ifndef ATT_ONLY
            if (l == 0) {
                for (int u = bx; u < 64; u += G) if ((u >> 4) == 0) {
                    const int v = u & 15, b = v >> 2, kvh = (v >> 1) & 1, blk = v & 1, h = kvh * 2 + (wid >> 2);
                    att::UnitP P; P.linit = 0.f; P.lam = lam; P.outscale = 1.0f; P.subln = subln; P.nloc = 0; P.locrow0 = 0; P.kpos0 = 0; P.qpos0 = 0;
                    P.qrow0 = ctxb + b * CTXL + blk * 128 + (wid & 3) * 32; P.ctxrow0 = ctxb + b * CTXL;
                    P.qcol = QA + h * 64; P.kcol = KA + kvh * 64; P.vcol = VA + kvh * 64; P.ocol = h * 64; P.qgain = INP(I_AQN) + l * 64; P.rope = nullptr;
                    att::attn_unit<0>(lds, QKV, BR, P);
                }
                for (int u = bx; u < 64; u += G) if ((u >> 4) == 1) {
                    const int v = u & 15, b = v >> 2, h = v & 3;
                    att::UnitP P; P.linit = 0.f; P.lam = lam; P.outscale = 1.0f - lam_init; P.subln = subln; P.nloc = 0; P.locrow0 = 0; P.kpos0 = 0; P.qpos0 = 0;
                    P.qrow0 = ctxb + b * CTXL + wid * 32; P.ctxrow0 = ctxb + b * CTXL;
                    P.qcol = QB_ + h * 64; P.kcol = KB_ + h * 64; P.vcol = VB_ + h * 64; P.ocol = 256 + h * 64; P.qgain = INP(I_BQN) + l * 32; P.rope = nullptr;
                    att::attn_unit<1>(lds, QKV, BR, P);
                }
                for (int u = bx; u < 64; u += G) if ((u >> 4) == 2) {
                    const int v = u & 15, b = v >> 2, kvh = (v >> 1) & 1, blk = v & 1, h = kvh * 2 + (wid >> 2);
                    att::UnitP P; P.lam = lam; P.outscale = 1.0f; P.subln = subln; P.nloc = 0; P.locrow0 = 0; P.kpos0 = 0; P.qpos0 = 0;
                    P.qrow0 = ctxb + b * CTXL + blk * 128 + (wid & 3) * 32; P.ctxrow0 = ctxb + b * CTXL;
                    P.qcol = QC + h * 64; P.kcol = KC + kvh * 64; P.vcol = VC + kvh * 64; P.ocol = 512 + h * 64; P.qgain = INP(I_CQN) + l * 64; P.rope = nullptr;
                    P.linit = __builtin_amdgcn_exp2f(INP(I_SINK)[l * 4 + h] * LOG2E);
                    att::attn_unit<0>(lds, QKV, BR, P);
                }
                for (int u = bx; u < 64; u += G) if ((u >> 4) == 3) {
                    const int v = u & 15, b = v >> 2, h = v & 3;
                    att::UnitP P; P.linit = 0.f; P.lam = lam; P.outscale = 1.0f; P.subln = subln; P.nloc = 0; P.locrow0 = 0; P.kpos0 = 0; P.qpos0 = 0;
                    P.qrow0 = ctxb + b * CTXL + wid * 32; P.ctxrow0 = ctxb + b * CTXL;
                    P.qcol = QD + h * 64; P.kcol = KD + h * 64; P.vcol = VD + h * 64; P.ocol = 768 + h * 64; P.qgain = INP(I_DQN) + l * 64; P.rope = nullptr;
                    att::attn_unit<0>(lds, QKV, BR, P);
                }
            }
#endif
#if !defined(ATT_ONLY) || ATT_ONLY == 2
            PSTART(3, l == 1);
            for (;;) { LAS int* qs_ = (LAS int*)(lds + MISC_OFF + 772);
                __syncthreads(); if (tid == 0) qs_[0] = (int)__hip_atomic_fetch_add(ctl + 3200 + 8 * l, 1u, __ATOMIC_RELAXED, __HIP_MEMORY_SCOPE_AGENT); __syncthreads();
                const int u = qs_[0]; if (u >= 512) break;
                att::UnitP P; P.lam = lam; P.outscale = 1.0f; P.subln = subln;
                const int bk = u & 7, blk = u >> 3, b = bk >> 1, kvh = bk & 1, h = kvh * 2 + (wid >> 2);
                P.qrow0 = b * SEQ + blk * 128 + (wid & 3) * 32; P.qpos0 = blk * 128 + (wid & 3) * 32;
                P.qcol = QC + h * 64; P.kcol = KC + kvh * 64; P.vcol = VC + kvh * 64; P.ocol = 512 + h * 64; P.qgain = INP(I_CQN) + l * 64; P.rope = ROPE;
                const int k0 = max(blk * 128 - 128, 0), k1 = min(blk * 128 + 256, SEQ);
                P.locrow0 = b * SEQ + k0; P.nloc = (k1 - k0) >> 6; P.kpos0 = k0; P.ctxrow0 = ctxb + b * CTXL;
                P.linit = __builtin_amdgcn_exp2f(INP(I_SINK)[l * 4 + h] * LOG2E);
                att::attn_unit<2>(lds, QKV, BR, P);
            }
            PEND(3, l == 1);
#endif
#if !defined(ATT_ONLY) || ATT_ONLY == 3
            PSTART(4, l == 1);
            for (;;) { LAS int* qs_ = (LAS int*)(lds + MISC_OFF + 772);
                __syncthreads(); if (tid == 0) qs_[0] = (int)__hip_atomic_fetch_add(ctl + 3201 + 8 * l, 1u, __ATOMIC_RELAXED, __HIP_MEMORY_SCOPE_AGENT); __syncthreads();
                const int u = qs_[0]; if (u >= 512) break;
                att::UnitP P; P.linit = 0.f; P.lam = lam; P.outscale = 1.0f; P.subln = subln;
                const int bh = (u & 7) * 2 + ((u >> 8) & 1), blk = (u >> 3) & 31, b = bh >> 2, h = bh & 3;
                { LAS float* bt = (LAS float*)(lds + att::LDS_BIAS); const float* rp = INP(I_RPB) + ((size_t)l * 4 + h) * 465;
                  for (int i = tid; i < 465; i += NTHR) bt[i] = rp[i] * LOG2E; }
                P.qrow0 = b * SEQ + blk * 256 + wid * 32; P.qpos0 = blk * 256 + wid * 32;
                P.qcol = QD + h * 64; P.kcol = KD + h * 64; P.vcol = VD + h * 64; P.ocol = 768 + h * 64; P.qgain = INP(I_DQN) + l * 64; P.rope = nullptr;
                const int ra = min(max(4 * blk - 4, 0), 120), rb = min(max(4 * blk + 3 - 4, 0), 120) + 8;
                P.locrow0 = b * SEQ + ra * 64; P.nloc = rb - ra; P.kpos0 = ra * 64; P.ctxrow0 = ctxb + b * CTXL;
                att::attn_unit<3>(lds, QKV, BR, P);
            }
            PEND(4, l == 1);
#endif
        }
        SEAM(pb + 3);
        PEND(15, l == 1);

        PSTART(9, l == 1);
        if (PHON(4) && IN(pb + 4)) {
            PH_LOCALS_X
            pg8::BranchSchedH S; S.nM = nrows_m / 256; S.nwg = S.nM * 8; S.G = G; S.c = bx; S.Bt = (const char*)(WB + (size_t)l * 4096 * 256);
            pg8::EpiBranchH E{}; E.Gt = GT; E.SUMB = H;
            pg8::gemm_phase<pg8::EpiBranchH, pg8::BranchSchedH>(lds, (const char*)BR, 2048u, 512u, 256, S, E);
        }
        SEAM(pb + 4);
        PEND(9, l == 1);

        if (PHON(5) && IN(pb + 5)) {
            PH_LOCALS_X
        }

        PSTART(10, l == 1);
        if (PHON(6) && IN(pb + 6)) {
            PH_LOCALS_X
            pg8::DenseSched S; S.nM = nrows_m / 256; S.nN = 4; S.nwg = S.nM * S.nN; S.G = G; S.c = bx; S.Bt = (const char*)(WO + (size_t)l * 1024 * 1024); S.ldb2 = 2048; S.kmul = 0;
            pg8::EpiOut E{INP(I_X), INP(I_CTX), XRB, modl, l};
            pg8::gemm_phase<pg8::EpiOut, pg8::DenseSched>(lds, (const char*)H, 2048u, 2048u, 1024, S, E);
        }
        SEAM(pb + 6);
        PEND(10, l == 1);

        PSTART(11, l == 1);
        if (PHON(7) && IN(pb + 7)) {
            PH_LOCALS_X
            constexpr int XRS = 2064;
            LAS char* xh = (LAS char*)lds;
            constexpr int XLO = 32 * XRS;
            LAS float* part = (LAS float*)lds;
            LAS float* lgl = (LAS float*)(lds + 133120);
            LAS unsigned* ent = (LAS unsigned*)lgl;
            LAS int* lcount = (LAS int*)(lds + 133120 + 160 * 128);
            const float* rw = INP(I_RW) + (size_t)l * 1024 * 32;
            if (tid < 64) lcount[tid] = 0;
            const int nloc_rows = (nrows_m - bx + G - 1) / G;
            const f32x4* gn = (const f32x4*)(INP(I_N2G) + l * DM) + lane;
            const int fn = lane & 31, fkg = lane >> 5;
            bf16x8 wh[8], wl[8];
#pragma unroll
            for (int s = 0; s < 8; ++s) { const float* wp = rw + (size_t)(128 * wid + 16 * s + 8 * fkg) * 32 + fn; u32x4 h4, l4;
#pragma unroll
                for (int i = 0; i < 4; ++i) { const float w0 = wp[(2 * i) * 32], w1 = wp[(2 * i + 1) * 32]; const unsigned hp = cvtpk(w0, w1); h4[i] = hp; l4[i] = cvtpk(w0 - bflo(hp), w1 - bfhi(hp)); }
                wh[s] = __builtin_bit_cast(bf16x8, h4); wl[s] = __builtin_bit_cast(bf16x8, l4); }
            f32x4 gnv[4];
#pragma unroll
            for (int j = 0; j < 4; ++j) gnv[j] = gn[64 * j];
            const float rb0 = INP(I_RB)[l * 32 + (tid & 15) * 2], rb1 = INP(I_RB)[l * 32 + (tid & 15) * 2 + 1];
            u32x2 nx[4][4];
#pragma unroll
            for (int i = 0; i < 4; ++i) { const int li = wid * 4 + i; const u32x2* xr = (const u32x2*)(XRB + (size_t)(bx + (li < nloc_rows ? li : 0) * G) * DM) + lane;
#pragma unroll
                for (int j = 0; j < 4; ++j) nx[i][j] = xr[64 * j]; }
            const int nch = (nloc_rows + 31) >> 5;
            for (int c = 0; c < nch; ++c) {
                const int rowc = bx + c * 32 * G; const int ridx = rowc < TL ? (rowc >> 13) : 4;
                f32x4 shv[4], scv[4];
                { const f32x4* sh = (const f32x4*)(modl + ridx * 6144 + 3 * 1024) + lane; const f32x4* sc = (const f32x4*)(modl + ridx * 6144 + 4 * 1024) + lane;
#pragma unroll
                    for (int j = 0; j < 4; ++j) { shv[j] = sh[64 * j]; scv[j] = sc[64 * j]; } }
                __builtin_amdgcn_sched_barrier(0);
#pragma unroll
                for (int pr = 0; pr < 2; ++pr) {
                    f32x4 v[2][4]; float ss[2] = {0.f, 0.f};
#pragma unroll
                    for (int r = 0; r < 2; ++r)
#pragma unroll
                        for (int j = 0; j < 4; ++j) { const u32x2 t2 = nx[2 * pr + r][j]; v[r][j] = (f32x4){bflo(t2.x), bfhi(t2.x), bflo(t2.y), bfhi(t2.y)}; }
                    __builtin_amdgcn_sched_barrier(0);
#pragma unroll
                    for (int r = 0; r < 2; ++r) { const int li = (c + 1) * 32 + wid * 4 + 2 * pr + r; const u32x2* xr = (const u32x2*)(XRB + (size_t)(bx + (li < nloc_rows ? li : 0) * G) * DM) + lane;
#pragma unroll
                        for (int j = 0; j < 4; ++j) nx[2 * pr + r][j] = xr[64 * j]; }
                    __builtin_amdgcn_sched_barrier(0);
#pragma unroll
                    for (int r = 0; r < 2; ++r) {
#pragma unroll
                        for (int j = 0; j < 4; ++j) ss[r] += (v[r][j][0] * v[r][j][0] + v[r][j][1] * v[r][j][1]) + (v[r][j][2] * v[r][j][2] + v[r][j][3] * v[r][j][3]); }
#pragma unroll
                    for (int r = 0; r < 2; ++r) { const int rc = wid * 4 + 2 * pr + r, li = c * 32 + rc; const bool valid = li < nloc_rows; const int row = bx + (valid ? li : 0) * G;
                        const float rstd = __builtin_amdgcn_rsqf(wave_sum(ss[r], lane) * (1.0f / DM) + EPSN);
                        u32x2* o8 = (u32x2*)(H + (size_t)row * DM) + lane;
#pragma unroll
                        for (int j = 0; j < 4; ++j) { const f32x4 y = (v[r][j] * rstd * gnv[j]) * (scv[j] + 1.0f) + shv[j];
                            u32x2 w, wlo; w.x = cvtpk(y[0], y[1]); w.y = cvtpk(y[2], y[3]); wlo.x = cvtpk(y[0] - bflo(w.x), y[1] - bfhi(w.x)); wlo.y = cvtpk(y[2] - bflo(w.y), y[3] - bfhi(w.y));
                            if (valid) o8[64 * j] = w;
                            *(LAS u32x2*)(xh + rc * XRS + (4 * lane + 256 * j) * 2) = w; *(LAS u32x2*)(xh + XLO + rc * XRS + (4 * lane + 256 * j) * 2) = wlo; } }
                }
                __syncthreads();
                f32x16 acc;
#pragma unroll
                for (int i = 0; i < 16; ++i) acc[i] = 0.f;
                { LAS const char* bh = xh + fn * XRS + (128 * wid + 8 * fkg) * 2;
#pragma unroll
                    for (int s = 0; s < 8; ++s) { const bf16x8 fh = *(LAS const bf16x8*)(bh + 32 * s), fl = *(LAS const bf16x8*)(bh + XLO + 32 * s);
                        acc = ATT_MFMA(wh[s], fh, acc); acc = ATT_MFMA(wh[s], fl, acc); acc = ATT_MFMA(wl[s], fh, acc); } }
                __syncthreads();
#pragma unroll
                for (int q = 0; q < 4; ++q) *(LAS f32x4*)(part + (wid * 32 + fn) * 36 + 8 * q + 4 * fkg) = (f32x4){acc[4 * q], acc[4 * q + 1], acc[4 * q + 2], acc[4 * q + 3]};
                __syncthreads();
                { const int r = tid >> 4, e0 = (tid & 15) * 2; f32x2 sacc = (f32x2){rb0, rb1};
#pragma unroll
                    for (int w = 0; w < 8; ++w) sacc += *(LAS const f32x2*)(part + (w * 32 + r) * 36 + e0);
                    *(LAS f32x2*)(lgl + (c * 32 + r) * 32 + e0) = sacc; }
                __syncthreads();
            }
            __syncthreads();
            for (int li = tid; li < nloc_rows; li += NTHR) {
                float q[32];
#pragma unroll
                for (int i = 0; i < 8; ++i) { const f32x4 t4 = *(const LAS f32x4*)(lgl + li * 32 + 4 * i); q[4 * i] = t4[0]; q[4 * i + 1] = t4[1]; q[4 * i + 2] = t4[2]; q[4 * i + 3] = t4[3]; }
                int te[4]; float tv[4];
#pragma unroll
                for (int k = 0; k < 4; ++k) { float best = q[0]; int bi = 0;
#pragma unroll
                    for (int e = 1; e < 32; ++e) { const bool gt = q[e] > best; best = gt ? q[e] : best; bi = gt ? e : bi; }
                    te[k] = bi; tv[k] = best;
#pragma unroll
                    for (int e = 0; e < 32; ++e) q[e] = (e == bi) ? -INFINITY : q[e]; }
                float ew[4], es = 0.f;
#pragma unroll
                for (int k = 0; k < 4; ++k) { ew[k] = __expf(tv[k] - tv[0]); es += ew[k]; }
                const float ies = 1.0f / es;
#pragma unroll
                for (int k = 0; k < 4; ++k) { const int lp = __hip_atomic_fetch_add(&lcount[te[k]], 1, __ATOMIC_RELAXED, __HIP_MEMORY_SCOPE_WORKGROUP);
                    ent[li * 32 + 2 * k] = (unsigned)te[k] | ((unsigned)lp << 8); ent[li * 32 + 2 * k + 1] = __float_as_uint(ew[k] * ies); }
            }
            __syncthreads();
            if (tid < 32) lcount[32 + tid] = (int)atomicAdd(&gcount[tid], (unsigned)lcount[tid]);
            __syncthreads();
            for (int i = tid; i < nloc_rows * 4; i += NTHR) { const int li = i >> 2, k = i & 3, row = bx + li * G;
                const unsigned ev = ent[li * 32 + 2 * k]; const int e = (int)(ev & 255u), pos = lcount[32 + e] + (int)(ev >> 8);
                TOKMAP[(size_t)e * ECAP + pos] = row; TOKEP[row * 4 + k] = ((unsigned)e << 24) | (unsigned)pos; TOKW[row * 4 + k] = __uint_as_float(ent[li * 32 + 2 * k + 1]); }
            __syncthreads();
        }
        SEAM(pb + 7);
        PEND(11, l == 1);

        PSTART(6, l == 1);
        if (PHON(8) && IN(pb + 8)) {
            PH_LOCALS_X
            moe_tables(tb, gcount);
            pg8::MoeSched S; S.G = G; S.c = bx; S.npn = 8; S.gather = 1; S.tb = tb; S.tokmap = TOKMAP; S.Bt = (const char*)(WGU + (size_t)l * 32 * 2048 * 1024); S.bexp = (size_t)2048 * 1024 * 2; S.ldb2 = 2048; S.zrow = TT;
            pg8::EpiSwiglu E{ACT, INP(I_BGU) + (size_t)l * 32 * 2048, lds, 0};
            pg8::gemm_phase<pg8::EpiSwiglu, pg8::MoeSched>(lds, (const char*)H, 2048u, 2048u, 1024, S, E);
        }
        SEAM(pb + 8);
        PEND(6, l == 1);

        PSTART(7, l == 1);
        if (PHON(9) && IN(pb + 9)) {
            PH_LOCALS_X
            moe_tables(tb, gcount);
            pg8::MoeSched S; S.G = G; S.c = bx; S.npn = 4; S.gather = 0; S.tb = tb; S.tokmap = TOKMAP; S.Bt = (const char*)(WD + (size_t)l * 32 * 1024 * 1024); S.bexp = (size_t)1024 * 1024 * 2; S.ldb2 = 2048; S.zrow = TT;
            pg8::EpiDown E{Y, INP(I_BD) + (size_t)l * 32 * 1024, lds, 0};
            pg8::gemm_phase<pg8::EpiDown, pg8::MoeSched>(lds, (const char*)ACT, 2048u, 2048u, 1024, S, E);
        }
        SEAM(pb + 9);
        PEND(7, l == 1);
    }

    PSTART(14, true);
    if (PHON(11) && IN(21)) {
        PH_LOCALS
        moe_tables(tb, ctl + CW_GCOUNT + 64);
        const float* mod1 = MOD + 1 * 5 * 6144;
        for (int rowA = gw; rowA < TL; rowA += 2 * NGW) {
            const bool hasB = rowA + NGW < TL; const int rowB = hasB ? rowA + NGW : rowA;
            f32x4 v[2][4], a[2][4];
#pragma unroll
            for (int r = 0; r < 2; ++r) { const u32x2* xr = (const u32x2*)(XRB + (size_t)(r ? rowB : rowA) * DM) + lane;
#pragma unroll
                for (int j = 0; j < 4; ++j) { const u32x2 t2 = xr[64 * j]; v[r][j] = (f32x4){bflo(t2.x), bfhi(t2.x), bflo(t2.y), bfhi(t2.y)}; a[r][j] = (f32x4){0.f, 0.f, 0.f, 0.f}; } }
            moe_gather_row(a[0], rowA, TOKEP, TOKW, tb, Y, lane);
            moe_gather_row(a[1], rowB, TOKEP, TOKW, tb, Y, lane);
#pragma unroll
            for (int r = 0; r < 2; ++r) { const int row = r ? rowB : rowA;
                if (r == 1 && !hasB) break;
                const f32x4* g2 = (const f32x4*)(mod1 + (row >> 13) * 6144 + 5 * 1024) + lane;
                f32x4* op = (f32x4*)(args.out + (size_t)row * DM) + lane;
#pragma unroll
                for (int j = 0; j < 4; ++j) op[64 * j] = v[r][j] + g2[64 * j] * a[r][j]; }
        }
    }
#if PROBE_SEC >= 200 && PROBE_SEC < 232
        { constexpr int l = 1; PH_LOCALS_X
            xcd_barrier(bar);
            PSTART(PROBE_SEC, true);
            { const int u = bx; att::UnitP P; P.linit = 0.f; P.lam = 0.f; P.outscale = 1.0f; P.subln = INP(I_SUBLN);
                const int bk = u & 7, blk = u >> 3, b = bk >> 1, kvh = bk & 1, h = kvh * 2 + (wid >> 2);
                P.qrow0 = b * SEQ + blk * 256 + (wid & 3) * 64; P.qpos0 = blk * 256 + (wid & 3) * 64;
                P.qcol = QA + h * 64; P.kcol = KA + kvh * 64; P.vcol = VA + kvh * 64; P.ocol = 0 + h * 64; P.qgain = INP(I_AQN) + l * 64; P.rope = ROPE;
                P.locrow0 = b * SEQ; P.nloc = 128; P.kpos0 = 0; P.ctxrow0 = TL + b * CTXL;
                att::attn_unit_a2<PROBE_SEC - 200>(lds, QKV, ACT, P); }
            PEND(PROBE_SEC, true);
        }
#endif
#if PROBE_SEC
    PEND(14, true);
    if (bx == 0 && tid0 == 0) { asm volatile("s_waitcnt vmcnt(0)" ::: "memory"); const unsigned tk_ = __hip_atomic_load(&ctl[3000], __ATOMIC_RELAXED, __HIP_MEMORY_SCOPE_AGENT);
        const unsigned long long t0_ = __builtin_amdgcn_s_memrealtime(); while (__builtin_amdgcn_s_memrealtime() - t0_ < (unsigned long long)tk_ * 10ull) __builtin_amdgcn_s_sleep(8); }
#endif
#undef IN
#undef SEAM
}

extern "C" void kernel_launch(void* const* d_in, const int* in_sizes, int n_in, void* d_out, int out_size, void* d_ws, size_t ws_size, hipStream_t stream) {
    static int grid = 0;
    if (grid == 0) {
        if (n_in != 33 || out_size != TL * DM || ws_size < WS_END) { fprintf(stderr, "kernel_launch: unexpected shapes (n_in %d out %d ws %zu)\n", n_in, out_size, ws_size); grid = -1; return; }
        int dev = 0, cus = 0, per_cu = 0;
        if (hipGetDevice(&dev) != hipSuccess || hipDeviceGetAttribute(&cus, hipDeviceAttributeMultiprocessorCount, dev) != hipSuccess) { grid = -1; return; }
        if (hipFuncSetAttribute((const void*)hdb_fwd, hipFuncAttributeMaxDynamicSharedMemorySize, LDS_BYTES) != hipSuccess) { fprintf(stderr, "kernel_launch: hipFuncSetAttribute failed\n"); grid = -1; return; }
        if (hipOccupancyMaxActiveBlocksPerMultiprocessor(&per_cu, (const void*)hdb_fwd, NTHR, LDS_BYTES) != hipSuccess || per_cu < 1) { fprintf(stderr, "kernel_launch: occupancy query reports %d\n", per_cu); }
        (void)hipGetLastError();
        grid = cus;
        if (grid > 256) grid = 256;
        if (grid != 256) { fprintf(stderr, "kernel_launch: the router phase assumes 256 workgroups (one batch per 32 local rows), device has %d CUs\n", cus); grid = -1; return; }
    }
    if (grid < 0) return;
    (void)hipMemsetAsync((char*)d_ws + WS_CTL, 0, CTL_ZERO_BYTES, stream);
    Args a{};
    for (int i = 0; i < 33; ++i) a.in[i] = (const float*)d_in[i];
    a.out = (float*)d_out; a.ws = (unsigned char*)d_ws;
#if MK_PER_PHASE
    for (int p = 0; p < N_PHASES; ++p) { a.ph_lo = p; a.ph_hi = p + 1; hipLaunchKernelGGL(hdb_fwd, dim3(grid), dim3(NTHR), LDS_BYTES, stream, a); }
#else
    a.ph_lo = 0; a.ph_hi = N_PHASES;
    hipLaunchKernelGGL(hdb_fwd, dim3(grid), dim3(NTHR), LDS_BYTES, stream, a);
#endif
}
```
